# Optimizing an MI355X kernel written in HIP

```python
import math
import jax, jax.numpy as jnp
from jax import lax
import numpy as np

D_MODEL = 1024
BATCH = 8
SEQ = 4096
DEPTH = 1

CHUNK = 64
D_MIX = D_MODEL
FOX_HEADS = 8
FOX_HEAD_DIM = 64
FOX_WIDTH = FOX_HEADS * FOX_HEAD_DIM
HGRN_HEADS = 4
HGRN_HEAD_DIM = 128
HGRN_WIDTH = HGRN_HEADS * HGRN_HEAD_DIM
Q_BLOCK = 128
PEER_HEADS = 8
PEER_QUERY_DIM = 256
N_KEYS = 128
N_EXPERTS = N_KEYS * N_KEYS
PEER_TOPK = 16
PEER_TOKEN_BLOCK = 128
N_MOD = 6
EPS = 1e-6
SPLIT_SIZES = (FOX_WIDTH, FOX_WIDTH, FOX_WIDTH, FOX_HEADS,
               HGRN_WIDTH, HGRN_WIDTH, HGRN_WIDTH, HGRN_WIDTH)
D_IN = sum(SPLIT_SIZES)

kernel_name = "hybrid_fox_hgrn2_peer_block"


def _rmsnorm(x, g):
    x32 = x.astype(jnp.float32)
    y = x32 * lax.rsqrt(jnp.mean(x32 * x32, axis=-1, keepdims=True) + EPS)
    return (y * g.astype(jnp.float32)).astype(x.dtype)


def _forgetting_attention(q, k, v, logf):
    B, S, H, Dh = q.shape
    F = jnp.cumsum(logf, axis=1).transpose(0, 2, 1)
    scale = Dh ** -0.5
    outs = []
    for start in range(0, S, Q_BLOCK):
        end = start + Q_BLOCK
        qb, kb, vb = q[:, start:end], k[:, :end], v[:, :end]
        logits = (jnp.einsum('bqhd,bkhd->bhqk', qb, kb).astype(jnp.float32) * scale
                  + F[:, :, start:end, None] - F[:, :, None, :end])
        mask = (start + jnp.arange(Q_BLOCK))[:, None] >= jnp.arange(end)[None, :]
        p = jax.nn.softmax(jnp.where(mask[None, None], logits, -jnp.inf), axis=-1)
        outs.append(jnp.einsum('bhqk,bkhd->bqhd', p.astype(v.dtype), vb))
    return jnp.concatenate(outs, axis=1)


def _hgrn2_chunkwise(q, f, inp):
    B, S, H, Dk = q.shape
    Dv = inp.shape[-1]
    n = S // CHUNK
    f32 = jnp.float32

    def to_chunks(a):
        return a.astype(f32).reshape(B, n, CHUNK, H, a.shape[-1]).transpose(1, 0, 3, 2, 4)

    qc = to_chunks(q) * (Dk ** -0.5)
    kc = to_chunks(1.0 - f)
    lfc = to_chunks(jnp.log(f))
    ic = to_chunks(inp)
    tri = jnp.tril(jnp.ones((CHUNK, CHUNK), dtype=bool))

    def step(state, xs):
        q_, k_, i_, lf_ = xs
        A = jnp.cumsum(lf_, axis=2)
        o_inter = jnp.einsum('bhtk,bhkv->bhtv', q_ * jnp.exp(A), state)
        diff = A[:, :, :, None, :] - A[:, :, None, :, :]
        decay = jnp.exp(jnp.where(tri[:, :, None], diff, -jnp.inf))
        scores = jnp.einsum('bhtk,bhsk,bhtsk->bhts', q_, k_, decay)
        o_intra = jnp.einsum('bhts,bhsv->bhtv', scores, i_)
        A_last = A[:, :, -1:, :]
        new_state = (jnp.exp(A_last[:, :, 0, :])[..., None] * state
                     + jnp.einsum('bhsk,bhsv->bhkv', k_ * jnp.exp(A_last - A), i_))
        return new_state, o_inter + o_intra

    s0 = jnp.zeros((B, H, Dk, Dv), f32)
    _, o = lax.scan(step, s0, (qc, kc, ic, lfc))
    return o.transpose(1, 0, 3, 2, 4).reshape(B, S, H, Dv).astype(inp.dtype)


def _peer(h, w_q, sub_keys, u, v):
    B, S, D = h.shape
    T = B * S
    ht = h.reshape(T, D)
    q = (ht @ w_q).astype(jnp.float32).reshape(T, PEER_HEADS, 2, PEER_QUERY_DIM // 2)
    q = q * lax.rsqrt(jnp.mean(q * q, axis=-1, keepdims=True) + EPS)
    scores = jnp.einsum('thpd,hpnd->thpn', q, sub_keys.astype(jnp.float32))
    s_top, i_top = lax.top_k(scores, PEER_TOPK)
    cand = (s_top[:, :, 0, :, None] + s_top[:, :, 1, None, :]).reshape(T, PEER_HEADS, PEER_TOPK * PEER_TOPK)
    cand_idx = (i_top[:, :, 0, :, None] * N_KEYS + i_top[:, :, 1, None, :]).reshape(T, PEER_HEADS, PEER_TOPK * PEER_TOPK)
    best, pos = lax.top_k(cand, PEER_TOPK)
    idx = jnp.take_along_axis(cand_idx, pos, axis=-1)
    gate = jax.nn.softmax(best, axis=-1)
    E = PEER_HEADS * PEER_TOPK
    nblk = T // PEER_TOKEN_BLOCK

    def expert_block(args):
        xb, ib, gb = args
        a = jnp.einsum('td,ted->te', xb, u[ib])
        act = (gb * jax.nn.gelu(a.astype(jnp.float32), approximate=False)).astype(xb.dtype)
        return jnp.einsum('te,ted->td', act, v[ib])

    out = lax.map(expert_block, (ht.reshape(nblk, PEER_TOKEN_BLOCK, D),
                                 idx.reshape(nblk, PEER_TOKEN_BLOCK, E),
                                 gate.reshape(nblk, PEER_TOKEN_BLOCK, E)))
    return out.reshape(B, S, D)


def setup_inputs(seed: int = 0) -> dict:
    key = jax.random.key(seed)
    ks = jax.random.split(key, 17)
    nrm = jax.random.normal
    D = D_MODEL
    return {
        'x': nrm(ks[0], (BATCH, SEQ, D), jnp.float32),
        'c': nrm(ks[1], (BATCH, D), jnp.float32),
        'w_ada': nrm(ks[2], (DEPTH, D, N_MOD * D), jnp.float32) * (0.1 * D ** -0.5),
        'b_ada': nrm(ks[3], (DEPTH, N_MOD * D), jnp.float32) * 0.3,
        'pre_mix_g': 1.0 + 0.05 * nrm(ks[4], (DEPTH, D), jnp.float32),
        'post_mix_g': 1.0 + 0.05 * nrm(ks[5], (DEPTH, D), jnp.float32),
        'w_in': nrm(ks[6], (DEPTH, D, D_IN), jnp.float32) * D ** -0.5,
        'b_fox_f': 2.0 + 0.5 * nrm(ks[7], (DEPTH, FOX_HEADS), jnp.float32),
        'hgrn_gamma': 0.5 * nrm(ks[8], (DEPTH + 1, HGRN_WIDTH), jnp.float32),
        'hgrn_norm_g': 1.0 + 0.05 * nrm(ks[9], (DEPTH, HGRN_WIDTH), jnp.float32),
        'w_out': nrm(ks[10], (DEPTH, D_MIX, D), jnp.float32) * D_MIX ** -0.5,
        'pre_ffn_g': 1.0 + 0.05 * nrm(ks[11], (DEPTH, D), jnp.float32),
        'post_ffn_g': 1.0 + 0.05 * nrm(ks[12], (DEPTH, D), jnp.float32),
        'peer_w_q': nrm(ks[13], (DEPTH, D, PEER_HEADS * PEER_QUERY_DIM), jnp.float32) * D ** -0.5,
        'peer_sub_keys': nrm(ks[14], (DEPTH, PEER_HEADS, 2, N_KEYS, PEER_QUERY_DIM // 2), jnp.float32) * (PEER_QUERY_DIM // 2) ** -0.5,
        'peer_u': nrm(ks[15], (DEPTH, N_EXPERTS, D), jnp.float32) * D ** -0.5,
        'peer_v': nrm(ks[16], (DEPTH, N_EXPERTS, D), jnp.float32) * D ** -0.5,
    }


def reference(x, c, w_ada, b_ada, pre_mix_g, post_mix_g, w_in, b_fox_f, hgrn_gamma,
              hgrn_norm_g, w_out, pre_ffn_g, post_ffn_g, peer_w_q, peer_sub_keys,
              peer_u, peer_v):
    B, S, D = x.shape
    lower_bounds = jnp.cumsum(jax.nn.softmax(hgrn_gamma.astype(jnp.float32), axis=0), axis=0)
    cond = jax.nn.silu(c)
    split_idx = [int(s) for s in np.cumsum(SPLIT_SIZES)[:-1]]
    for l in range(DEPTH):
        mod = cond @ w_ada[l] + b_ada[l]
        shift_a, scale_a, gate_a, shift_f, scale_f, gate_f = [m[:, None, :] for m in jnp.split(mod, N_MOD, axis=-1)]

        h = _rmsnorm(x, pre_mix_g[l]) * (1.0 + scale_a) + shift_a
        proj = h @ w_in[l]
        fq, fk, fv, ff, hq, hf, hi, hg = jnp.split(proj, split_idx, axis=-1)

        logf = jax.nn.log_sigmoid(ff.astype(jnp.float32) + b_fox_f[l].astype(jnp.float32))
        shp_f = (B, S, FOX_HEADS, FOX_HEAD_DIM)
        o_fox = _forgetting_attention(fq.reshape(shp_f), fk.reshape(shp_f), fv.reshape(shp_f), logf)
        o_fox = o_fox.reshape(B, S, FOX_WIDTH)

        lb = lower_bounds[l]
        f = lb + (1.0 - lb) * jax.nn.sigmoid(hf.astype(jnp.float32))
        shp_h = (B, S, HGRN_HEADS, HGRN_HEAD_DIM)
        o_h = _hgrn2_chunkwise(hq.reshape(shp_h), f.reshape(shp_h), hi.reshape(shp_h))
        o_h = _rmsnorm(o_h, hgrn_norm_g[l].reshape(HGRN_HEADS, HGRN_HEAD_DIM)).reshape(B, S, HGRN_WIDTH)
        o_h = o_h * jax.nn.silu(hg)

        mix = jnp.concatenate([o_fox, o_h], axis=-1) @ w_out[l]
        x = x + gate_a * _rmsnorm(mix, post_mix_g[l])

        h2 = _rmsnorm(x, pre_ffn_g[l]) * (1.0 + scale_f) + shift_f
        y = _peer(h2, peer_w_q[l], peer_sub_keys[l], peer_u[l], peer_v[l])
        x = x + gate_f * _rmsnorm(y, post_ffn_g[l])
    return x
```

```cpp
#include <hip/hip_runtime.h>
#include <stdint.h>
#include <cstdio>

typedef unsigned short bf16_t;
typedef short bf16x8 __attribute__((ext_vector_type(8)));
typedef float f32x4 __attribute__((ext_vector_type(4)));
typedef float f32x16 __attribute__((ext_vector_type(16)));
typedef unsigned u32x4 __attribute__((ext_vector_type(4)));
typedef unsigned u32x2 __attribute__((ext_vector_type(2)));

constexpr int BATCH = 8, SEQ = 4096, DM = 1024, T = BATCH * SEQ;
constexpr int NPROJ = 3584;
constexpr int C_Q = 0, C_K = 512, C_V = 1024, C_HQ = 1536, C_LF = 2048, C_HI = 2560, C_SG = 3072;
constexpr int NQ2 = 2048, NEXP = 16384;
constexpr float EPS = 1e-6f;
constexpr float LOG2E = 1.4426950408889634f;
constexpr float QSCALE = 0.125f * LOG2E;
constexpr float HQSCALE = 0.08838834764831845f;

constexpr size_t MiB = 1u << 20;
constexpr size_t WS_CTL = 0;
constexpr size_t WS_MOD = 1 * MiB;
constexpr size_t WS_LB = WS_MOD + 256 * 1024;
constexpr size_t WS_WFF = WS_MOD + 512 * 1024;
constexpr size_t WS_WIN = 2 * MiB;
constexpr size_t WS_WOUT = 10 * MiB;
constexpr size_t WS_WQ = 12 * MiB;
constexpr size_t WS_KEYS = 16 * MiB;
constexpr size_t WS_US = 17 * MiB;
constexpr size_t WS_VS = WS_US + 256 * 1024;
constexpr size_t WS_UQ = 18 * MiB;
constexpr size_t WS_F = 50 * MiB;
constexpr size_t WS_F2T = 52 * MiB;
constexpr size_t WS_H = 56 * MiB;
constexpr size_t WS_PROJ = 120 * MiB;
constexpr size_t WS_KK = 344 * MiB;
constexpr size_t WS_OCAT = 376 * MiB;
constexpr size_t WS_HST = 440 * MiB;
constexpr size_t WS_HD = 504 * MiB;
constexpr size_t WS_Q2 = WS_PROJ;
constexpr size_t WS_IDX = WS_PROJ + 128 * MiB;
constexpr size_t WS_GATE = WS_PROJ + 144 * MiB;
constexpr size_t WS_END = 505 * MiB;

__device__ __forceinline__ float bf2f(bf16_t v) { return __uint_as_float(((unsigned)v) << 16); }
typedef float f32x2_t __attribute__((ext_vector_type(2))); typedef __bf16 bf16x2_t __attribute__((ext_vector_type(2)));
__device__ __forceinline__ unsigned pk2(float lo, float hi) { f32x2_t v = {lo, hi}; bf16x2_t b = __builtin_convertvector(v, bf16x2_t); return __builtin_bit_cast(unsigned, b); }
__device__ __forceinline__ bf16_t f2bf(float f) { return (bf16_t)(pk2(f, 0.f) & 0xffffu); }
__device__ __forceinline__ unsigned short f2h(float f) { _Float16 h = (_Float16)f; return __builtin_bit_cast(unsigned short, h); }
__device__ __forceinline__ float h2f(unsigned short u) { _Float16 h = __builtin_bit_cast(_Float16, u); return (float)h; }
__device__ __forceinline__ float wave_sum(float v) {
#pragma unroll
    for (int o = 1; o < 64; o <<= 1) v += __shfl_xor(v, o);
    return v;
}
__device__ __forceinline__ float wave_max(float v) {
#pragma unroll
    for (int o = 1; o < 64; o <<= 1) v = fmaxf(v, __shfl_xor(v, o));
    return v;
}
__device__ __forceinline__ float sigmoidf_(float z) { return 1.f / (1.f + __expf(-z)); }
__device__ __forceinline__ float gelu_erf(float a) { return 0.5f * a * (1.f + erff(a * 0.7071067811865476f)); }

#define DUP_PHASE (-1)
#define DUP_MODE 0
namespace pg8 {
__device__ __forceinline__ int ptid_() { int t = threadIdx.x; asm volatile("" : "+v"(t)); return t; }
#define PG8_LAS __attribute__((address_space(3)))
typedef unsigned short bf16_t;
typedef short bf16x8 __attribute__((ext_vector_type(8)));
typedef float f32x4 __attribute__((ext_vector_type(4)));
typedef unsigned u32x4 __attribute__((ext_vector_type(4)));
constexpr int BM = 256, BK = 64, HALF = 128, HTB = HALF * BK * 2  , STAGE_BYTES = 8 * HTB, NXCD = 8, WGM = 8;

__host__ __device__ __forceinline__ int lds_byte(int r, int c) { const int st = (r >> 4) * 2 + (c >> 5), rr = r & 15, cc = c & 31, ob = rr * 64 + cc * 2; return st * 1024 + (ob ^ (((ob >> 9) & 1) << 5)); }
__host__ __device__ __forceinline__ void stage_rc(int b, int& R, int& C) { const int st = b / 1024, sb = b % 1024, swz = sb ^ (((sb >> 9) & 1) << 5); R = (st >> 1) * 16 + swz / 64; C = (st & 1) * 32 + (swz % 64) / 2; }
__host__ __device__ __forceinline__ int perm32(int rho) { const int n = rho >> 4, i = rho & 15; return 8 * (i >> 2) + 4 * n + (i & 3); }

struct Unit { int pm, pn; };
struct Gemm { const bf16_t* A; const bf16_t* Bt; int M, N, K; };

struct StaticOrder {
    int nM, nN, nwg, G, c;
    __host__ __device__ void init(int M, int N, int G_, int c_) { nM = M / BM; nN = N / BM; nwg = nM * nN; G = G_; c = c_; }
    __host__ __device__ bool next(int i, Unit& u) const {
        const long L = (long)i * G + c; if (L >= nwg) return false;
        int wgid = (int)L; { const int q = nwg / NXCD, r = nwg % NXCD, xcd = wgid % NXCD, off = wgid / NXCD; wgid = (xcd < r ? xcd * (q + 1) : r * (q + 1) + (xcd - r) * q) + off; }
        const int nig = WGM * nN, gid = wgid / nig, fm = gid * WGM, gsz = (nM - fm) < WGM ? (nM - fm) : WGM;
        u.pm = fm + ((wgid % nig) % gsz); u.pn = (wgid % nig) / gsz; return true;
    }
    __device__ __forceinline__ void a_ready(const Unit&) const {}
    __device__ __forceinline__ void done(const Unit&) const {}
};

template <class Epi, class Sched, bool ALIGN_EPI = false, bool SP2 = false>
__device__ __forceinline__ void gemm_phase(PG8_LAS unsigned char* lds, const Gemm g, const Sched& S, const Epi& E) {
    const int tid = ptid_(), wid = __builtin_amdgcn_readfirstlane(tid >> 6), lane = tid & 63, wr = wid >> 2, wc = wid & 3, fr = lane & 15, fq = lane >> 4;
    const int K = g.K, nt = K / BK;
    unsigned voffA[2], voffB[2];
#pragma unroll
    for (int i = 0; i < 2; ++i) { int R, C; stage_rc(tid * 16 + i * 8192, R, C); const int Rb = Epi::PERM ? ((R & ~31) + perm32(R & 31)) : R;
        voffA[i] = (unsigned)(R * K + C) * 2u; voffB[i] = (unsigned)(Rb * K + C) * 2u; }
    const size_t kstep = (size_t)(BK * 2);
    const size_t hstep = (size_t)HALF * K * 2;
    const size_t tstep = 2 * hstep;
    const unsigned ldsw = (unsigned)wid * 1024u;
    const int aoff = lds_byte(wr * 64 + fr, fq * 8), boff = lds_byte(wc * 32 + fr, fq * 8);
#define PG8_SA(b, h) (((b) * 2 + (h)) * HTB)
#define PG8_SB(b, h) ((4 + (b) * 2 + (h)) * HTB)
#define PG8_STAGE(bufoff, gbase, voff) do { _Pragma("unroll") for (int _i = 0; _i < 2; ++_i) \
        __builtin_amdgcn_global_load_lds((const unsigned*)((const char*)(gbase) + (voff)[_i]), (PG8_LAS unsigned*)(lds + (bufoff) + ldsw + _i * 8192), 16, 0, 0); } while (0)
#define PG8_LDA(dst, b, h) do { _Pragma("unroll") for (int m = 0; m < 4; ++m) _Pragma("unroll") for (int k = 0; k < 2; ++k) dst[m][k] = *(const PG8_LAS bf16x8*)(lds + PG8_SA(b, h) + aoff + m * 2048 + k * 1024); } while (0)
#define PG8_LDB(dst, b, h) do { _Pragma("unroll") for (int n = 0; n < 2; ++n) _Pragma("unroll") for (int k = 0; k < 2; ++k) dst[n][k] = *(const PG8_LAS bf16x8*)(lds + PG8_SB(b, h) + boff + n * 2048 + k * 1024); } while (0)
#define PG8_MMA(ai, bj, At, Bt) do { __builtin_amdgcn_s_setprio(1); _Pragma("unroll") for (int m = 0; m < 4; ++m) _Pragma("unroll") for (int n = 0; n < 2; ++n) _Pragma("unroll") for (int k = 0; k < 2; ++k) \
        acc[ai][bj][m][n] = __builtin_amdgcn_mfma_f32_16x16x32_bf16(Bt[n][k], At[m][k], acc[ai][bj][m][n], 0, 0, 0); __builtin_amdgcn_s_setprio(0); } while (0)
#define PG8_WAIT_V(n) asm volatile("s_waitcnt vmcnt(" #n ")" ::: "memory")
#define PG8_WAIT_L(n) asm volatile("s_waitcnt lgkmcnt(" #n ")" ::: "memory")
#define PG8_BAR __builtin_amdgcn_s_barrier()
#define PG8_SCHED __builtin_amdgcn_sched_barrier(0)
    Unit cur, nxt; int ui = 0;
    if (!S.next(0, cur)) return;
    f32x4 acc[2][2][4][2];
#pragma unroll
    for (int a = 0; a < 2; ++a)
#pragma unroll
        for (int b = 0; b < 2; ++b)
#pragma unroll
            for (int m = 0; m < 4; ++m)
#pragma unroll
                for (int n = 0; n < 2; ++n) acc[a][b][m][n] = (f32x4){0.f, 0.f, 0.f, 0.f};
    bf16x8 At[4][2], B0[2][2], B1[2][2];
    const char* cA = (const char*)g.A + (size_t)cur.pm * tstep; const char* cB = (const char*)g.Bt + (size_t)cur.pn * tstep;
    S.a_ready(cur);
    if constexpr (SP2) {
        PG8_STAGE(PG8_SB(0, 0), cB, voffB); PG8_STAGE(PG8_SB(0, 1), cB + hstep, voffB); PG8_STAGE(PG8_SA(0, 0), cA, voffA); PG8_STAGE(PG8_SA(0, 1), cA + hstep, voffA);
        if (wr == 1) PG8_BAR;
        PG8_WAIT_V(2); PG8_BAR;
        PG8_STAGE(PG8_SB(1, 0), cB + kstep, voffB); PG8_STAGE(PG8_SA(1, 0), cA + kstep, voffA); PG8_STAGE(PG8_SB(1, 1), cB + hstep + kstep, voffB);
        PG8_WAIT_V(6); PG8_BAR;
    } else {
        PG8_STAGE(PG8_SB(0, 0), cB, voffB); PG8_STAGE(PG8_SA(0, 0), cA, voffA); PG8_STAGE(PG8_SB(0, 1), cB + hstep, voffB); PG8_STAGE(PG8_SA(0, 1), cA + hstep, voffA);
        if (wr == 1) PG8_BAR;
        PG8_WAIT_V(4); PG8_BAR;
        PG8_STAGE(PG8_SB(1, 0), cB + kstep, voffB); PG8_STAGE(PG8_SA(1, 0), cA + kstep, voffA); PG8_STAGE(PG8_SB(1, 1), cB + hstep + kstep, voffB);
        PG8_WAIT_V(6); PG8_BAR;
    }
    for (;;) {
        const bool has_next = S.next(ui + 1, nxt);
        const char* nA = has_next ? (const char*)g.A + (size_t)nxt.pm * tstep : cA; const char* nB = has_next ? (const char*)g.Bt + (size_t)nxt.pn * tstep : cB;
        for (int t = 0; t < nt; t += 2) {
            const bool last = (t == nt - 2);
            const char* a1 = cA + (size_t)(t + 1) * kstep;
            const char* a2 = last ? nA : cA + (size_t)(t + 2) * kstep; const char* b2 = last ? nB : cB + (size_t)(t + 2) * kstep;
            const char* a3 = a2 + kstep; const char* b3 = b2 + kstep;
            if (last && has_next) S.a_ready(nxt);
            if constexpr (SP2) {
            PG8_LDB(B0, 0, 0); PG8_LDB(B1, 0, 1); PG8_SCHED; PG8_LDA(At, 0, 0); PG8_STAGE(PG8_SA(1, 1), a1 + hstep, voffA);
            PG8_WAIT_V(8); PG8_WAIT_L(0); PG8_BAR; PG8_MMA(0, 0, At, B0); PG8_MMA(0, 1, At, B1); PG8_BAR; PG8_SCHED;
            PG8_LDA(At, 0, 1); PG8_STAGE(PG8_SB(0, 0), b2, voffB); PG8_STAGE(PG8_SB(0, 1), b2 + hstep, voffB); PG8_STAGE(PG8_SA(0, 0), a2, voffA);
            PG8_WAIT_V(8); PG8_WAIT_L(0); PG8_BAR; PG8_MMA(1, 0, At, B0); PG8_MMA(1, 1, At, B1); PG8_BAR; PG8_SCHED;
            PG8_LDB(B0, 1, 0); PG8_LDB(B1, 1, 1); PG8_SCHED; PG8_LDA(At, 1, 0); PG8_STAGE(PG8_SA(0, 1), a2 + hstep, voffA);
            PG8_WAIT_V(8); PG8_WAIT_L(0); PG8_BAR; PG8_MMA(0, 0, At, B0); PG8_MMA(0, 1, At, B1); PG8_BAR; PG8_SCHED;
            PG8_LDA(At, 1, 1); PG8_STAGE(PG8_SB(1, 0), b3, voffB); PG8_STAGE(PG8_SB(1, 1), b3 + hstep, voffB); PG8_STAGE(PG8_SA(1, 0), a3, voffA);
            PG8_WAIT_V(8); PG8_WAIT_L(0); PG8_BAR; PG8_MMA(1, 0, At, B0); PG8_MMA(1, 1, At, B1); PG8_BAR; PG8_SCHED;
            } else {
            PG8_LDB(B0, 0, 0); PG8_SCHED; PG8_LDA(At, 0, 0); PG8_STAGE(PG8_SA(1, 1), a1 + hstep, voffA);
            PG8_WAIT_L(8); PG8_BAR; PG8_WAIT_L(0); PG8_MMA(0, 0, At, B0); PG8_BAR; PG8_SCHED;
            PG8_LDB(B1, 0, 1); PG8_STAGE(PG8_SB(0, 0), b2, voffB);
            PG8_BAR; PG8_WAIT_L(0); PG8_MMA(0, 1, At, B1); PG8_BAR;
            PG8_LDA(At, 0, 1); PG8_STAGE(PG8_SA(0, 0), a2, voffA);
            PG8_BAR; PG8_WAIT_L(0); PG8_MMA(1, 0, At, B0); PG8_BAR; PG8_SCHED;
            PG8_STAGE(PG8_SB(0, 1), b2 + hstep, voffB);
            PG8_WAIT_V(6); PG8_BAR; PG8_MMA(1, 1, At, B1); PG8_BAR;
            PG8_LDB(B0, 1, 0); PG8_SCHED; PG8_LDA(At, 1, 0); PG8_STAGE(PG8_SA(0, 1), a2 + hstep, voffA);
            PG8_WAIT_L(8); PG8_BAR; PG8_WAIT_L(0); PG8_MMA(0, 0, At, B0); PG8_BAR; PG8_SCHED;
            PG8_LDB(B1, 1, 1); PG8_STAGE(PG8_SB(1, 0), b3, voffB);
            PG8_BAR; PG8_WAIT_L(0); PG8_MMA(0, 1, At, B1); PG8_BAR;
            PG8_LDA(At, 1, 1); PG8_STAGE(PG8_SA(1, 0), a3, voffA);
            PG8_BAR; PG8_WAIT_L(0); PG8_MMA(1, 0, At, B0); PG8_BAR; PG8_SCHED;
            PG8_STAGE(PG8_SB(1, 1), b3 + hstep, voffB);
            PG8_WAIT_V(6); PG8_BAR; PG8_MMA(1, 1, At, B1); PG8_BAR;
            }
        }
        if constexpr (ALIGN_EPI) { if (wr == 0) PG8_BAR; }
        if constexpr (!Epi::AFTER_DRAIN) { E(acc, cur, wr, wc, fr, fq); S.done(cur); }
        if (!has_next) break;
#pragma unroll
        for (int a = 0; a < 2; ++a)
#pragma unroll
            for (int b = 0; b < 2; ++b)
#pragma unroll
                for (int m = 0; m < 4; ++m)
#pragma unroll
                    for (int n = 0; n < 2; ++n) acc[a][b][m][n] = (f32x4){0.f, 0.f, 0.f, 0.f};
        cur = nxt; cA = nA; cB = nB; ++ui;
        if constexpr (ALIGN_EPI) { if (wr == 1) PG8_BAR; }
    }
    PG8_WAIT_V(0);
    if constexpr (!ALIGN_EPI) { if (wr == 0) PG8_BAR; }
    PG8_BAR;
    if constexpr (Epi::AFTER_DRAIN) { E.fused(acc, cur, wr, wc, fr, fq, lds, wid, lane); S.done(cur); }
#undef PG8_SA
#undef PG8_SB
#undef PG8_STAGE
#undef PG8_LDA
#undef PG8_LDB
#undef PG8_MMA
#undef PG8_WAIT_V
#undef PG8_WAIT_L
#undef PG8_BAR
#undef PG8_SCHED
}
}

#define LAS __attribute__((address_space(3)))
__device__ __forceinline__ int ptid() { int t = threadIdx.x; asm volatile("" : "+v"(t)); return t; }
constexpr int NWAVES = 8, NTHREADS = 512;
constexpr int RING_BYTES = 131072;
constexpr int MISC_OFF = RING_BYTES + 320;
constexpr int LDS_BYTES = 147456;
constexpr int CW_BAR = 4096;
constexpr size_t CTL_ZERO_BYTES = 256 * 1024;
constexpr int CW_ATTNQ = 20480;

#define XB_TMO      128
#define XB_XCNT(j)  (256  + 64 * (j))
#define XB_XSUB(j)  (1280 + 64 * (j))
#define XB_XGEN(j)  (2304 + 64 * (j))
#define XB_TOP      3328
#define XB_TOPGEN   3392
#define XCD_BAR_WORDS 3456
#define XB_SPIN_CAP (1u << 20)
__device__ __forceinline__ unsigned xb_ld(unsigned* p)              { return __hip_atomic_load(p, __ATOMIC_RELAXED, __HIP_MEMORY_SCOPE_AGENT); }
__device__ __forceinline__ unsigned xb_add(unsigned* p, unsigned v) { return __hip_atomic_fetch_add(p, v, __ATOMIC_RELAXED, __HIP_MEMORY_SCOPE_AGENT); }
__device__ __forceinline__ unsigned xb_xcc_id() { return (unsigned)__builtin_amdgcn_s_getreg((3 << 11) | 20) & 0xFu; }
#define XB_SPIN(cond, bar) do { unsigned _sp = 0; while (cond) { __builtin_amdgcn_s_sleep(1); \
    if ((++_sp & 255u) == 0u) { if (xb_ld(&(bar)[XB_TMO])) break; if (_sp > XB_SPIN_CAP) { atomicAdd(&(bar)[XB_TMO], 1u); break; } } } } while (0)
struct XcdBarrier { unsigned* bar; unsigned x; volatile LAS unsigned* st; };
__device__ __forceinline__ XcdBarrier xcd_barrier_post(unsigned* bar, volatile LAS unsigned* st) {
    XcdBarrier b; b.bar = bar; b.x = xb_xcc_id(); b.st = st;
    if (threadIdx.x == 0) (void)xb_add(&bar[XB_XCNT(b.x)], 1u);
    return b;
}
__device__ __forceinline__ void xcd_barrier_complete(unsigned* bar, unsigned x, unsigned& nloc, unsigned& nx) {
    const unsigned G = gridDim.x * gridDim.y * gridDim.z;
    unsigned sum, cnt, mine, sp = 0u;
    for (;;) {
        sum = 0u; cnt = 0u; mine = 0u;
#pragma unroll
        for (unsigned j = 0; j < 16; ++j) { const unsigned c = xb_ld(&bar[XB_XCNT(j)]); sum += c; cnt += (c > 0u) ? 1u : 0u; mine = (j == x) ? c : mine; }
        if (sum == G) break;
        __builtin_amdgcn_s_sleep(1);
        if ((++sp & 255u) == 0u) { if (xb_ld(&bar[XB_TMO])) break; if (sp > XB_SPIN_CAP) { atomicAdd(&bar[XB_TMO], 1u); break; } }
    }
    nloc = mine > 0u ? mine : 1u; nx = cnt > 0u ? cnt : 1u;
}
__device__ __forceinline__ void xcd_barrier(const XcdBarrier& b) {
    asm volatile("s_waitcnt vmcnt(0)" ::: "memory");
    __syncthreads();
    if (threadIdx.x == 0) {
        unsigned* bar = b.bar;
        __builtin_amdgcn_s_waitcnt(0);
        unsigned nloc = b.st[0], nx = b.st[1];
        if (nloc == 0u) { xcd_barrier_complete(bar, b.x, nloc, nx); b.st[0] = nloc; b.st[1] = nx; }
        const unsigned old = xb_add(&bar[XB_XSUB(b.x)], 1u);
        const unsigned gen = old / nloc;
        if (old + 1u == (gen + 1u) * nloc) {
            __builtin_amdgcn_fence(__ATOMIC_RELEASE, "agent");
            asm volatile("s_waitcnt vmcnt(0)" ::: "memory");
            const unsigned og = xb_add(&bar[XB_TOP], 1u);
            const unsigned tg = og / nx;
            if (og + 1u == (tg + 1u) * nx) xb_add(&bar[XB_TOPGEN], 1u);
            else XB_SPIN(xb_ld(&bar[XB_TOPGEN]) == tg, bar);
            __builtin_amdgcn_fence(__ATOMIC_ACQUIRE, "agent");
            xb_add(&bar[XB_XGEN(b.x)], 1u);
            asm volatile("s_waitcnt vmcnt(0)" ::: "memory");
        } else {
            XB_SPIN(xb_ld(&bar[XB_XGEN(b.x)]) == gen, bar);
            __builtin_amdgcn_fence(__ATOMIC_ACQUIRE, "agent");
            asm volatile("s_waitcnt vmcnt(0)" ::: "memory");
        }
    }
    __syncthreads();
}

struct Args { const float* in[17]; float* out; unsigned char* ws; int ph_lo, ph_hi, li, flags; };
enum { FL_ATTN = 1, FL_HGRN = 2 };

__device__ __forceinline__ unsigned cvt_pk_bf16(float lo, float hi) { f32x2_t v = {lo, hi}; bf16x2_t b = __builtin_convertvector(v, bf16x2_t); return __builtin_bit_cast(unsigned, b); }
struct EpiPlainT {
    static constexpr bool PERM = true, AFTER_DRAIN = false;
    bf16_t* O; int ld;
    __device__ __forceinline__ void operator()(const pg8::f32x4 (&acc)[2][2][4][2], const pg8::Unit& u, int wr, int wc, int fr, int fq) const {
        const int row0 = u.pm * 256 + wr * 64 + fr, col0 = u.pn * 256 + wc * 32 + 8 * fq;
#pragma unroll
        for (int ai = 0; ai < 2; ++ai)
#pragma unroll
            for (int m = 0; m < 4; ++m) { bf16_t* rowp = O + (size_t)(row0 + ai * 128 + m * 16) * ld + col0;
#pragma unroll
                for (int bj = 0; bj < 2; ++bj) { const pg8::f32x4 v0 = acc[ai][bj][m][0], v1 = acc[ai][bj][m][1];
                    u32x4 w; w.x = cvt_pk_bf16(v0[0], v0[1]); w.y = cvt_pk_bf16(v0[2], v0[3]); w.z = cvt_pk_bf16(v1[0], v1[1]); w.w = cvt_pk_bf16(v1[2], v1[3]);
                    *(u32x4*)(rowp + bj * 128) = w; } }
    }
};
struct EpiProjT {
    static constexpr bool PERM = true, AFTER_DRAIN = false;
    bf16_t* proj; bf16_t* kk; const float* lb; unsigned* kmaxh;
    __device__ __forceinline__ void operator()(const pg8::f32x4 (&acc)[2][2][4][2], const pg8::Unit& u, int wr, int wc, int fr, int fq) const {
        const int row0 = u.pm * 256 + wr * 64 + fr, col0 = u.pn * 256 + wc * 32 + 8 * fq, seg = (u.pn * 256) >> 9;
        float kmx[2] = {0.f, 0.f};
        float lbv[2][8];
        if (seg == 4) {
#pragma unroll
            for (int bj = 0; bj < 2; ++bj)
#pragma unroll
                for (int i = 0; i < 8; ++i) lbv[bj][i] = lb[col0 - C_LF + bj * 128 + i];
        }
        const float sc = (seg == 0) ? QSCALE : (seg == 3) ? HQSCALE : 1.f;
#pragma unroll
        for (int ai = 0; ai < 2; ++ai)
#pragma unroll
            for (int m = 0; m < 4; ++m) { const size_t row = (size_t)(row0 + ai * 128 + m * 16);
#pragma unroll
                for (int bj = 0; bj < 2; ++bj) {
                    float v[8];
#pragma unroll
                    for (int i = 0; i < 4; ++i) { v[i] = acc[ai][bj][m][0][i]; v[4 + i] = acc[ai][bj][m][1][i]; }
                    u32x4 w;
                    if (seg == 4) {
                        float k1[8]; unsigned short hh[8];
#pragma unroll
                        for (int i = 0; i < 8; ++i) { const float l = lbv[bj][i], f = l + (1.f - l) * sigmoidf_(v[i]); k1[i] = 1.f - f; hh[i] = f2h(__logf(f)); }
                        w.x = hh[0] | ((unsigned)hh[1] << 16); w.y = hh[2] | ((unsigned)hh[3] << 16); w.z = hh[4] | ((unsigned)hh[5] << 16); w.w = hh[6] | ((unsigned)hh[7] << 16);
                        u32x4 kw; kw.x = cvt_pk_bf16(k1[0], k1[1]); kw.y = cvt_pk_bf16(k1[2], k1[3]); kw.z = cvt_pk_bf16(k1[4], k1[5]); kw.w = cvt_pk_bf16(k1[6], k1[7]);
                        *(u32x4*)(kk + row * 512 + (col0 - C_LF + bj * 128)) = kw;
                    } else {
                        if (seg == 6) {
#pragma unroll
                            for (int i = 0; i < 8; ++i) v[i] = v[i] * sigmoidf_(v[i]);
                        } else {
#pragma unroll
                            for (int i = 0; i < 8; ++i) v[i] *= sc;
                        }
                        w.x = cvt_pk_bf16(v[0], v[1]); w.y = cvt_pk_bf16(v[2], v[3]); w.z = cvt_pk_bf16(v[4], v[5]); w.w = cvt_pk_bf16(v[6], v[7]);
                        if (seg == 1) {
                            float s = 0.f;
#pragma unroll
                            for (int i = 0; i < 4; ++i) { const float a = __uint_as_float(w[i] << 16), b = __uint_as_float(w[i] & 0xffff0000u); s += a * a + b * b; }
                            s += __shfl_xor(s, 16); s += __shfl_xor(s, 32);
                            kmx[bj] = fmaxf(kmx[bj], s);
                        }
                    }
                    *(u32x4*)(proj + row * NPROJ + col0 + bj * 128) = w;
                } }
        if (seg == 1) {
#pragma unroll
            for (int bj = 0; bj < 2; ++bj) { float m = kmx[bj]; m = fmaxf(m, __shfl_xor(m, 1)); m = fmaxf(m, __shfl_xor(m, 2)); m = fmaxf(m, __shfl_xor(m, 4)); m = fmaxf(m, __shfl_xor(m, 8));
                const int head = (u.pn - 2) * 4 + bj * 2 + (wc >> 1), b = (u.pm * 256) / SEQ;
                if (fr == 0 && fq == 0) atomicMax(kmaxh + ((b * 8 + head) * 2 + (wc & 1)), __float_as_uint(m)); }
        }
    }
};

__device__ __forceinline__ void transpose_item(const float* __restrict__ W, int ldw, int c0, bf16_t* WT, int r0, LAS float* scr, int item, int nblk, int lane) {
    const int k0 = 64 * (item / nblk), n0 = 32 * (item % nblk);
#pragma unroll 8
    for (int i = 0; i < 32; ++i) { const int kk = 2 * i + (lane >> 5); scr[kk * 33 + (lane & 31)] = W[(size_t)(k0 + kk) * ldw + c0 + n0 + (lane & 31)]; }
    asm volatile("s_waitcnt lgkmcnt(0)" ::: "memory");
    const int c = lane & 7;
#pragma unroll
    for (int j = 0; j < 4; ++j) { const int n = (lane >> 3) + 8 * j; const LAS float* s = scr + (8 * c) * 33 + n;
        u32x4 o; o.x = pk2(s[0 * 33], s[1 * 33]); o.y = pk2(s[2 * 33], s[3 * 33]); o.z = pk2(s[4 * 33], s[5 * 33]); o.w = pk2(s[6 * 33], s[7 * 33]);
        *(u32x4*)(WT + (size_t)(r0 + n0 + n) * 1024 + k0 + 8 * c) = o; }
    asm volatile("s_waitcnt lgkmcnt(0)" ::: "memory");
}
__device__ __forceinline__ void quant_row4(const float* __restrict__ src, unsigned char* q, float* scale, int row, int lane) {
    const f32x4* p = (const f32x4*)(src + (size_t)row * 1024 + lane * 16);
    f32x4 v[4]; float ss = 0.f;
#pragma unroll
    for (int j = 0; j < 4; ++j) { v[j] = p[j]; ss += v[j].x * v[j].x + v[j].y * v[j].y + v[j].z * v[j].z + v[j].w * v[j].w; }
    ss = wave_sum(ss);
    const float sc = ss > 0.f ? 0.3352f * sqrtf(ss * (1.f / 1024.f)) : 1.f, inv = 1.f / sc;
    unsigned n[16];
#pragma unroll
    for (int j = 0; j < 4; ++j) {
#pragma unroll
        for (int i = 0; i < 4; ++i) { const float f = floorf(v[j][i] * inv) + 8.f; n[4 * j + i] = (unsigned)fminf(fmaxf(f, 0.f), 15.f); } }
    u32x2 o;
#pragma unroll
    for (int m = 0; m < 2; ++m) { unsigned w = 0;
#pragma unroll
        for (int b = 0; b < 4; ++b) w |= (n[8 * m + b] | (n[8 * m + 4 + b] << 4)) << (8 * b);
        o[m] = w; }
    *(u32x2*)(q + (size_t)row * 1024 + lane * 16) = o;
    if (lane == 0) scale[row] = sc;
}
__device__ __forceinline__ void h_row(const float* __restrict__ x, const float* __restrict__ g, const float* __restrict__ mod, const float* __restrict__ wff, const float* __restrict__ bf, bf16_t* H, float* logf, int t, int lane) {
    const int b = t / SEQ;
    const float* shift = mod + b * 6144, * scale = shift + 1024;
    f32x4 v[4]; float s = 0.f;
#pragma unroll
    for (int j = 0; j < 4; ++j) { v[j] = *(const f32x4*)(x + (size_t)t * 1024 + 256 * j + 4 * lane); s += v[j].x * v[j].x + v[j].y * v[j].y + v[j].z * v[j].z + v[j].w * v[j].w; }
    const float rstd = rsqrtf(wave_sum(s) * (1.f / 1024.f) + EPS);
    float ff[8];
#pragma unroll
    for (int i = 0; i < 8; ++i) ff[i] = 0.f;
#pragma unroll
    for (int j = 0; j < 4; ++j) {
        const int c0 = 256 * j + 4 * lane;
        const f32x4 gg = *(const f32x4*)(g + c0), sc = *(const f32x4*)(scale + c0), sh = *(const f32x4*)(shift + c0);
        f32x4 h = v[j] * rstd * gg * (sc + 1.f) + sh;
        u32x2 o; o.x = pk2(h.x, h.y); o.y = pk2(h.z, h.w);
        *(u32x2*)(H + (size_t)t * 1024 + c0) = o;
#pragma unroll
        for (int i = 0; i < 8; ++i) { const f32x4 w = *(const f32x4*)(wff + i * 1024 + c0); ff[i] += h.x * w.x + h.y * w.y + h.z * w.z + h.w * w.w; }
    }
#pragma unroll
    for (int i = 0; i < 8; ++i) ff[i] = wave_sum(ff[i]);
    if (lane < 8) {
        float z = 0.f;
#pragma unroll
        for (int i = 0; i < 8; ++i) z = (lane == i) ? ff[i] : z;
        z += bf[lane];
        logf[(size_t)t * 8 + lane] = fminf(z, 0.f) - log1pf(__expf(-fabsf(z)));
    }
}


__device__ __forceinline__ void row_pass(const float* __restrict__ x, const bf16_t* __restrict__ mix, const float* __restrict__ mod, const float* __restrict__ g_post, const float* __restrict__ g_pre, bf16_t* XB, bf16_t* H2, int t, int lane) {
    const int b = t / SEQ; const float* md = mod + b * 6144;
    f32x4 m[4], xv[4]; float s = 0.f;
#pragma unroll
    for (int j = 0; j < 4; ++j) { const int c0 = 256 * j + 4 * lane; const u32x2 w = *(const u32x2*)(mix + (size_t)t * 1024 + c0);
        m[j] = (f32x4){__uint_as_float(w.x << 16), __uint_as_float(w.x & 0xffff0000u), __uint_as_float(w.y << 16), __uint_as_float(w.y & 0xffff0000u)};
        s += m[j].x * m[j].x + m[j].y * m[j].y + m[j].z * m[j].z + m[j].w * m[j].w; }
    const float r1 = rsqrtf(wave_sum(s) * (1.f / 1024.f) + EPS);
    float s2 = 0.f;
#pragma unroll
    for (int j = 0; j < 4; ++j) { const int c0 = 256 * j + 4 * lane;
        xv[j] = *(const f32x4*)(x + (size_t)t * 1024 + c0) + *(const f32x4*)(md + 2048 + c0) * (m[j] * r1 * *(const f32x4*)(g_post + c0));
        { u32x2 xo; xo.x = pk2(xv[j].x, xv[j].y); xo.y = pk2(xv[j].z, xv[j].w); *(u32x2*)(XB + (size_t)t * 1024 + c0) = xo; }
        s2 += xv[j].x * xv[j].x + xv[j].y * xv[j].y + xv[j].z * xv[j].z + xv[j].w * xv[j].w; }
    const float r2 = rsqrtf(wave_sum(s2) * (1.f / 1024.f) + EPS);
#pragma unroll
    for (int j = 0; j < 4; ++j) { const int c0 = 256 * j + 4 * lane;
        const f32x4 h = xv[j] * r2 * *(const f32x4*)(g_pre + c0) * (*(const f32x4*)(md + 4096 + c0) + 1.f) + *(const f32x4*)(md + 3072 + c0);
        u32x2 o; o.x = pk2(h.x, h.y); o.y = pk2(h.z, h.w);
        *(u32x2*)(H2 + (size_t)t * 1024 + c0) = o; }
}

__device__ __forceinline__ float gelu_as(float v) {
    const float av = fabsf(v), t = __builtin_amdgcn_rcpf(av * 0.2316418882f + 1.0f);
    float q = t * 0.5307027145f + (-0.7265760135f); q = q * t + 0.7107068705f; q = q * t + (-0.142248368f); q = q * t + 0.127414796f; q = q * t;
    const float m = v * (q * __builtin_amdgcn_exp2f((v * v) * (-0.72134752044f)));
    return v < 0.f ? m : v - m;
}
constexpr int EB = 16;
__device__ __forceinline__ void expert_token(const unsigned char* __restrict__ UV, const float* __restrict__ US, const float* __restrict__ VS,
                                             const int* __restrict__ IDX, const float* __restrict__ GATE, const float* __restrict__ mod, const float* __restrict__ g_pre, const float* __restrict__ g_post,
                                             const bf16_t* __restrict__ xin, float* out, int t, int lane, int rmask) {
    const int b = t / SEQ; const float* md = mod + b * 6144;
    const int c0 = 16 * lane;
    float s2 = 0.f;
    float hv[16]; float mx = 0.f;
    {
    f32x4 x1[4];
#pragma unroll
    for (int j = 0; j < 4; ++j) { const u32x2 xw = *(const u32x2*)(xin + (size_t)t * 1024 + c0 + 4 * j);
        x1[j] = (f32x4){__uint_as_float(xw.x << 16), __uint_as_float(xw.x & 0xffff0000u), __uint_as_float(xw.y << 16), __uint_as_float(xw.y & 0xffff0000u)}; s2 += x1[j].x * x1[j].x + x1[j].y * x1[j].y + x1[j].z * x1[j].z + x1[j].w * x1[j].w; }
    const float r2 = rsqrtf(wave_sum(s2) * (1.f / 1024.f) + EPS);
#pragma unroll
    for (int j = 0; j < 4; ++j) { const f32x4 h = x1[j] * r2 * *(const f32x4*)(g_pre + c0 + 4 * j) * (*(const f32x4*)(md + 4096 + c0 + 4 * j) + 1.f) + *(const f32x4*)(md + 3072 + c0 + 4 * j);
        hv[4 * j] = h.x; hv[4 * j + 1] = h.y; hv[4 * j + 2] = h.z; hv[4 * j + 3] = h.w;
        mx = fmaxf(mx, fmaxf(fmaxf(fabsf(h.x), fabsf(h.y)), fmaxf(fabsf(h.z), fabsf(h.w)))); }
    }
    const int i0 = IDX[(size_t)t * 128 + lane] & rmask, i1 = IDX[(size_t)t * 128 + 64 + lane] & rmask;
    const float g0 = GATE[(size_t)t * 128 + lane], g1 = GATE[(size_t)t * 128 + 64 + lane];
    const float su0 = US[i0], su1 = US[i1], sv0 = VS[i0], sv1 = VS[i1];
    mx = wave_max(mx);
    const float sx = mx > 0.f ? mx / 127.f : 1.f, isx = 1.f / sx;
    int xq[4]; int xs = 0;
#pragma unroll
    for (int j = 0; j < 4; ++j) { const int q0 = (int)rintf(hv[4 * j] * isx), q1 = (int)rintf(hv[4 * j + 1] * isx), q2 = (int)rintf(hv[4 * j + 2] * isx), q3 = (int)rintf(hv[4 * j + 3] * isx);
        xs += q0 + q1 + q2 + q3;
        xq[j] = (int)((unsigned)(q0 & 255) | ((unsigned)(q1 & 255) << 8) | ((unsigned)(q2 & 255) << 16) | ((unsigned)(q3 & 255) << 24)); }
#pragma unroll
    for (int o = 1; o < 64; o <<= 1) xs += __shfl_xor(xs, o);
    const float xoff = 7.5f * (float)xs;
    const int el = ((lane >> 5) & 1) * 8 + ((lane >> 4) & 1) * 4 + ((lane >> 1) & 1) * 2 + (lane & 1);
    float acc[16];
#pragma unroll
    for (int i = 0; i < 16; ++i) acc[i] = 0.f;
    float sumc = 0.f;
    const unsigned lo16 = (unsigned)lane * 16u;
    u32x4 rb[EB];
#pragma unroll
    for (int e = 0; e < EB; ++e) { const unsigned row = (unsigned)__builtin_amdgcn_readlane(i0, e); rb[e] = *(const u32x4*)(UV + (row * 1024u + lo16)); }
#pragma unroll 1
    for (int bi = 0; bi < 128 / EB; ++bi) {
        u32x4 rn[EB];
        {
            const int nb = (bi + 1) & 7, srcn = (nb < 4) ? i0 : i1, ln = (nb & 3) * EB;
#pragma unroll
            for (int e = 0; e < EB; ++e) { const unsigned row = (unsigned)__builtin_amdgcn_readlane(srcn, ln + e); rn[e] = *(const u32x4*)(UV + (row * 1024u + lo16)); }
        }
        int d[EB];
#pragma unroll
        for (int e = 0; e < EB; ++e) { const unsigned w0 = rb[e].x, w1 = rb[e].y;
            int s = __builtin_amdgcn_sdot4(xq[0], (int)(w0 & 0x0F0F0F0Fu), 0, false); s = __builtin_amdgcn_sdot4(xq[1], (int)((w0 >> 4) & 0x0F0F0F0Fu), s, false);
            s = __builtin_amdgcn_sdot4(xq[2], (int)(w1 & 0x0F0F0F0Fu), s, false); d[e] = __builtin_amdgcn_sdot4(xq[3], (int)((w1 >> 4) & 0x0F0F0F0Fu), s, false); }
        int d8[8], d4[4], d2[2], d1;
#pragma unroll
        for (int k = 0; k < 8; ++k) { const auto r = __builtin_amdgcn_permlane32_swap((unsigned)d[k], (unsigned)d[8 + k], false, false); d8[k] = (int)(r[0] + r[1]); }
#pragma unroll
        for (int k = 0; k < 4; ++k) { const auto r = __builtin_amdgcn_permlane16_swap((unsigned)d8[k], (unsigned)d8[4 + k], false, false); d4[k] = (int)(r[0] + r[1]); }
        { const bool up = (lane & 2) != 0;
#pragma unroll
          for (int k = 0; k < 2; ++k) { const int keep = up ? d4[2 + k] : d4[k], give = up ? d4[k] : d4[2 + k]; d2[k] = keep + __builtin_amdgcn_update_dpp(0, give, 0x4E, 0xF, 0xF, false); } }
        { const bool up = (lane & 1) != 0; const int keep = up ? d2[1] : d2[0], give = up ? d2[0] : d2[1]; d1 = keep + __builtin_amdgcn_update_dpp(0, give, 0xB1, 0xF, 0xF, false); }
        d1 += __builtin_amdgcn_update_dpp(0, d1, 0x128, 0xF, 0xF, false);
        d1 += __builtin_amdgcn_update_dpp(0, d1, 0x124, 0xF, 0xF, false);
        const int ei = bi * EB + el;
        const int ba = (ei & 63) * 4;
        const float gsel = __uint_as_float((unsigned)__builtin_amdgcn_ds_bpermute(ba, (int)__float_as_uint((bi < 4) ? g0 : g1)));
        const float susel = __uint_as_float((unsigned)__builtin_amdgcn_ds_bpermute(ba, (int)__float_as_uint((bi < 4) ? su0 : su1)));
        const float svsel = __uint_as_float((unsigned)__builtin_amdgcn_ds_bpermute(ba, (int)__float_as_uint((bi < 4) ? sv0 : sv1)));
        const float aval = ((float)d1 - xoff) * sx * susel;
        const float cl = gsel * gelu_as(aval) * svsel;
#pragma unroll
        for (int e = 0; e < EB; ++e) {
            const float ce = __uint_as_float((unsigned)__builtin_amdgcn_readlane((int)__float_as_uint(cl), ((e >> 3) & 1) * 32 + ((e >> 2) & 1) * 16 + ((e >> 1) & 1) * 2 + (e & 1)));
            sumc += ce;
#pragma unroll
            for (int m = 0; m < 2; ++m) { const unsigned w = rb[e][2 + m], lo = w & 0x0F0F0F0Fu, hi = (w >> 4) & 0x0F0F0F0Fu;
                float f[8];
                asm("v_cvt_f32_ubyte0 %0, %1" : "=v"(f[0]) : "v"(lo)); asm("v_cvt_f32_ubyte1 %0, %1" : "=v"(f[1]) : "v"(lo)); asm("v_cvt_f32_ubyte2 %0, %1" : "=v"(f[2]) : "v"(lo)); asm("v_cvt_f32_ubyte3 %0, %1" : "=v"(f[3]) : "v"(lo));
                asm("v_cvt_f32_ubyte0 %0, %1" : "=v"(f[4]) : "v"(hi)); asm("v_cvt_f32_ubyte1 %0, %1" : "=v"(f[5]) : "v"(hi)); asm("v_cvt_f32_ubyte2 %0, %1" : "=v"(f[6]) : "v"(hi)); asm("v_cvt_f32_ubyte3 %0, %1" : "=v"(f[7]) : "v"(hi));
#pragma unroll
                for (int i = 0; i < 8; ++i) acc[8 * m + i] += ce * f[i]; }
        }
#pragma unroll
        for (int e = 0; e < EB; ++e) rb[e] = rn[e];
    }
    float sy = 0.f;
#pragma unroll
    for (int i = 0; i < 16; ++i) { acc[i] -= 7.5f * sumc; sy += acc[i] * acc[i]; }
    const float ry = rsqrtf(wave_sum(sy) * (1.f / 1024.f) + EPS);
#pragma unroll
    for (int j = 0; j < 4; ++j) { const f32x4 y = (f32x4){acc[4 * j], acc[4 * j + 1], acc[4 * j + 2], acc[4 * j + 3]};
        float* op = out + (size_t)t * 1024 + c0 + 4 * j;
        const u32x2 xw = *(const u32x2*)(xin + (size_t)t * 1024 + c0 + 4 * j);
        *(f32x4*)op = (f32x4){__uint_as_float(xw.x << 16), __uint_as_float(xw.x & 0xffff0000u), __uint_as_float(xw.y << 16), __uint_as_float(xw.y & 0xffff0000u)} + *(const f32x4*)(md + 5120 + c0 + 4 * j) * (y * ry * *(const f32x4*)(g_post + c0 + 4 * j)); }
}

#define CE_DESC(a, b) do { const float _t = fmaxf(a, b); b = fminf(a, b); a = _t; } while (0)
__device__ __forceinline__ void sort16_desc(float (&v)[16]) {
#pragma unroll
    for (int k = 2; k <= 16; k <<= 1)
#pragma unroll
        for (int j = k >> 1; j > 0; j >>= 1)
#pragma unroll
            for (int i = 0; i < 16; ++i) { const int l = i ^ j; if (l > i) { if ((i & k) == 0 || k == 16) CE_DESC(v[i], v[l]); else CE_DESC(v[l], v[i]); } }
}
__device__ __forceinline__ void merge16_desc(float (&a)[16], const float (&b)[16]) {
#pragma unroll
    for (int i = 0; i < 16; ++i) a[i] = fmaxf(a[i], b[15 - i]);
#pragma unroll
    for (int j = 8; j > 0; j >>= 1)
#pragma unroll
        for (int i = 0; i < 16; ++i) { const int l = i ^ j; if (l > i) CE_DESC(a[i], a[l]); }
}
#define CE2_DESC(va, pa, vb, pb) do { const bool _c = (va) >= (vb); const float _tv = _c ? (va) : (vb), _tw = _c ? (vb) : (va); const int _tp = _c ? (pa) : (pb), _tq = _c ? (pb) : (pa); va = _tv; vb = _tw; pa = _tp; pb = _tq; } while (0)
template <int N> __device__ __forceinline__ void bitonic_merge_desc2(float (&v)[N], int (&p)[N]) {
#pragma unroll
    for (int j = N / 2; j > 0; j >>= 1)
#pragma unroll
        for (int i = 0; i < N; ++i) { const int l = i ^ j; if (l > i) CE2_DESC(v[i], p[i], v[l], p[l]); }
}
__device__ __forceinline__ void merge16_desc2(float (&a)[16], int (&pa)[16], const float (&b)[16], const int (&pb)[16]) {
#pragma unroll
    for (int i = 0; i < 16; ++i) { const bool c = a[i] >= b[15 - i]; pa[i] = c ? pa[i] : pb[15 - i]; a[i] = c ? a[i] : b[15 - i]; }
    bitonic_merge_desc2<16>(a, pa);
}
__device__ __forceinline__ void sort8_desc2(float (&v)[8], int (&p)[8]) {
#pragma unroll
    for (int k = 2; k <= 8; k <<= 1)
#pragma unroll
        for (int j = k >> 1; j > 0; j >>= 1)
#pragma unroll
            for (int i = 0; i < 8; ++i) { const int l = i ^ j; if (l > i) { if ((i & k) == 0 || k == 8) CE2_DESC(v[i], p[i], v[l], p[l]); else CE2_DESC(v[l], p[l], v[i], p[i]); } }
}
constexpr int RT_KROW = 272;
__device__ __forceinline__ void route_half(float (&top)[16], LAS const unsigned char* keys_lds, const bf16_t* __restrict__ qrow, int r32, int hi) {
    bf16x8 qf[8]; float ss = 0.f;
#pragma unroll
    for (int ks = 0; ks < 8; ++ks) { qf[ks] = *(const bf16x8*)(qrow + 16 * ks + 8 * hi);
#pragma unroll
        for (int j = 0; j < 8; ++j) { const float f = bf2f((bf16_t)qf[ks][j]); ss += f * f; } }
    ss += __shfl_xor(ss, 32);
    const float rn = rsqrtf(ss * (1.f / 128.f) + EPS);
    f32x16 acc[4];
#pragma unroll
    for (int kt = 0; kt < 4; ++kt) {
#pragma unroll
        for (int r = 0; r < 16; ++r) acc[kt][r] = 0.f;
#pragma unroll
        for (int ks = 0; ks < 8; ++ks) { const bf16x8 kf = *(LAS const bf16x8*)(keys_lds + (32 * kt + r32) * RT_KROW + (16 * ks + 8 * hi) * 2);
            acc[kt] = __builtin_amdgcn_mfma_f32_32x32x16_bf16(kf, qf[ks], acc[kt], 0, 0, 0); }
        __builtin_amdgcn_sched_barrier(0);
    }
    const unsigned hi4 = (unsigned)hi << 2;
    float g[4][16];
#pragma unroll
    for (int kt = 0; kt < 4; ++kt)
#pragma unroll
        for (int r = 0; r < 16; ++r) { const unsigned base = (unsigned)(32 * kt + (r & 3) + 8 * (r >> 2)); g[kt][r] = __uint_as_float((__float_as_uint(acc[kt][r] * rn) & 0xFFFFFF80u) | base); }
#pragma unroll
    for (int kt = 0; kt < 4; ++kt) sort16_desc(g[kt]);
    merge16_desc(g[0], g[1]); merge16_desc(g[2], g[3]); merge16_desc(g[0], g[2]);
    float o[16];
#pragma unroll
    for (int i = 0; i < 16; ++i) { g[0][i] = __uint_as_float(__float_as_uint(g[0][i]) | hi4); o[i] = __shfl_xor(g[0][i], 32); }
    merge16_desc(g[0], o);
#pragma unroll
    for (int i = 0; i < 16; ++i) top[i] = g[0][i];
}
__device__ __forceinline__ void route_final(const float (&A)[16], const float (&B)[16], LAS unsigned char* tab, int* idx_out, float* gate_out, bool writer) {
    {
        unsigned w[8];
#pragma unroll
        for (int q = 0; q < 4; ++q) {
            w[q] = (__float_as_uint(A[4 * q]) & 127u) | ((__float_as_uint(A[4 * q + 1]) & 127u) << 8) | ((__float_as_uint(A[4 * q + 2]) & 127u) << 16) | ((__float_as_uint(A[4 * q + 3]) & 127u) << 24);
            w[4 + q] = (__float_as_uint(B[4 * q]) & 127u) | ((__float_as_uint(B[4 * q + 1]) & 127u) << 8) | ((__float_as_uint(B[4 * q + 2]) & 127u) << 16) | ((__float_as_uint(B[4 * q + 3]) & 127u) << 24);
        }
        *(LAS u32x4*)(tab) = (u32x4){w[0], w[1], w[2], w[3]}; *(LAS u32x4*)(tab + 16) = (u32x4){w[4], w[5], w[6], w[7]};
    }
    const float NEG = -INFINITY;
#define CAND(i, j) __uint_as_float((__float_as_uint(A[i] + B[j]) & 0xFFFFFF00u) | (unsigned)(((i) << 4) | (j)))
    float m1[16], m2[16], m3[16];
#pragma unroll
    for (int j = 0; j < 16; ++j) m1[j] = CAND(0, j);
#pragma unroll
    for (int i = 0; i < 16; ++i) m2[i] = (i < 15) ? CAND((i < 15 ? i + 1 : 0), 0) : NEG;
    merge16_desc(m1, m2);
    __builtin_amdgcn_sched_barrier(0);
#pragma unroll
    for (int j = 0; j < 16; ++j) m3[j] = (j < 7) ? CAND(1, (j < 7 ? j + 1 : 0)) : NEG;
#pragma unroll
    for (int i = 0; i < 16; ++i) m2[i] = (i < 6) ? CAND((i < 6 ? i + 2 : 0), 1) : NEG;
    merge16_desc(m3, m2);
    __builtin_amdgcn_sched_barrier(0);
    m2[0] = CAND(2, 2); m2[1] = CAND(2, 3); m2[2] = CAND(2, 4); m2[3] = CAND(3, 2); m2[4] = CAND(4, 2); m2[5] = CAND(3, 3);
#pragma unroll
    for (int i = 6; i < 16; ++i) m2[i] = NEG;
    sort16_desc(m2);
    merge16_desc(m3, m2);
    merge16_desc(m1, m3);
    __builtin_amdgcn_sched_barrier(0);
#undef CAND
    float e[16], den = 0.f; int ex[16];
#pragma unroll
    for (int i = 0; i < 16; ++i) { e[i] = __expf(m1[i] - m1[0]); den += e[i]; const unsigned r = __float_as_uint(m1[i]) & 255u; ex[i] = (int)tab[r >> 4] * 128 + (int)tab[16 + (r & 15u)]; }
    const float inv = 1.f / den;
    if (writer) {
#pragma unroll
        for (int i = 0; i < 4; ++i) { *(u32x4*)(idx_out + 4 * i) = (u32x4){(unsigned)ex[4 * i], (unsigned)ex[4 * i + 1], (unsigned)ex[4 * i + 2], (unsigned)ex[4 * i + 3]};
            *(f32x4*)(gate_out + 4 * i) = (f32x4){e[4 * i] * inv, e[4 * i + 1] * inv, e[4 * i + 2] * inv, e[4 * i + 3] * inv}; }
    }
}

namespace fa {
typedef short s16x4 __attribute__((ext_vector_type(4)));
constexpr int SLOT_V = 8192, SLOT_F = 16384, SLOT_BYTES = 16384 + 256;
constexpr int LDS_WS = 2 * SLOT_BYTES, LDS_OST = LDS_WS + 8 * 64 * 4, LDS_TOTAL = LDS_OST + 8 * 4096;
__device__ __forceinline__ int crow(int r, int hi) { return (r & 3) + 8 * (r >> 2) + 4 * hi; }
__device__ __forceinline__ void attn_unit(LAS unsigned char* lds, const bf16_t* __restrict__ PROJ, const float* __restrict__ F2T, bf16_t* OCAT, int b, int h, int qb, float kmax) {
    const int tid = ptid(), lane = tid & 63, r32 = lane & 31, hi = lane >> 5; const int wid = __builtin_amdgcn_readfirstlane(tid >> 6);
    const size_t rowbase = (size_t)b * SEQ; const int q0 = qb * 256;
    const bf16_t* Qw = PROJ + (rowbase + q0 + wid * 32) * NPROJ + C_Q + h * 64;
    const bf16_t* Kh = PROJ + rowbase * NPROJ + C_K + h * 64;
    const bf16_t* Vh = PROJ + rowbase * NPROJ + C_V + h * 64;
    const float* Fh = F2T + (size_t)(b * 8 + h) * SEQ;
    LAS float* wsf = (LAS float*)(lds + LDS_WS) + wid * 64;
    bf16x8 qr[4];
#pragma unroll
    for (int d0 = 0; d0 < 4; ++d0) qr[d0] = *(const bf16x8*)(Qw + (size_t)r32 * NPROJ + d0 * 16 + hi * 8);
    const float Fq = Fh[q0 + wid * 32 + r32];
    const int NT = 4 * qb + 4;
    int t0; float c0;
    {
        float qs = 0.f;
#pragma unroll
        for (int d0 = 0; d0 < 4; ++d0)
#pragma unroll
            for (int j = 0; j < 8; ++j) { const float f = bf2f((bf16_t)qr[d0][j]); qs += f * f; }
        qs += __shfl_xor(qs, 32);
        qs = wave_max(qs);
        if (lane == 0) wsf[0] = qs;
        __syncthreads();
        float qm = 0.f;
#pragma unroll
        for (int w = 0; w < 8; ++w) qm = fmaxf(qm, ((LAS float*)(lds + LDS_WS))[w * 64]);
        c0 = sqrtf(qm) * kmax;
        const float bound = 2.f * c0 + Fh[q0] + 40.f;
        const bool skip = (lane < NT - 4) && (bound - Fh[64 * lane + 63] < 0.f);
        const unsigned long long bal = __ballot(skip);
        t0 = __builtin_amdgcn_readfirstlane((int)__builtin_ctzll(~bal));
        __syncthreads();
    }
    const bf16_t* ksrc = Kh + (size_t)lane * NPROJ + wid * 8;
    const bf16_t* vsrc = Vh + (size_t)(16 * (wid & 3) + (lane >> 2)) * NPROJ + (wid >> 2) * 32 + (lane & 3) * 8;
    const int sdst = wid * 1024 + lane * 16;
    u32x4 kreg = *(const u32x4*)(ksrc + (size_t)t0 * 64 * NPROJ), vreg = *(const u32x4*)(vsrc + (size_t)t0 * 64 * NPROJ);
    float freg = (wid == 0) ? Fh[t0 * 64 + lane] : 0.f;
    *(LAS u32x4*)(lds + sdst) = kreg; *(LAS u32x4*)(lds + SLOT_V + sdst) = vreg; if (wid == 0) *(LAS float*)(lds + SLOT_F + lane * 4) = freg;
    if (t0 + 1 < NT) { kreg = *(const u32x4*)(ksrc + (size_t)(t0 + 1) * 64 * NPROJ); vreg = *(const u32x4*)(vsrc + (size_t)(t0 + 1) * 64 * NPROJ); if (wid == 0) freg = Fh[(t0 + 1) * 64 + lane]; }
    __syncthreads();
    float l = 0.f; f32x16 o[2]; const float Fqs = Fq - c0;
#pragma unroll
    for (int r = 0; r < 16; ++r) { o[0][r] = 0.f; o[1][r] = 0.f; }
    const int qrel = wid * 32 + r32;
    int cur = 0;
    for (int t = t0; t < NT; ++t) {
        const bool more = (t + 1 < NT);
        u32x4 kreg2 = kreg, vreg2 = vreg; float freg2 = freg;
        if (t + 2 < NT) { kreg2 = *(const u32x4*)(ksrc + (size_t)(t + 2) * 64 * NPROJ); vreg2 = *(const u32x4*)(vsrc + (size_t)(t + 2) * 64 * NPROJ); if (wid == 0) freg2 = Fh[(t + 2) * 64 + lane]; }
        LAS unsigned char* slot = lds + cur * SLOT_BYTES;
        f32x16 p0, p1;
        { const LAS float* fk = (const LAS float*)(slot + SLOT_F);
#pragma unroll
          for (int g = 0; g < 4; ++g) { const f32x4 a = *(const LAS f32x4*)(fk + 8 * g + 4 * hi), c = *(const LAS f32x4*)(fk + 32 + 8 * g + 4 * hi);
#pragma unroll
              for (int i = 0; i < 4; ++i) { p0[4 * g + i] = Fqs - a[i]; p1[4 * g + i] = Fqs - c[i]; } } }
        { const LAS unsigned char* kb = slot + hi * 1024 + r32 * 16;
#pragma unroll
          for (int d0 = 0; d0 < 4; ++d0) { const bf16x8 b0 = *(const LAS bf16x8*)(kb + d0 * 2048), b1 = *(const LAS bf16x8*)(kb + d0 * 2048 + 512);
              p0 = __builtin_amdgcn_mfma_f32_32x32x16_bf16(b0, qr[d0], p0, 0, 0, 0); p1 = __builtin_amdgcn_mfma_f32_32x32x16_bf16(b1, qr[d0], p1, 0, 0, 0); } }
        const int jb = t - (NT - 4);
        if (jb >= 0) { const int kb0 = 64 * jb + 4 * hi;
#pragma unroll
            for (int r = 0; r < 16; ++r) { const int kv = kb0 + (r & 3) + 8 * (r >> 2); if (kv > qrel) p0[r] = -INFINITY; if (kv + 32 > qrel) p1[r] = -INFINITY; } }
        float rs = 0.f;
#pragma unroll
        for (int r = 0; r < 16; ++r) { p0[r] = exp2f(p0[r]); p1[r] = exp2f(p1[r]); rs += p0[r] + p1[r]; }
        l += rs;
        u32x4 pw0, pw1, pw2, pw3;
        pw0 = (u32x4){cvt_pk_bf16(p0[0], p0[1]), cvt_pk_bf16(p0[2], p0[3]), cvt_pk_bf16(p0[4], p0[5]), cvt_pk_bf16(p0[6], p0[7])};
        pw1 = (u32x4){cvt_pk_bf16(p0[8], p0[9]), cvt_pk_bf16(p0[10], p0[11]), cvt_pk_bf16(p0[12], p0[13]), cvt_pk_bf16(p0[14], p0[15])};
        pw2 = (u32x4){cvt_pk_bf16(p1[0], p1[1]), cvt_pk_bf16(p1[2], p1[3]), cvt_pk_bf16(p1[4], p1[5]), cvt_pk_bf16(p1[6], p1[7])};
        pw3 = (u32x4){cvt_pk_bf16(p1[8], p1[9]), cvt_pk_bf16(p1[10], p1[11]), cvt_pk_bf16(p1[12], p1[13]), cvt_pk_bf16(p1[14], p1[15])};
        { const int vb = (int)(unsigned)(size_t)(slot + SLOT_V) + ((lane >> 4) & 1) * 32 + (lane & 3) * 8 + (4 * hi + ((lane & 15) >> 2)) * 64;
#pragma unroll
          for (int d0 = 0; d0 < 2; ++d0) { s16x4 lo4[4], hi4[4];
#pragma unroll
              for (int ks = 0; ks < 4; ++ks) {
                  asm volatile("ds_read_b64_tr_b16 %0,%1 offset:%c2" : "=&v"(lo4[ks]) : "v"(vb), "i"(d0 * 4096 + ks * 1024) : "memory");
                  asm volatile("ds_read_b64_tr_b16 %0,%1 offset:%c2" : "=&v"(hi4[ks]) : "v"(vb), "i"(d0 * 4096 + ks * 1024 + 512) : "memory"); }
              asm volatile("s_waitcnt lgkmcnt(0)" ::: "memory"); __builtin_amdgcn_sched_barrier(0);
#define FA_PK(k) (bf16x8){lo4[k][0], lo4[k][1], lo4[k][2], lo4[k][3], hi4[k][0], hi4[k][1], hi4[k][2], hi4[k][3]}
              o[d0] = __builtin_amdgcn_mfma_f32_32x32x16_bf16(__builtin_bit_cast(bf16x8, pw0), FA_PK(0), o[d0], 0, 0, 0);
              o[d0] = __builtin_amdgcn_mfma_f32_32x32x16_bf16(__builtin_bit_cast(bf16x8, pw1), FA_PK(1), o[d0], 0, 0, 0);
              o[d0] = __builtin_amdgcn_mfma_f32_32x32x16_bf16(__builtin_bit_cast(bf16x8, pw2), FA_PK(2), o[d0], 0, 0, 0);
              o[d0] = __builtin_amdgcn_mfma_f32_32x32x16_bf16(__builtin_bit_cast(bf16x8, pw3), FA_PK(3), o[d0], 0, 0, 0);
#undef FA_PK
          } }
        if (more) { LAS unsigned char* nslot = lds + (cur ^ 1) * SLOT_BYTES;
            *(LAS u32x4*)(nslot + sdst) = kreg; *(LAS u32x4*)(nslot + SLOT_V + sdst) = vreg; if (wid == 0) *(LAS float*)(nslot + SLOT_F + lane * 4) = freg; }
        __syncthreads();
        cur ^= 1; kreg = kreg2; vreg = vreg2; freg = freg2;
    }
    l += __shfl_xor(l, 32);
    if (hi == 0) wsf[32 + r32] = l;
    asm volatile("s_waitcnt lgkmcnt(0)" ::: "memory");
    float rli[16];
#pragma unroll
    for (int r = 0; r < 16; ++r) rli[r] = 1.f / wsf[32 + crow(r, hi)];
    bf16_t* Ow = OCAT + (rowbase + q0 + wid * 32) * 1024 + h * 64;
    LAS bf16_t* stg = (LAS bf16_t*)(lds + LDS_OST) + wid * 2048;
#pragma unroll
    for (int r = 0; r < 16; ++r) { const int orow = crow(r, hi);
#pragma unroll
        for (int d0 = 0; d0 < 2; ++d0) stg[orow * 64 + d0 * 32 + r32] = f2bf(o[d0][r] * rli[r]); }
    asm volatile("s_waitcnt lgkmcnt(0)" ::: "memory");
#pragma unroll
    for (int i = 0; i < 4; ++i) { const int row = i * 8 + (lane >> 3), ch = lane & 7; const u32x4 v = *(const LAS u32x4*)(stg + row * 64 + ch * 8); *(u32x4*)(Ow + (size_t)row * 1024 + ch * 8) = v; }
    __syncthreads();
}
}

namespace hg {
constexpr int P272 = 272, P144 = 144;
constexpr int L_SEGT = 0, L_RAW = 2048, L_RLF = L_RAW, L_RQ = L_RAW + 16384, L_RKK = L_RAW + 32768, L_RI = L_RAW + 49152;
constexpr int L_QJ = 2048, L_KH = L_QJ + 160 * P272;
constexpr int L_KT = L_RI + 64 * P272, L_IT = L_KT + 128 * P144, L_P = L_IT + 128 * P144, L_END = L_P + 64 * P144;
static_assert(L_KH + 64 * P272 <= L_KT && L_END <= RING_BYTES, "hgrn LDS");
__device__ __forceinline__ int crow(int r, int hi) { return (r & 3) + 8 * (r >> 2) + 4 * hi; }
__device__ __forceinline__ int qj_row0(int j) { return (j == 0) ? 0 : (j == 1) ? 64 : (j == 2) ? 112 : 144; }
struct RawRegs { u32x4 lf[2], q[2], kk[2], iv[2]; };
__device__ __forceinline__ void raw_load(RawRegs& R, const bf16_t* __restrict__ PROJ, const bf16_t* __restrict__ KK, int unit, int tid) {
    const int bh = unit >> 6, cch = unit & 63, b = bh >> 2, h = bh & 3; const size_t row0 = (size_t)b * SEQ + cch * 64;
#pragma unroll
    for (int it = 0; it < 2; ++it) { const int id = tid + 512 * it, t = id >> 4, ch = id & 15;
        const bf16_t* pr = PROJ + (row0 + t) * NPROJ + h * 128 + 8 * ch;
        R.lf[it] = *(const u32x4*)(pr + C_LF); R.q[it] = *(const u32x4*)(pr + C_HQ); R.iv[it] = *(const u32x4*)(pr + C_HI);
        R.kk[it] = *(const u32x4*)(KK + (row0 + t) * 512 + h * 128 + 8 * ch); }
}
template <bool DRY> __device__ __forceinline__ void pass_a_all(LAS unsigned char* lds, bf16_t* PROJ, const bf16_t* __restrict__ KK, bf16_t* HST, float* HD, int u0, int ustep, int uend) {
    const int tid = ptid(), lane = tid & 63, r32 = lane & 31, hi = lane >> 5; const int wid = __builtin_amdgcn_readfirstlane(tid >> 6);
    const int k = tid & 127, seg = tid >> 7;
    LAS float* segt = (LAS float*)(lds + L_SEGT);
    RawRegs R;
    if (u0 < uend) raw_load(R, PROJ, KK, u0, tid);
    for (int unit = u0; unit < uend; unit += ustep) {
        const int bh = unit >> 6, cch = unit & 63, b = bh >> 2, h = bh & 3;
        const size_t row0 = (size_t)b * SEQ + cch * 64;
#pragma unroll
        for (int it = 0; it < 2; ++it) { const int id = tid + 512 * it, t = id >> 4, ch = id & 15;
            *(LAS u32x4*)(lds + L_RLF + t * 256 + ch * 16) = R.lf[it]; *(LAS u32x4*)(lds + L_RQ + t * 256 + ch * 16) = R.q[it];
            *(LAS u32x4*)(lds + L_RKK + t * 256 + ch * 16) = R.kk[it]; *(LAS u32x4*)(lds + L_RI + t * P272 + ch * 16) = R.iv[it]; }
        __syncthreads();
        if (unit + ustep < uend) raw_load(R, PROJ, KK, unit + ustep, tid);
        float Aa[16], qv[16], kv[16];
        { float run = 0.f;
#pragma unroll
          for (int i = 0; i < 16; ++i) { const int off = (16 * seg + i) * 256 + k * 2;
              run += h2f(*(const LAS unsigned short*)(lds + L_RLF + off)); Aa[i] = run; qv[i] = bf2f(*(const LAS bf16_t*)(lds + L_RQ + off)); kv[i] = bf2f(*(const LAS bf16_t*)(lds + L_RKK + off)); }
          segt[seg * 128 + k] = run; }
#pragma unroll
        for (int it = 0; it < 2; ++it) { const int vc = 2 * wid + it;
            const bf16x8 v8 = *(const LAS bf16x8*)(lds + L_RI + lane * P272 + vc * 16);
#pragma unroll
            for (int e = 0; e < 8; ++e) *(LAS bf16_t*)(lds + L_IT + (8 * vc + e) * P144 + lane * 2) = (bf16_t)v8[e]; }
        __syncthreads();
        float E[4];
        { float s = 0.f;
#pragma unroll
          for (int j = 0; j < 4; ++j) { s += segt[j * 128 + k]; E[j] = s; } }
        const float pre = (seg == 0) ? 0.f : (seg == 1) ? E[0] : (seg == 2) ? E[1] : E[2];
        const float Eown = (seg == 0) ? E[0] : (seg == 1) ? E[1] : (seg == 2) ? E[2] : E[3];
        {
            bf16_t* pq = PROJ + (row0 + 16 * seg) * NPROJ + C_HQ + h * 128 + k;
            unsigned kt[8];
            float fj[4];
#pragma unroll
            for (int j = 0; j < 4; ++j) fj[j] = __expf(Eown - E[j]);
            const float f0 = __expf(Eown), f3 = __expf(E[3] - Eown);
#pragma unroll
            for (int i = 0; i < 16; ++i) {
                const float A = pre + Aa[i]; const int t = 16 * seg + i;
                const float e1 = __expf(A - Eown), r1 = __builtin_amdgcn_rcpf(e1);
                const float qe = qv[i] * e1, ke1 = kv[i] * r1;
                if (!DRY) pq[(size_t)i * NPROJ] = f2bf(qe * f0);
#pragma unroll
                for (int j = 0; j < 4; ++j) if (j <= seg) *(LAS bf16_t*)(lds + L_QJ + (qj_row0(j) + t - 16 * j) * P272 + k * 2) = f2bf(j == seg ? qe : qe * fj[j]);
                *(LAS bf16_t*)(lds + L_KH + t * P272 + k * 2) = f2bf(ke1);
                const unsigned ke = f2bf(ke1 * f3);
                if (i & 1) kt[i >> 1] |= ke << 16; else kt[i >> 1] = ke;
            }
            *(LAS u32x4*)(lds + L_KT + k * P144 + seg * 32) = (u32x4){kt[0], kt[1], kt[2], kt[3]};
            *(LAS u32x4*)(lds + L_KT + k * P144 + seg * 32 + 16) = (u32x4){kt[4], kt[5], kt[6], kt[7]};
            if (seg == 0) HD[(size_t)unit * 128 + k] = __expf(E[3]);
        }
        __syncthreads();
        {
            const int fr = lane & 15, fq = lane >> 4;
#pragma unroll
            for (int bb = 0; bb < 2; ++bb) {
                const int blk = 2 * wid + bb, bi = blk >> 2, bj = blk & 3;
                f32x4 acc = (f32x4){0.f, 0.f, 0.f, 0.f};
                if (bj <= bi) {
                    const LAS unsigned char* ap = lds + L_QJ + (qj_row0(bj) + 16 * (bi - bj) + fr) * P272 + fq * 16;
                    const LAS unsigned char* bp = lds + L_KH + (16 * bj + fr) * P272 + fq * 16;
#pragma unroll
                    for (int s = 0; s < 4; ++s) acc = __builtin_amdgcn_mfma_f32_16x16x32_bf16(*(const LAS bf16x8*)(ap + s * 64), *(const LAS bf16x8*)(bp + s * 64), acc, 0, 0, 0);
                }
#pragma unroll
                for (int r = 0; r < 4; ++r) { const int tl = 4 * fq + r; float v = acc[r]; if (bi == bj && fr > tl) v = 0.f;
                    *(LAS bf16_t*)(lds + L_P + (16 * bi + tl) * P144 + (16 * bj + fr) * 2) = f2bf(v); }
            }
        }
        __syncthreads();
        {
            const int vt = wid & 3, tt = wid >> 2;
            f32x16 acc;
#pragma unroll
            for (int r = 0; r < 16; ++r) acc[r] = 0.f;
#pragma unroll
            for (int ks = 0; ks < 4; ++ks) acc = __builtin_amdgcn_mfma_f32_32x32x16_bf16(*(const LAS bf16x8*)(lds + L_IT + (32 * vt + r32) * P144 + (16 * ks + 8 * hi) * 2), *(const LAS bf16x8*)(lds + L_P + (32 * tt + r32) * P144 + (16 * ks + 8 * hi) * 2), acc, 0, 0, 0);
            bf16_t* po = PROJ + (row0 + 32 * tt + r32) * NPROJ + C_LF + h * 128 + 32 * vt + 4 * hi;
#pragma unroll
            for (int g = 0; g < 4; ++g) { u32x2 w; w.x = cvt_pk_bf16(acc[4 * g], acc[4 * g + 1]); w.y = cvt_pk_bf16(acc[4 * g + 2], acc[4 * g + 3]); if (!DRY) *(u32x2*)(po + 8 * g) = w; }
        }
        {
            const int kt_ = wid & 3;
#pragma unroll
            for (int vv = 0; vv < 2; ++vv) { const int vt = 2 * (wid >> 2) + vv;
                f32x16 acc;
#pragma unroll
                for (int r = 0; r < 16; ++r) acc[r] = 0.f;
#pragma unroll
                for (int ks = 0; ks < 4; ++ks) acc = __builtin_amdgcn_mfma_f32_32x32x16_bf16(*(const LAS bf16x8*)(lds + L_KT + (32 * kt_ + r32) * P144 + (16 * ks + 8 * hi) * 2), *(const LAS bf16x8*)(lds + L_IT + (32 * vt + r32) * P144 + (16 * ks + 8 * hi) * 2), acc, 0, 0, 0);
                bf16_t* pu = HST + (size_t)unit * 16384 + (32 * vt + r32) * 128 + 32 * kt_ + 4 * hi;
#pragma unroll
                for (int g = 0; g < 4; ++g) { u32x2 w; w.x = cvt_pk_bf16(acc[4 * g], acc[4 * g + 1]); w.y = cvt_pk_bf16(acc[4 * g + 2], acc[4 * g + 3]); *(u32x2*)(pu + 8 * g) = w; } }
        }
        __syncthreads();
    }
}
__device__ __forceinline__ void pass_b(bf16_t* HST, const float* __restrict__ HD, int grp) {
    const int bh = grp >> 12, rem = grp & 4095;
    float s0 = 0.f, s1 = 0.f, s2 = 0.f, s3 = 0.f;
    bf16_t* p = HST + (size_t)bh * 64 * 16384 + rem * 4;
    const float* pd = HD + (size_t)bh * 64 * 128 + (rem & 31) * 4;
#pragma unroll 8
    for (int cch = 0; cch < 64; ++cch) {
        const u32x2 u = *(const u32x2*)(p + (size_t)cch * 16384); const f32x4 d = *(const f32x4*)(pd + cch * 128);
        u32x2 w; w.x = pk2(s0, s1); w.y = pk2(s2, s3); *(u32x2*)(p + (size_t)cch * 16384) = w;
        s0 = d.x * s0 + __uint_as_float(u.x << 16); s1 = d.y * s1 + __uint_as_float(u.x & 0xffff0000u);
        s2 = d.z * s2 + __uint_as_float(u.y << 16); s3 = d.w * s3 + __uint_as_float(u.y & 0xffff0000u);
    }
}
struct CRegs { bf16x8 a[8], b[8]; u32x2 oi[4], sg[4]; };
__device__ __forceinline__ void c_load(CRegs& R, const bf16_t* __restrict__ PROJ, const bf16_t* __restrict__ HST, int unit, int vt, int tt, int r32, int hi) {
    const int bh = unit >> 6, cch = unit & 63, b = bh >> 2, h = bh & 3; const size_t row0 = (size_t)b * SEQ + cch * 64;
    const bf16_t* pa = HST + (size_t)unit * 16384 + (32 * vt + r32) * 128 + 8 * hi;
    const bf16_t* prow = PROJ + (row0 + 32 * tt + r32) * NPROJ + h * 128;
#pragma unroll
    for (int ks = 0; ks < 8; ++ks) { R.a[ks] = *(const bf16x8*)(pa + 16 * ks); R.b[ks] = *(const bf16x8*)(prow + C_HQ + 16 * ks + 8 * hi); }
#pragma unroll
    for (int g = 0; g < 4; ++g) { R.oi[g] = *(const u32x2*)(prow + C_LF + 32 * vt + 4 * hi + 8 * g); R.sg[g] = *(const u32x2*)(prow + C_SG + 32 * vt + 4 * hi + 8 * g); }
}
__device__ __forceinline__ void pass_c_all(LAS unsigned char* lds, const bf16_t* __restrict__ PROJ, const bf16_t* __restrict__ HST, const float* __restrict__ gn, bf16_t* OCAT, int u0, int ustep, int uend) {
    const int tid = ptid(), lane = tid & 63, r32 = lane & 31, hi = lane >> 5; const int wid = __builtin_amdgcn_readfirstlane(tid >> 6);
    const int vt = wid & 3, tt = wid >> 2, tl = 32 * tt + r32;
    LAS float* part = (LAS float*)lds;
    CRegs R;
    if (u0 < uend) c_load(R, PROJ, HST, u0, vt, tt, r32, hi);
    int par = 0;
    for (int unit = u0; unit < uend; unit += ustep, par ^= 1) {
        const int bh = unit >> 6, cch = unit & 63, b = bh >> 2, h = bh & 3;
        const size_t row0 = (size_t)b * SEQ + cch * 64;
        f32x16 acc;
#pragma unroll
        for (int g = 0; g < 4; ++g) { const u32x2 w = R.oi[g]; acc[4 * g] = __uint_as_float(w.x << 16); acc[4 * g + 1] = __uint_as_float(w.x & 0xffff0000u); acc[4 * g + 2] = __uint_as_float(w.y << 16); acc[4 * g + 3] = __uint_as_float(w.y & 0xffff0000u); }
#pragma unroll
        for (int ks = 0; ks < 8; ++ks) acc = __builtin_amdgcn_mfma_f32_32x32x16_bf16(R.a[ks], R.b[ks], acc, 0, 0, 0);
        u32x2 sgv[4];
#pragma unroll
        for (int g = 0; g < 4; ++g) sgv[g] = R.sg[g];
        if (unit + ustep < uend) c_load(R, PROJ, HST, unit + ustep, vt, tt, r32, hi);
        float ss = 0.f;
#pragma unroll
        for (int r = 0; r < 16; ++r) ss += acc[r] * acc[r];
        ss += __shfl_xor(ss, 32);
        LAS float* pp = part + par * 256;
        if (hi == 0) pp[vt * 64 + tl] = ss;
        __syncthreads();
        const float rn = rsqrtf((pp[tl] + pp[64 + tl] + pp[128 + tl] + pp[192 + tl]) * (1.f / 128.f) + EPS);
        const float* pg = gn + h * 128 + 32 * vt + 4 * hi;
        bf16_t* po = OCAT + (row0 + tl) * 1024 + 512 + h * 128 + 32 * vt + 4 * hi;
#pragma unroll
        for (int g = 0; g < 4; ++g) { const u32x2 sw = sgv[g]; const f32x4 gv = *(const f32x4*)(pg + 8 * g);
            u32x2 w; w.x = cvt_pk_bf16(acc[4 * g] * rn * gv.x * __uint_as_float(sw.x << 16), acc[4 * g + 1] * rn * gv.y * __uint_as_float(sw.x & 0xffff0000u));
            w.y = cvt_pk_bf16(acc[4 * g + 2] * rn * gv.z * __uint_as_float(sw.y << 16), acc[4 * g + 3] * rn * gv.w * __uint_as_float(sw.y & 0xffff0000u));
            *(u32x2*)(po + 8 * g) = w; }
    }
    __syncthreads();
}
}

__global__ void __launch_bounds__(NTHREADS, 2) mega(Args a) {
    extern __shared__ __attribute__((aligned(16))) unsigned char lds_raw[];
    LAS unsigned char* lds = (LAS unsigned char*)lds_raw;
    volatile LAS unsigned* MISC = (volatile LAS unsigned*)(lds + MISC_OFF);
    const int tid0 = threadIdx.x, wave = __builtin_amdgcn_readfirstlane(tid0 >> 6);
    const int G = gridDim.x, bx = blockIdx.x, vcu = (G % 8 == 0) ? (bx % 8) * (G / 8) + bx / 8 : bx;
    const int gw = vcu * NWAVES + wave, NGW = G * NWAVES;
    unsigned* ctl = (unsigned*)(a.ws + WS_CTL);
    for (int u = tid0; u < (LDS_BYTES - RING_BYTES) / 4; u += NTHREADS) ((LAS unsigned*)(lds + RING_BYTES))[u] = 0u;
    __syncthreads();
    XcdBarrier bar = xcd_barrier_post(ctl + CW_BAR + a.li * XCD_BAR_WORDS, MISC + 8);
    const int lo = a.ph_lo, hi = a.ph_hi;
#ifndef PH_COMPILE
#define PH_COMPILE 0x7FF
#endif
#define IN(k) ((((PH_COMPILE) >> (k)) & 1) && lo <= (k) && (k) < hi)
#define SEAM(k) do { if (IN(k) && IN((k) + 1)) xcd_barrier(bar); } while (0)

    typedef const __attribute__((address_space(4))) Args* KArgs;
#define PHASE_PTRS \
    KArgs ka = (KArgs)__builtin_amdgcn_kernarg_segment_ptr(); asm volatile("" : "+s"(ka)); \
    const int tid = ptid(), lane = tid & 63; (void)lane; \
    unsigned char* ws = ka->ws; (void)ws; \
    const float* x = ka->in[0]; const float* c_in = ka->in[1]; const float* w_ada = ka->in[2]; const float* b_ada = ka->in[3]; \
    const float* pre_mix_g = ka->in[4]; const float* w_in = ka->in[6]; const float* b_fox_f = ka->in[7]; const float* gamma = ka->in[8]; \
    const float* w_out = ka->in[10]; const float* w_q = ka->in[13]; const float* sub_keys = ka->in[14]; const float* U = ka->in[15]; const float* V = ka->in[16]; \
    float* MOD = (float*)(ws + WS_MOD); float* LB = (float*)(ws + WS_LB); float* WFF = (float*)(ws + WS_WFF); \
    bf16_t* WIN = (bf16_t*)(ws + WS_WIN); bf16_t* WOUT = (bf16_t*)(ws + WS_WOUT); bf16_t* WQ = (bf16_t*)(ws + WS_WQ); bf16_t* KEYS = (bf16_t*)(ws + WS_KEYS); \
    float* LOGF = (float*)(ws + WS_F); float* F2T = (float*)(ws + WS_F2T); bf16_t* H = (bf16_t*)(ws + WS_H); bf16_t* PROJ = (bf16_t*)(ws + WS_PROJ); bf16_t* KK = (bf16_t*)(ws + WS_KK); \
    bf16_t* OCAT = (bf16_t*)(ws + WS_OCAT); bf16_t* MIX = H; bf16_t* H2 = OCAT; bf16_t* Q2 = (bf16_t*)(ws + WS_Q2); \
    (void)x; (void)c_in; (void)w_ada; (void)b_ada; (void)pre_mix_g; (void)w_in; (void)b_fox_f; (void)gamma; (void)w_out; (void)w_q; (void)sub_keys; (void)U; (void)V; \
    (void)MOD; (void)LB; (void)WFF; (void)WIN; (void)WOUT; (void)WQ; (void)KEYS; (void)LOGF; (void)F2T; (void)H; (void)PROJ; (void)KK; (void)OCAT; (void)MIX; (void)H2; (void)Q2;
    const int flags = a.flags;

    for (int rep_ = 0; rep_ < ((DUP_PHASE == 0) ? 2 : 1); ++rep_) if (IN(0)) { PHASE_PTRS
        LAS float* condl = (LAS float*)lds;
        for (int i = tid; i < 8192; i += NTHREADS) { const float cv = c_in[i]; condl[i] = cv * sigmoidf_(cv); }
        __syncthreads();
        for (int it = gw; it < 768; it += NGW) {
            const int j = it * 8 + (lane & 7), ks = lane >> 3;
            float acc[8];
#pragma unroll
            for (int b = 0; b < 8; ++b) acc[b] = 0.f;
            const float* wp = w_ada + (size_t)ks * 6144 + j;
#pragma unroll 8
            for (int i = 0; i < 128; ++i) { const float w = wp[(size_t)i * 8 * 6144]; const int k = ks + 8 * i;
#pragma unroll
                for (int b = 0; b < 8; ++b) acc[b] += condl[b * 1024 + k] * w; }
#pragma unroll
            for (int b = 0; b < 8; ++b) { float v = acc[b]; v += __shfl_xor(v, 8); v += __shfl_xor(v, 16); v += __shfl_xor(v, 32); acc[b] = v; }
            if (lane < 8) { const float bb = b_ada[j];
#pragma unroll
                for (int b = 0; b < 8; ++b) MOD[b * 6144 + j] = acc[b] + bb; }
        }
        if (gw == NGW - 1) { for (int i = lane; i < 512; i += 64) LB[i] = 1.f / (1.f + __expf(gamma[512 + i] - gamma[i])); ((float*)(ws + WS_LB + 4096))[lane] = 0.f; ((float*)(ws + WS_LB + 4096))[64 + lane] = 0.f; }
        LAS float* scr = (LAS float*)(lds + 32768 + wave * 8448);
        for (int it = gw; it < 3328; it += NGW) {
            int r = it;
            if (r < 768) { transpose_item(w_in, 3592, 0, WIN, 0, scr, r, 48, lane); continue; } r -= 768;
            if (r < 1024) { transpose_item(w_in, 3592, 1544, WIN, 1536, scr, r, 64, lane); continue; } r -= 1024;
            if (r < 512) { transpose_item(w_out, 1024, 0, WOUT, 0, scr, r, 32, lane); continue; } r -= 512;
            transpose_item(w_q, 2048, 0, WQ, 0, scr, r, 64, lane);
        }
        for (int i = gw * 64 + lane; i < 8192; i += NGW * 64) { const int jj = i >> 10, k = i & 1023; WFF[i] = w_in[(size_t)k * 3592 + 1536 + jj]; }
        for (int i = gw * 64 + lane; i < 65536; i += NGW * 64) { const f32x4 v = *(const f32x4*)(sub_keys + (size_t)i * 4); u32x2 o; o.x = pk2(v.x, v.y); o.y = pk2(v.z, v.w); *(u32x2*)(KEYS + (size_t)i * 4) = o; }
        for (int r = gw; r < 2 * NEXP; r += NGW) {
            if (r < NEXP) quant_row4(U, ws + WS_UQ, (float*)(ws + WS_US), r, lane);
            else quant_row4(V, ws + WS_UQ + 8, (float*)(ws + WS_VS), r - NEXP, lane);
        }
    }
    SEAM(0);
    for (int rep_ = 0; rep_ < ((DUP_PHASE == 1) ? 2 : 1); ++rep_) if (IN(1)) { PHASE_PTRS for (int t = gw; t < T; t += NGW) h_row(x, pre_mix_g, MOD, WFF, b_fox_f, H, LOGF, t, lane); }
    SEAM(1);
    if (DUP_PHASE == 99) { for (int i = 0; i < 10; ++i) xcd_barrier(bar); }
    for (int rep_ = 0; rep_ < ((DUP_PHASE == 2) ? 2 : 1); ++rep_) if (IN(2)) { PHASE_PTRS
        if (bx < 64) {
            const int bh = bx, b = bh >> 3, h = bh & 7;
            LAS float* wtot = (LAS float*)lds;
            const float* p = LOGF + ((size_t)b * SEQ + tid * 8) * 8 + h;
            float v[8], tot = 0.f;
#pragma unroll
            for (int i = 0; i < 8; ++i) { v[i] = p[i * 8]; tot += v[i]; }
            float incl = tot;
#pragma unroll
            for (int o = 1; o < 64; o <<= 1) { const float n = __shfl_up(incl, o); if (lane >= o) incl += n; }
            if (lane == 63) wtot[wave] = incl;
            __syncthreads();
            float base = incl - tot;
            for (int w = 0; w < wave; ++w) base += wtot[w];
            u32x4 dummy; (void)dummy;
            float run = base;
            float* o = F2T + (size_t)bh * SEQ + tid * 8;
#pragma unroll
            for (int i = 0; i < 8; ++i) { run += v[i]; o[i] = run * LOG2E; }
            __syncthreads();
        }
        pg8::Gemm g{H, WIN, T, NPROJ, 1024}; pg8::StaticOrder S; S.init(T, NPROJ, G, bx);
        EpiProjT E{PROJ, KK, LB, (unsigned*)(ws + WS_LB + 4096)};
        pg8::gemm_phase<EpiProjT, pg8::StaticOrder, true, true>(lds, g, S, E);
    }
    SEAM(2);
    if (IN(3)) { PHASE_PTRS
        const float* KMAXH = (const float*)(ws + WS_LB + 4096);
        if (flags & FL_HGRN) hg::pass_a_all<false>(lds, PROJ, KK, (bf16_t*)(ws + WS_HST), (float*)(ws + WS_HD), vcu, G, 2048);
        xcd_barrier(bar);
        if (flags & FL_HGRN) { for (int g = vcu * NTHREADS + tid; g < 32 * 4096; g += G * NTHREADS) hg::pass_b((bf16_t*)(ws + WS_HST), (const float*)(ws + WS_HD), g); }
        if (flags & FL_ATTN) {
            unsigned* qctr = ctl + CW_ATTNQ;
            LAS int* ubox = (LAS int*)(lds + RING_BYTES + 64);
            for (int rep_ = 0; rep_ < ((DUP_PHASE == 3) ? 2 : 1); ++rep_)
            for (;;) {
                if (tid == 0) *ubox = (int)atomicAdd(qctr + 64 * rep_, 1u);
                __syncthreads();
                const int u = *ubox;
                __syncthreads();
                if (u >= 1024) break;
                const int qb = 15 - (u >> 6), bh = u & 63;
                fa::attn_unit(lds, PROJ, F2T, OCAT, bh >> 3, bh & 7, qb, sqrtf(KMAXH[2 * bh] + KMAXH[2 * bh + 1]));
            }
        }
    }
    SEAM(3);
    for (int rep_ = 0; rep_ < ((DUP_PHASE == 5) ? 2 : 1); ++rep_) if (IN(5) && (flags & FL_HGRN)) { PHASE_PTRS hg::pass_c_all(lds, PROJ, (const bf16_t*)(ws + WS_HST), ka->in[9], OCAT, vcu, G, 2048); }
    SEAM(5);
    for (int rep_ = 0; rep_ < ((DUP_PHASE == 6) ? 2 : 1); ++rep_) if (IN(6)) { PHASE_PTRS
        pg8::Gemm g{OCAT, WOUT, T, 1024, 1024}; pg8::StaticOrder S; S.init(T, 1024, G, bx);
        EpiPlainT E{MIX, 1024};
        pg8::gemm_phase<EpiPlainT, pg8::StaticOrder, true, true>(lds, g, S, E);
    }
    SEAM(6);
    for (int rep_ = 0; rep_ < ((DUP_PHASE == 7) ? 2 : 1); ++rep_) if (IN(7)) { PHASE_PTRS for (int t = gw; t < T; t += NGW) row_pass(x, MIX, MOD, ka->in[5], ka->in[11], (bf16_t*)(ws + WS_HST), H2, t, lane); }
    SEAM(7);
    for (int rep_ = 0; rep_ < ((DUP_PHASE == 8) ? 2 : 1); ++rep_) if (IN(8)) { PHASE_PTRS
        pg8::Gemm g{H2, WQ, T, NQ2, 1024}; pg8::StaticOrder S; S.init(T, NQ2, G, bx);
        EpiPlainT E{Q2, NQ2};
        pg8::gemm_phase<EpiPlainT, pg8::StaticOrder, true, true>(lds, g, S, E);
    }
    SEAM(8);
    for (int rep_ = 0; rep_ < ((DUP_PHASE == 9) ? 2 : 1); ++rep_) if (IN(9)) { PHASE_PTRS
        const int h = vcu & 7;
        {
            const bf16_t* ksrc = KEYS + (size_t)h * 2 * 128 * 128;
            for (int i = tid; i < 4096; i += NTHREADS) { const int row = i >> 4, ch = i & 15; *(LAS u32x4*)(lds + row * RT_KROW + ch * 16) = *(const u32x4*)(ksrc + row * 128 + ch * 8); }
        }
        __syncthreads();
        const int r32 = lane & 31, hi = lane >> 5;
        int* IDXw = (int*)(ws + WS_IDX); float* GATEw = (float*)(ws + WS_GATE);
        for (int tb = (vcu >> 3); tb < T / 256; tb += G / 8) {
            const int t = tb * 256 + wave * 32 + r32;
            const bf16_t* qrow = Q2 + (size_t)t * NQ2 + h * 256;
            float A[16], B[16];
            route_half(A, lds, qrow, r32, hi);
            __builtin_amdgcn_sched_barrier(0);
            route_half(B, lds + 128 * RT_KROW, qrow + 128, r32, hi);
            __builtin_amdgcn_sched_barrier(0);
            route_final(A, B, lds + 256 * RT_KROW + tid * 32, IDXw + (size_t)t * 128 + h * 16, GATEw + (size_t)t * 128 + h * 16, hi == 0);
        }
    }
    SEAM(9);
    if (IN(10)) { PHASE_PTRS
        const int* IDX = (const int*)(ws + WS_IDX); const float* GATE = (const float*)(ws + WS_GATE);
        for (int rep_ = ((DUP_PHASE == 10) ? 0 : 1); rep_ < 2; ++rep_) { float* outp = rep_ ? ka->out : (float*)(ws + 280 * MiB);
            const int rmask = (rep_ == 0 && DUP_MODE == 1) ? 255 : 0x3FFF;
            for (int t = gw; t < T; t += NGW) expert_token((const unsigned char*)(ws + WS_UQ), (const float*)(ws + WS_US), (const float*)(ws + WS_VS), IDX, GATE, MOD, ka->in[11], ka->in[12], (const bf16_t*)(ws + WS_HST), outp, t, lane, rmask); }
    }
#undef IN
#undef SEAM
}

extern "C" void kernel_launch(void* const* d_in, const int* in_sizes, int n_in, void* d_out, int out_size, void* d_ws, size_t ws_size, hipStream_t stream) {
    if (n_in != 17 || in_sizes[0] != T * DM || out_size != T * DM || ws_size < WS_END) { fprintf(stderr, "kernel_launch: unexpected inputs (n_in %d, ws %zu); nothing launched\n", n_in, ws_size); return; }
    static int grid = 0;
    if (grid == 0) {
        int dev = 0, cus = 0, per_cu = 0;
        if (hipGetDevice(&dev) != hipSuccess || hipDeviceGetAttribute(&cus, hipDeviceAttributeMultiprocessorCount, dev) != hipSuccess) { grid = -1; return; }
        if (hipFuncSetAttribute((const void*)mega, hipFuncAttributeMaxDynamicSharedMemorySize, LDS_BYTES) != hipSuccess) { fprintf(stderr, "kernel_launch: hipFuncSetAttribute failed\n"); grid = -1; return; }
        if (hipOccupancyMaxActiveBlocksPerMultiprocessor(&per_cu, (const void*)mega, NTHREADS, LDS_BYTES) != hipSuccess || per_cu < 1) { fprintf(stderr, "kernel_launch: occupancy query says %d\n", per_cu); (void)hipGetLastError(); grid = -1; return; }
        grid = cus;
        if (grid % 8 != 0) { fprintf(stderr, "kernel_launch: %d CUs: the routing phase deals heads over groups of 8 workgroups; nothing launched\n", grid); grid = -1; return; }
    }
    if (grid < 0) return;
    if (hipMemsetAsync((unsigned char*)d_ws + WS_CTL, 0, CTL_ZERO_BYTES, stream) != hipSuccess) return;
    Args a{}; for (int i = 0; i < 17; ++i) a.in[i] = (const float*)d_in[i];
    a.out = (float*)d_out; a.ws = (unsigned char*)d_ws; a.ph_lo = 0; a.ph_hi = 11; a.li = 0; a.flags = FL_ATTN | FL_HGRN;
    hipLaunchKernelGGL(mega, dim3(grid), dim3(NTHREADS), LDS_BYTES, stream, a);
}
```

```cpp
#include <hip/hip_runtime.h>
#include <stdint.h>
#include <cstdio>

typedef unsigned short bf16_t;
typedef short bf16x8 __attribute__((ext_vector_type(8)));
typedef float f32x4 __attribute__((ext_vector_type(4)));
typedef float f32x16 __attribute__((ext_vector_type(16)));
typedef unsigned u32x4 __attribute__((ext_vector_type(4)));
typedef unsigned u32x2 __attribute__((ext_vector_type(2)));

constexpr int BATCH = 8, SEQ = 4096, DM = 1024, T = BATCH * SEQ;
constexpr int NPROJ = 3584;
constexpr int C_Q = 0, C_K = 512, C_V = 1024, C_HQ = 1536, C_LF = 2048, C_HI = 2560, C_SG = 3072;
constexpr int NQ2 = 2048, NEXP = 16384;
constexpr float EPS = 1e-6f;
constexpr float LOG2E = 1.4426950408889634f;
constexpr float QSCALE = 0.125f * LOG2E;
constexpr float HQSCALE = 0.08838834764831845f;

constexpr size_t MiB = 1u << 20;
constexpr size_t WS_CTL = 0;
constexpr size_t WS_MOD = 1 * MiB;
constexpr size_t WS_LB = WS_MOD + 256 * 1024;
constexpr size_t WS_WFF = WS_MOD + 512 * 1024;
constexpr size_t WS_WIN = 2 * MiB;
constexpr size_t WS_WOUT = 10 * MiB;
constexpr size_t WS_WQ = 12 * MiB;
constexpr size_t WS_KEYS = 16 * MiB;
constexpr size_t WS_US = 17 * MiB;
constexpr size_t WS_VS = WS_US + 256 * 1024;
constexpr size_t WS_UQ = 18 * MiB;
constexpr size_t WS_F = 50 * MiB;
constexpr size_t WS_F2T = 52 * MiB;
constexpr size_t WS_H = 56 * MiB;
constexpr size_t WS_PROJ = 120 * MiB;
constexpr size_t WS_KK = 344 * MiB;
constexpr size_t WS_OCAT = 376 * MiB;
constexpr size_t WS_HST = 440 * MiB;
constexpr size_t WS_HD = 504 * MiB;
constexpr size_t WS_Q2 = WS_PROJ;
constexpr size_t WS_IDX = WS_PROJ + 128 * MiB;
constexpr size_t WS_GATE = WS_PROJ + 144 * MiB;
constexpr size_t WS_END = 505 * MiB;

__device__ __forceinline__ float bf2f(bf16_t v) { return __uint_as_float(((unsigned)v) << 16); }
typedef float f32x2_t __attribute__((ext_vector_type(2))); typedef __bf16 bf16x2_t __attribute__((ext_vector_type(2)));
__device__ __forceinline__ unsigned pk2(float lo, float hi) { f32x2_t v = {lo, hi}; bf16x2_t b = __builtin_convertvector(v, bf16x2_t); return __builtin_bit_cast(unsigned, b); }
__device__ __forceinline__ bf16_t f2bf(float f) { return (bf16_t)(pk2(f, 0.f) & 0xffffu); }
__device__ __forceinline__ unsigned short f2h(float f) { _Float16 h = (_Float16)f; return __builtin_bit_cast(unsigned short, h); }
__device__ __forceinline__ float h2f(unsigned short u) { _Float16 h = __builtin_bit_cast(_Float16, u); return (float)h; }
#define WAVE_DPP(v, ctrl) __int_as_float(__builtin_amdgcn_update_dpp(0, __float_as_int(v), ctrl, 0xF, 0xF, false))
__device__ __forceinline__ float wave_sum(float v) {
    v += WAVE_DPP(v, 0xB1);
    v += WAVE_DPP(v, 0x4E);
    v += WAVE_DPP(v, 0x124);
    v += WAVE_DPP(v, 0x128);
    { const auto r = __builtin_amdgcn_permlane16_swap(__float_as_uint(v), __float_as_uint(v), false, false); v = __uint_as_float(r[0]) + __uint_as_float(r[1]); }
    { const auto r = __builtin_amdgcn_permlane32_swap(__float_as_uint(v), __float_as_uint(v), false, false); v = __uint_as_float(r[0]) + __uint_as_float(r[1]); }
    return v;
}
__device__ __forceinline__ float wave_max(float v) {
    v = fmaxf(v, WAVE_DPP(v, 0xB1));
    v = fmaxf(v, WAVE_DPP(v, 0x4E));
    v = fmaxf(v, WAVE_DPP(v, 0x124));
    v = fmaxf(v, WAVE_DPP(v, 0x128));
    { const auto r = __builtin_amdgcn_permlane16_swap(__float_as_uint(v), __float_as_uint(v), false, false); v = fmaxf(__uint_as_float(r[0]), __uint_as_float(r[1])); }
    { const auto r = __builtin_amdgcn_permlane32_swap(__float_as_uint(v), __float_as_uint(v), false, false); v = fmaxf(__uint_as_float(r[0]), __uint_as_float(r[1])); }
    return v;
}
__device__ __forceinline__ float sigmoidf_(float z) { return __builtin_amdgcn_rcpf(1.f + __expf(-z)); }
__device__ __forceinline__ float gelu_erf(float a) { return 0.5f * a * (1.f + erff(a * 0.7071067811865476f)); }

#define DUP_PHASE (-1)
#define DUP_MODE 0
#define TPROBE_FS 300.f
namespace pg8 {
__device__ __forceinline__ int ptid_() { int t = threadIdx.x; asm volatile("" : "+v"(t)); return t; }
#define PG8_LAS __attribute__((address_space(3)))
typedef unsigned short bf16_t;
typedef short bf16x8 __attribute__((ext_vector_type(8)));
typedef float f32x4 __attribute__((ext_vector_type(4)));
typedef unsigned u32x4 __attribute__((ext_vector_type(4)));
constexpr int BM = 256, BK = 64, HALF = 128, HTB = HALF * BK * 2  , STAGE_BYTES = 8 * HTB, NXCD = 8, WGM = 4;

__host__ __device__ __forceinline__ int lds_byte(int r, int c) { const int st = (r >> 4) * 2 + (c >> 5), rr = r & 15, cc = c & 31, ob = rr * 64 + cc * 2; return st * 1024 + (ob ^ (((ob >> 9) & 1) << 5)); }
__host__ __device__ __forceinline__ void stage_rc(int b, int& R, int& C) { const int st = b / 1024, sb = b % 1024, swz = sb ^ (((sb >> 9) & 1) << 5); R = (st >> 1) * 16 + swz / 64; C = (st & 1) * 32 + (swz % 64) / 2; }
__host__ __device__ __forceinline__ int perm32(int rho) { const int n = rho >> 4, i = rho & 15; return 8 * (i >> 2) + 4 * n + (i & 3); }

struct Unit { int pm, pn; };
struct Gemm { const bf16_t* A; const bf16_t* Bt; int M, N, K; };

struct StaticOrder {
    int nM, nN, nwg, G, c, wgm;
    __host__ __device__ void init(int M, int N, int G_, int c_, int wgm_ = WGM) { nM = M / BM; nN = N / BM; nwg = nM * nN; G = G_; c = c_; wgm = wgm_; }
    __host__ __device__ bool next(int i, Unit& u) const {
        const long L = (long)i * G + c; if (L >= nwg) return false;
        int wgid = (int)L; { const int q = nwg / NXCD, r = nwg % NXCD, xcd = wgid % NXCD, off = wgid / NXCD; wgid = (xcd < r ? xcd * (q + 1) : r * (q + 1) + (xcd - r) * q) + off; }
        const int nig = wgm * nN, gid = wgid / nig, fm = gid * wgm, gsz = (nM - fm) < wgm ? (nM - fm) : wgm;
        u.pm = fm + ((wgid % nig) % gsz); u.pn = (wgid % nig) / gsz; return true;
    }
    __device__ __forceinline__ void a_ready(const Unit&) const {}
    __device__ __forceinline__ void done(const Unit&) const {}
};

template <class Epi, class Sched, bool ALIGN_EPI = false, bool SP2 = false>
__device__ __forceinline__ void gemm_phase(PG8_LAS unsigned char* lds, const Gemm g, const Sched& S, const Epi& E) {
    const int tid = ptid_(), wid = __builtin_amdgcn_readfirstlane(tid >> 6), lane = tid & 63, wr = wid >> 2, wc = wid & 3, fr = lane & 15, fq = lane >> 4;
    const int K = g.K, nt = K / BK;
    unsigned voffA[2], voffB[2];
#pragma unroll
    for (int i = 0; i < 2; ++i) { int R, C; stage_rc(tid * 16 + i * 8192, R, C); const int Rb = Epi::PERM ? ((R & ~31) + perm32(R & 31)) : R;
        voffA[i] = (unsigned)(R * K + C) * 2u; voffB[i] = (unsigned)(Rb * K + C) * 2u; }
    const size_t kstep = (size_t)(BK * 2);
    const size_t hstep = (size_t)HALF * K * 2;
    const size_t tstep = 2 * hstep;
    const unsigned ldsw = (unsigned)wid * 1024u;
    const int aoff = lds_byte(wr * 64 + fr, fq * 8), boff = lds_byte(wc * 32 + fr, fq * 8);
#define PG8_SA(b, h) (((b) * 2 + (h)) * HTB)
#define PG8_SB(b, h) ((4 + (b) * 2 + (h)) * HTB)
#define PG8_STAGE(bufoff, gbase, voff) do { _Pragma("unroll") for (int _i = 0; _i < 2; ++_i) \
        __builtin_amdgcn_global_load_lds((const unsigned*)((const char*)(gbase) + (voff)[_i]), (PG8_LAS unsigned*)(lds + (bufoff) + ldsw + _i * 8192), 16, 0, 0); } while (0)
#define PG8_LDA(dst, b, h) do { _Pragma("unroll") for (int m = 0; m < 4; ++m) _Pragma("unroll") for (int k = 0; k < 2; ++k) dst[m][k] = *(const PG8_LAS bf16x8*)(lds + PG8_SA(b, h) + aoff + m * 2048 + k * 1024); } while (0)
#define PG8_LDB(dst, b, h) do { _Pragma("unroll") for (int n = 0; n < 2; ++n) _Pragma("unroll") for (int k = 0; k < 2; ++k) dst[n][k] = *(const PG8_LAS bf16x8*)(lds + PG8_SB(b, h) + boff + n * 2048 + k * 1024); } while (0)
#define PG8_MMA(ai, bj, At, Bt) do { __builtin_amdgcn_s_setprio(1); _Pragma("unroll") for (int m = 0; m < 4; ++m) _Pragma("unroll") for (int n = 0; n < 2; ++n) _Pragma("unroll") for (int k = 0; k < 2; ++k) \
        acc[ai][bj][m][n] = __builtin_amdgcn_mfma_f32_16x16x32_bf16(Bt[n][k], At[m][k], acc[ai][bj][m][n], 0, 0, 0); __builtin_amdgcn_s_setprio(0); } while (0)
#define PG8_WAIT_V(n) asm volatile("s_waitcnt vmcnt(" #n ")" ::: "memory")
#define PG8_WAIT_L(n) asm volatile("s_waitcnt lgkmcnt(" #n ")" ::: "memory")
#define PG8_BAR __builtin_amdgcn_s_barrier()
#define PG8_SCHED __builtin_amdgcn_sched_barrier(0)
    Unit cur, nxt; int ui = 0;
    if (!S.next(0, cur)) return;
    f32x4 acc[2][2][4][2];
#pragma unroll
    for (int a = 0; a < 2; ++a)
#pragma unroll
        for (int b = 0; b < 2; ++b)
#pragma unroll
            for (int m = 0; m < 4; ++m)
#pragma unroll
                for (int n = 0; n < 2; ++n) acc[a][b][m][n] = (f32x4){0.f, 0.f, 0.f, 0.f};
    bf16x8 At[4][2], B0[2][2], B1[2][2];
    const char* cA = (const char*)g.A + (size_t)cur.pm * tstep; const char* cB = (const char*)g.Bt + (size_t)cur.pn * tstep;
    S.a_ready(cur);
    if constexpr (SP2) {
        PG8_STAGE(PG8_SB(0, 0), cB, voffB); PG8_STAGE(PG8_SB(0, 1), cB + hstep, voffB); PG8_STAGE(PG8_SA(0, 0), cA, voffA); PG8_STAGE(PG8_SA(0, 1), cA + hstep, voffA);
        if (wr == 1) PG8_BAR;
        PG8_WAIT_V(2); PG8_BAR;
        PG8_STAGE(PG8_SB(1, 0), cB + kstep, voffB); PG8_STAGE(PG8_SA(1, 0), cA + kstep, voffA); PG8_STAGE(PG8_SB(1, 1), cB + hstep + kstep, voffB);
        PG8_WAIT_V(6); PG8_BAR;
    } else {
        PG8_STAGE(PG8_SB(0, 0), cB, voffB); PG8_STAGE(PG8_SA(0, 0), cA, voffA); PG8_STAGE(PG8_SB(0, 1), cB + hstep, voffB); PG8_STAGE(PG8_SA(0, 1), cA + hstep, voffA);
        if (wr == 1) PG8_BAR;
        PG8_WAIT_V(4); PG8_BAR;
        PG8_STAGE(PG8_SB(1, 0), cB + kstep, voffB); PG8_STAGE(PG8_SA(1, 0), cA + kstep, voffA); PG8_STAGE(PG8_SB(1, 1), cB + hstep + kstep, voffB);
        PG8_WAIT_V(6); PG8_BAR;
    }
    for (;;) {
        const bool has_next = S.next(ui + 1, nxt);
        const char* nA = has_next ? (const char*)g.A + (size_t)nxt.pm * tstep : cA; const char* nB = has_next ? (const char*)g.Bt + (size_t)nxt.pn * tstep : cB;
        for (int t = 0; t < nt; t += 2) {
            const bool last = (t == nt - 2);
            const char* a1 = cA + (size_t)(t + 1) * kstep;
            const char* a2 = last ? nA : cA + (size_t)(t + 2) * kstep; const char* b2 = last ? nB : cB + (size_t)(t + 2) * kstep;
            const char* a3 = a2 + kstep; const char* b3 = b2 + kstep;
            if (last && has_next) S.a_ready(nxt);
            if constexpr (SP2) {
            PG8_LDB(B0, 0, 0); PG8_LDB(B1, 0, 1); PG8_SCHED; PG8_LDA(At, 0, 0); PG8_STAGE(PG8_SA(1, 1), a1 + hstep, voffA);
            PG8_WAIT_V(8); PG8_WAIT_L(0); PG8_BAR; PG8_MMA(0, 0, At, B0); PG8_MMA(0, 1, At, B1); PG8_BAR; PG8_SCHED;
            PG8_LDA(At, 0, 1); PG8_STAGE(PG8_SB(0, 0), b2, voffB); PG8_STAGE(PG8_SB(0, 1), b2 + hstep, voffB); PG8_STAGE(PG8_SA(0, 0), a2, voffA);
            PG8_WAIT_V(8); PG8_WAIT_L(0); PG8_BAR; PG8_MMA(1, 0, At, B0); PG8_MMA(1, 1, At, B1); PG8_BAR; PG8_SCHED;
            PG8_LDB(B0, 1, 0); PG8_LDB(B1, 1, 1); PG8_SCHED; PG8_LDA(At, 1, 0); PG8_STAGE(PG8_SA(0, 1), a2 + hstep, voffA);
            PG8_WAIT_V(8); PG8_WAIT_L(0); PG8_BAR; PG8_MMA(0, 0, At, B0); PG8_MMA(0, 1, At, B1); PG8_BAR; PG8_SCHED;
            PG8_LDA(At, 1, 1); PG8_STAGE(PG8_SB(1, 0), b3, voffB); PG8_STAGE(PG8_SB(1, 1), b3 + hstep, voffB); PG8_STAGE(PG8_SA(1, 0), a3, voffA);
            PG8_WAIT_V(8); PG8_WAIT_L(0); PG8_BAR; PG8_MMA(1, 0, At, B0); PG8_MMA(1, 1, At, B1); PG8_BAR; PG8_SCHED;
            } else {
            PG8_LDB(B0, 0, 0); PG8_SCHED; PG8_LDA(At, 0, 0); PG8_STAGE(PG8_SA(1, 1), a1 + hstep, voffA);
            PG8_WAIT_L(8); PG8_BAR; PG8_WAIT_L(0); PG8_MMA(0, 0, At, B0); PG8_BAR; PG8_SCHED;
            PG8_LDB(B1, 0, 1); PG8_STAGE(PG8_SB(0, 0), b2, voffB);
            PG8_BAR; PG8_WAIT_L(0); PG8_MMA(0, 1, At, B1); PG8_BAR;
            PG8_LDA(At, 0, 1); PG8_STAGE(PG8_SA(0, 0), a2, voffA);
            PG8_BAR; PG8_WAIT_L(0); PG8_MMA(1, 0, At, B0); PG8_BAR; PG8_SCHED;
            PG8_STAGE(PG8_SB(0, 1), b2 + hstep, voffB);
            PG8_WAIT_V(6); PG8_BAR; PG8_MMA(1, 1, At, B1); PG8_BAR;
            PG8_LDB(B0, 1, 0); PG8_SCHED; PG8_LDA(At, 1, 0); PG8_STAGE(PG8_SA(0, 1), a2 + hstep, voffA);
            PG8_WAIT_L(8); PG8_BAR; PG8_WAIT_L(0); PG8_MMA(0, 0, At, B0); PG8_BAR; PG8_SCHED;
            PG8_LDB(B1, 1, 1); PG8_STAGE(PG8_SB(1, 0), b3, voffB);
            PG8_BAR; PG8_WAIT_L(0); PG8_MMA(0, 1, At, B1); PG8_BAR;
            PG8_LDA(At, 1, 1); PG8_STAGE(PG8_SA(1, 0), a3, voffA);
            PG8_BAR; PG8_WAIT_L(0); PG8_MMA(1, 0, At, B0); PG8_BAR; PG8_SCHED;
            PG8_STAGE(PG8_SB(1, 1), b3 + hstep, voffB);
            PG8_WAIT_V(6); PG8_BAR; PG8_MMA(1, 1, At, B1); PG8_BAR;
            }
        }
        if constexpr (ALIGN_EPI) { if (wr == 0) PG8_BAR; }
        if constexpr (!Epi::AFTER_DRAIN) { E(acc, cur, wr, wc, fr, fq); S.done(cur); }
        if (!has_next) break;
#pragma unroll
        for (int a = 0; a < 2; ++a)
#pragma unroll
            for (int b = 0; b < 2; ++b)
#pragma unroll
                for (int m = 0; m < 4; ++m)
#pragma unroll
                    for (int n = 0; n < 2; ++n) acc[a][b][m][n] = (f32x4){0.f, 0.f, 0.f, 0.f};
        cur = nxt; cA = nA; cB = nB; ++ui;
        if constexpr (ALIGN_EPI) { if (wr == 1) PG8_BAR; }
    }
    PG8_WAIT_V(0);
    if constexpr (!ALIGN_EPI) { if (wr == 0) PG8_BAR; }
    PG8_BAR;
    if constexpr (Epi::AFTER_DRAIN) { E.fused(acc, cur, wr, wc, fr, fq, lds, wid, lane); S.done(cur); }
#undef PG8_SA
#undef PG8_SB
#undef PG8_STAGE
#undef PG8_LDA
#undef PG8_LDB
#undef PG8_MMA
#undef PG8_WAIT_V
#undef PG8_WAIT_L
#undef PG8_BAR
#undef PG8_SCHED
}
}

#define LAS __attribute__((address_space(3)))
#ifndef WGM_G1
#define WGM_G1 4
#define WGM_G2 4
#define WGM_G3 4
#endif
#ifndef TPROBE
#define TPROBE (-1)
#endif
__device__ __forceinline__ int ptid() { int t = threadIdx.x; asm volatile("" : "+v"(t)); return t; }
constexpr int NWAVES = 8, NTHREADS = 512;
constexpr int RING_BYTES = 131072;
constexpr int MISC_OFF = RING_BYTES + 320;
constexpr int LDS_BYTES = 147456;
constexpr int CW_BAR = 4096;
constexpr size_t CTL_ZERO_BYTES = 40 * 1024;
constexpr int CW_ATTNQ = 7680;

#define XB_TMO      128
#define XB_XCNT(j)  (256  + 64 * (j))
#define XB_XSUB(j)  (1280 + 64 * (j))
#define XB_XGEN(j)  (2304 + 64 * (j))
#define XB_TOP      3328
#define XB_TOPGEN   3392
#define XCD_BAR_WORDS 3456
#define XB_SPIN_CAP (1u << 20)
__device__ __forceinline__ unsigned xb_ld(unsigned* p)              { return __hip_atomic_load(p, __ATOMIC_RELAXED, __HIP_MEMORY_SCOPE_AGENT); }
__device__ __forceinline__ unsigned xb_add(unsigned* p, unsigned v) { return __hip_atomic_fetch_add(p, v, __ATOMIC_RELAXED, __HIP_MEMORY_SCOPE_AGENT); }
__device__ __forceinline__ unsigned xb_xcc_id() { return (unsigned)__builtin_amdgcn_s_getreg((3 << 11) | 20) & 0xFu; }
#define XB_SPIN(cond, bar) do { unsigned _sp = 0; while (cond) { __builtin_amdgcn_s_sleep(1); \
    if ((++_sp & 255u) == 0u) { if (xb_ld(&(bar)[XB_TMO])) break; if (_sp > XB_SPIN_CAP) { atomicAdd(&(bar)[XB_TMO], 1u); break; } } } } while (0)
struct XcdBarrier { unsigned* bar; unsigned x; volatile LAS unsigned* st; };
__device__ __forceinline__ XcdBarrier xcd_barrier_post(unsigned* bar, volatile LAS unsigned* st) {
    XcdBarrier b; b.bar = bar; b.x = xb_xcc_id(); b.st = st;
    if (threadIdx.x == 0) (void)xb_add(&bar[XB_XCNT(b.x)], 1u);
    return b;
}
__device__ __forceinline__ void xcd_barrier_complete(unsigned* bar, unsigned x, unsigned& nloc, unsigned& nx) {
    const unsigned G = gridDim.x * gridDim.y * gridDim.z;
    unsigned sum, cnt, mine, sp = 0u;
    for (;;) {
        sum = 0u; cnt = 0u; mine = 0u;
#pragma unroll
        for (unsigned j = 0; j < 16; ++j) { const unsigned c = xb_ld(&bar[XB_XCNT(j)]); sum += c; cnt += (c > 0u) ? 1u : 0u; mine = (j == x) ? c : mine; }
        if (sum == G) break;
        __builtin_amdgcn_s_sleep(1);
        if ((++sp & 255u) == 0u) { if (xb_ld(&bar[XB_TMO])) break; if (sp > XB_SPIN_CAP) { atomicAdd(&bar[XB_TMO], 1u); break; } }
    }
    nloc = mine > 0u ? mine : 1u; nx = cnt > 0u ? cnt : 1u;
}
__device__ __forceinline__ void xcd_barrier(const XcdBarrier& b) {
    asm volatile("s_waitcnt vmcnt(0)" ::: "memory");
    __syncthreads();
    if (threadIdx.x == 0) {
        unsigned* bar = b.bar;
        __builtin_amdgcn_s_waitcnt(0);
        unsigned nloc = b.st[0], nx = b.st[1];
        if (nloc == 0u) { xcd_barrier_complete(bar, b.x, nloc, nx); b.st[0] = nloc; b.st[1] = nx; }
        const unsigned old = xb_add(&bar[XB_XSUB(b.x)], 1u);
        const unsigned gen = old / nloc;
        if (old + 1u == (gen + 1u) * nloc) {
            __builtin_amdgcn_fence(__ATOMIC_RELEASE, "agent");
            asm volatile("s_waitcnt vmcnt(0)" ::: "memory");
            const unsigned og = xb_add(&bar[XB_TOP], 1u);
            const unsigned tg = og / nx;
            if (og + 1u == (tg + 1u) * nx) xb_add(&bar[XB_TOPGEN], 1u);
            else XB_SPIN(xb_ld(&bar[XB_TOPGEN]) == tg, bar);
            __builtin_amdgcn_fence(__ATOMIC_ACQUIRE, "agent");
            xb_add(&bar[XB_XGEN(b.x)], 1u);
            asm volatile("s_waitcnt vmcnt(0)" ::: "memory");
        } else {
            XB_SPIN(xb_ld(&bar[XB_XGEN(b.x)]) == gen, bar);
            __builtin_amdgcn_fence(__ATOMIC_ACQUIRE, "agent");
            asm volatile("s_waitcnt vmcnt(0)" ::: "memory");
        }
    }
    __syncthreads();
}

struct Args { const float* in[17]; float* out; unsigned char* ws; int ph_lo, ph_hi, li, flags; };
enum { FL_ATTN = 1, FL_HGRN = 2 };

__device__ __forceinline__ unsigned cvt_pk_bf16(float lo, float hi) { f32x2_t v = {lo, hi}; bf16x2_t b = __builtin_convertvector(v, bf16x2_t); return __builtin_bit_cast(unsigned, b); }
struct EpiPlainT {
    static constexpr bool PERM = true, AFTER_DRAIN = false;
    bf16_t* O; int ld;
    __device__ __forceinline__ void operator()(const pg8::f32x4 (&acc)[2][2][4][2], const pg8::Unit& u, int wr, int wc, int fr, int fq) const {
        const int row0 = u.pm * 256 + wr * 64 + fr, col0 = u.pn * 256 + wc * 32 + 8 * fq;
#pragma unroll
        for (int ai = 0; ai < 2; ++ai)
#pragma unroll
            for (int m = 0; m < 4; ++m) { bf16_t* rowp = O + (size_t)(row0 + ai * 128 + m * 16) * ld + col0;
#pragma unroll
                for (int bj = 0; bj < 2; ++bj) { const pg8::f32x4 v0 = acc[ai][bj][m][0], v1 = acc[ai][bj][m][1];
                    u32x4 w; w.x = cvt_pk_bf16(v0[0], v0[1]); w.y = cvt_pk_bf16(v0[2], v0[3]); w.z = cvt_pk_bf16(v1[0], v1[1]); w.w = cvt_pk_bf16(v1[2], v1[3]);
                    *(u32x4*)(rowp + bj * 128) = w; } }
    }
};
struct EpiProjT {
    static constexpr bool PERM = true, AFTER_DRAIN = false;
    bf16_t* proj; bf16_t* kk; const float* lb; unsigned* kmaxh;
    __device__ __forceinline__ void operator()(const pg8::f32x4 (&acc)[2][2][4][2], const pg8::Unit& u, int wr, int wc, int fr, int fq) const {
        const int row0 = u.pm * 256 + wr * 64 + fr, col0 = u.pn * 256 + wc * 32 + 8 * fq, seg = (u.pn * 256) >> 9;
        float kmx[2] = {0.f, 0.f};
        float lbv[2][8];
        if (seg == 4) {
#pragma unroll
            for (int bj = 0; bj < 2; ++bj)
#pragma unroll
                for (int i = 0; i < 8; ++i) lbv[bj][i] = lb[col0 - C_LF + bj * 128 + i];
        }
        const float sc = (seg == 0) ? QSCALE : (seg == 3) ? HQSCALE : 1.f;
#pragma unroll
        for (int ai = 0; ai < 2; ++ai)
#pragma unroll
            for (int m = 0; m < 4; ++m) { const size_t row = (size_t)(row0 + ai * 128 + m * 16);
#pragma unroll
                for (int bj = 0; bj < 2; ++bj) {
                    float v[8];
#pragma unroll
                    for (int i = 0; i < 4; ++i) { v[i] = acc[ai][bj][m][0][i]; v[4 + i] = acc[ai][bj][m][1][i]; }
                    u32x4 w;
                    if (seg == 4) {
                        float k1[8]; unsigned short hh[8];
#pragma unroll
                        for (int i = 0; i < 8; ++i) { const float l = lbv[bj][i], f = l + (1.f - l) * sigmoidf_(v[i]); k1[i] = 1.f - f; hh[i] = f2h(__builtin_amdgcn_logf(f) * 0.69314718056f); }
                        w.x = hh[0] | ((unsigned)hh[1] << 16); w.y = hh[2] | ((unsigned)hh[3] << 16); w.z = hh[4] | ((unsigned)hh[5] << 16); w.w = hh[6] | ((unsigned)hh[7] << 16);
                        u32x4 kw; kw.x = cvt_pk_bf16(k1[0], k1[1]); kw.y = cvt_pk_bf16(k1[2], k1[3]); kw.z = cvt_pk_bf16(k1[4], k1[5]); kw.w = cvt_pk_bf16(k1[6], k1[7]);
                        *(u32x4*)(kk + row * 512 + (col0 - C_LF + bj * 128)) = kw;
                    } else {
                        if (seg == 6) {
#pragma unroll
                            for (int i = 0; i < 8; ++i) v[i] = v[i] * sigmoidf_(v[i]);
                        } else {
#pragma unroll
                            for (int i = 0; i < 8; ++i) v[i] *= sc;
                        }
                        w.x = cvt_pk_bf16(v[0], v[1]); w.y = cvt_pk_bf16(v[2], v[3]); w.z = cvt_pk_bf16(v[4], v[5]); w.w = cvt_pk_bf16(v[6], v[7]);
                        if (seg == 1) {
                            float s = 0.f;
#pragma unroll
                            for (int i = 0; i < 4; ++i) { const float a = __uint_as_float(w[i] << 16), b = __uint_as_float(w[i] & 0xffff0000u); s += a * a + b * b; }
                            s += __shfl_xor(s, 16); s += __shfl_xor(s, 32);
                            kmx[bj] = fmaxf(kmx[bj], s);
                        }
                    }
                    *(u32x4*)(proj + row * NPROJ + col0 + bj * 128) = w;
                } }
        if (seg == 1) {
#pragma unroll
            for (int bj = 0; bj < 2; ++bj) { float m = kmx[bj]; m = fmaxf(m, __shfl_xor(m, 1)); m = fmaxf(m, __shfl_xor(m, 2)); m = fmaxf(m, __shfl_xor(m, 4)); m = fmaxf(m, __shfl_xor(m, 8));
                const int head = (u.pn - 2) * 4 + bj * 2 + (wc >> 1), b = (u.pm * 256) / SEQ;
                if (fr == 0 && fq == 0) atomicMax(kmaxh + ((b * 8 + head) * 2 + (wc & 1)), __float_as_uint(m)); }
        }
    }
};

__device__ __forceinline__ void transpose_item(const float* __restrict__ W, int ldw, int c0, bf16_t* WT, int r0, LAS float* scr, int item, int nblk, int lane) {
    const int k0 = 64 * (item / nblk), n0 = 32 * (item % nblk);
#pragma unroll 8
    for (int i = 0; i < 32; ++i) { const int kk = 2 * i + (lane >> 5); scr[kk * 33 + (lane & 31)] = W[(size_t)(k0 + kk) * ldw + c0 + n0 + (lane & 31)]; }
    asm volatile("s_waitcnt lgkmcnt(0)" ::: "memory");
    const int c = lane & 7;
#pragma unroll
    for (int j = 0; j < 4; ++j) { const int n = (lane >> 3) + 8 * j; const LAS float* s = scr + (8 * c) * 33 + n;
        u32x4 o; o.x = pk2(s[0 * 33], s[1 * 33]); o.y = pk2(s[2 * 33], s[3 * 33]); o.z = pk2(s[4 * 33], s[5 * 33]); o.w = pk2(s[6 * 33], s[7 * 33]);
        *(u32x4*)(WT + (size_t)(r0 + n0 + n) * 1024 + k0 + 8 * c) = o; }
    asm volatile("s_waitcnt lgkmcnt(0)" ::: "memory");
}
__device__ __forceinline__ void qrow_load(f32x4 (&v)[4], const float* __restrict__ src, int row, int lane) {
#pragma unroll
    for (int j = 0; j < 4; ++j) v[j] = *(const f32x4*)(src + (size_t)row * 1024 + 256 * j + 4 * lane);
}
__device__ __forceinline__ void qrow_store(const f32x4 (&v)[4], unsigned char* q, float* scale, int row, int lane) {
    float ss = 0.f;
#pragma unroll
    for (int j = 0; j < 4; ++j) ss += v[j].x * v[j].x + v[j].y * v[j].y + v[j].z * v[j].z + v[j].w * v[j].w;
    ss = wave_sum(ss);
    const float sc = ss > 0.f ? 0.3352f * sqrtf(ss * (1.f / 1024.f)) : 1.f, inv = __builtin_amdgcn_rcpf(sc);
    unsigned n[16];
#pragma unroll
    for (int j = 0; j < 4; ++j) {
#pragma unroll
        for (int i = 0; i < 4; ++i) { const float f = floorf(v[j][i] * inv) + 8.f; n[4 * j + i] = (unsigned)fminf(fmaxf(f, 0.f), 15.f); } }
    u32x2 o;
#pragma unroll
    for (int m = 0; m < 2; ++m) { unsigned w = 0;
#pragma unroll
        for (int b = 0; b < 4; ++b) w |= (n[8 * m + b] | (n[8 * m + 4 + b] << 4)) << (8 * b);
        o[m] = w; }
    *(u32x2*)(q + (size_t)row * 1024 + lane * 16) = o;
    if (lane == 0) scale[row] = sc;
}
__device__ __forceinline__ void h_rows(const float* __restrict__ x, const float* __restrict__ g, const float* __restrict__ mod, const float* __restrict__ wff, const float* __restrict__ bf, bf16_t* H, float* logf, int t0, int t1, int lane) {
    if (t0 >= t1) return;
    const int b = t0 / SEQ;
    const float* shift = mod + b * 6144, * scale = shift + 1024;
    f32x4 gm[4], sh[4];
#pragma unroll
    for (int j = 0; j < 4; ++j) { const int c0 = 256 * j + 4 * lane; gm[j] = *(const f32x4*)(g + c0) * (*(const f32x4*)(scale + c0) + 1.f); sh[j] = *(const f32x4*)(shift + c0); }
    const float bfl = (lane < 8) ? bf[lane] : 0.f;
    f32x4 nx[4];
#pragma unroll
    for (int j = 0; j < 4; ++j) nx[j] = *(const f32x4*)(x + (size_t)t0 * 1024 + 256 * j + 4 * lane);
    for (int t = t0; t < t1; ++t) {
        f32x4 v[4]; float s = 0.f;
#pragma unroll
        for (int j = 0; j < 4; ++j) { v[j] = nx[j]; s += v[j].x * v[j].x + v[j].y * v[j].y + v[j].z * v[j].z + v[j].w * v[j].w; }
        if (t + 1 < t1) {
#pragma unroll
            for (int j = 0; j < 4; ++j) nx[j] = *(const f32x4*)(x + (size_t)(t + 1) * 1024 + 256 * j + 4 * lane);
        }
        const float rstd = rsqrtf(wave_sum(s) * (1.f / 1024.f) + EPS);
        float ff[8];
#pragma unroll
        for (int i = 0; i < 8; ++i) ff[i] = 0.f;
#pragma unroll
        for (int j = 0; j < 4; ++j) {
            const int c0 = 256 * j + 4 * lane;
            const f32x4 h = v[j] * rstd * gm[j] + sh[j];
            u32x2 o; o.x = pk2(h.x, h.y); o.y = pk2(h.z, h.w);
            *(u32x2*)(H + (size_t)t * 1024 + c0) = o;
#pragma unroll
            for (int i = 0; i < 8; ++i) { const f32x4 w = *(const f32x4*)(wff + i * 1024 + c0); ff[i] += h.x * w.x + h.y * w.y + h.z * w.z + h.w * w.w; }
        }
#pragma unroll
        for (int i = 0; i < 8; ++i) ff[i] = wave_sum(ff[i]);
        if (lane < 8) {
            float z = 0.f;
#pragma unroll
            for (int i = 0; i < 8; ++i) z = (lane == i) ? ff[i] : z;
            z += bfl;
            logf[(size_t)t * 8 + lane] = fminf(z, 0.f) - log1pf(__expf(-fabsf(z)));
        }
    }
}

__device__ __forceinline__ void row_passes(const float* __restrict__ x, const bf16_t* __restrict__ mix, const float* __restrict__ mod, const float* __restrict__ g_post, const float* __restrict__ g_pre, bf16_t* XB, bf16_t* H2, int t0, int t1, int lane) {
    if (t0 >= t1) return;
    const int b = t0 / SEQ; const float* md = mod + b * 6144;
    f32x4 ga[4], gp[4], shf[4];
#pragma unroll
    for (int j = 0; j < 4; ++j) { const int c0 = 256 * j + 4 * lane; ga[j] = *(const f32x4*)(md + 2048 + c0) * *(const f32x4*)(g_post + c0);
        gp[j] = *(const f32x4*)(g_pre + c0) * (*(const f32x4*)(md + 4096 + c0) + 1.f); shf[j] = *(const f32x4*)(md + 3072 + c0); }
    f32x4 nx[4]; u32x2 nm[4];
#pragma unroll
    for (int j = 0; j < 4; ++j) { const int c0 = 256 * j + 4 * lane; nx[j] = *(const f32x4*)(x + (size_t)t0 * 1024 + c0); nm[j] = *(const u32x2*)(mix + (size_t)t0 * 1024 + c0); }
    for (int t = t0; t < t1; ++t) {
        f32x4 m[4], xv[4]; float s = 0.f;
#pragma unroll
        for (int j = 0; j < 4; ++j) { const u32x2 w = nm[j]; xv[j] = nx[j];
            m[j] = (f32x4){__uint_as_float(w.x << 16), __uint_as_float(w.x & 0xffff0000u), __uint_as_float(w.y << 16), __uint_as_float(w.y & 0xffff0000u)};
            s += m[j].x * m[j].x + m[j].y * m[j].y + m[j].z * m[j].z + m[j].w * m[j].w; }
        if (t + 1 < t1) {
#pragma unroll
            for (int j = 0; j < 4; ++j) { const int c0 = 256 * j + 4 * lane; nx[j] = *(const f32x4*)(x + (size_t)(t + 1) * 1024 + c0); nm[j] = *(const u32x2*)(mix + (size_t)(t + 1) * 1024 + c0); }
        }
        const float r1 = rsqrtf(wave_sum(s) * (1.f / 1024.f) + EPS);
        float s2 = 0.f;
#pragma unroll
        for (int j = 0; j < 4; ++j) { const int c0 = 256 * j + 4 * lane;
            xv[j] = xv[j] + ga[j] * (m[j] * r1);
            { u32x2 xo; xo.x = pk2(xv[j].x, xv[j].y); xo.y = pk2(xv[j].z, xv[j].w); *(u32x2*)(XB + (size_t)t * 1024 + c0) = xo; }
            s2 += xv[j].x * xv[j].x + xv[j].y * xv[j].y + xv[j].z * xv[j].z + xv[j].w * xv[j].w; }
        const float r2 = rsqrtf(wave_sum(s2) * (1.f / 1024.f) + EPS);
#pragma unroll
        for (int j = 0; j < 4; ++j) { const int c0 = 256 * j + 4 * lane;
            const f32x4 h = xv[j] * r2 * gp[j] + shf[j];
            u32x2 o; o.x = pk2(h.x, h.y); o.y = pk2(h.z, h.w);
            *(u32x2*)(H2 + (size_t)t * 1024 + c0) = o; }
    }
}

__device__ __forceinline__ float gelu_as(float v) {
    const float av = fabsf(v), t = __builtin_amdgcn_rcpf(av * 0.2316418882f + 1.0f);
    float q = t * 0.5307027145f + (-0.7265760135f); q = q * t + 0.7107068705f; q = q * t + (-0.142248368f); q = q * t + 0.127414796f; q = q * t;
    const float m = v * (q * __builtin_amdgcn_exp2f((v * v) * (-0.72134752044f)));
    return v < 0.f ? m : v - m;
}
constexpr int EB = 16;
__device__ __forceinline__ void expert_token(const unsigned char* __restrict__ UV, const float* __restrict__ US, const float* __restrict__ VS,
                                             const int* __restrict__ IDX, const float* __restrict__ GATE, const LAS float* pv  ,
                                             const bf16_t* __restrict__ xin, float* out, int t, int lane, int rmask, float pscale) {
    float s2 = 0.f;
    float hv[16]; float mx = 0.f;
    {
    f32x4 x1[4];
#pragma unroll
    for (int j = 0; j < 4; ++j) { const u32x2 xw = *(const u32x2*)(xin + (size_t)t * 1024 + 256 * j + 4 * lane);
        x1[j] = (f32x4){__uint_as_float(xw.x << 16), __uint_as_float(xw.x & 0xffff0000u), __uint_as_float(xw.y << 16), __uint_as_float(xw.y & 0xffff0000u)}; s2 += x1[j].x * x1[j].x + x1[j].y * x1[j].y + x1[j].z * x1[j].z + x1[j].w * x1[j].w; }
    const float r2 = rsqrtf(wave_sum(s2) * (1.f / 1024.f) + EPS);
#pragma unroll
    for (int j = 0; j < 4; ++j) { const f32x4 h = x1[j] * r2 * *(const LAS f32x4*)(pv + 256 * j + 4 * lane) + *(const LAS f32x4*)(pv + 1024 + 256 * j + 4 * lane);
        hv[4 * j] = h.x; hv[4 * j + 1] = h.y; hv[4 * j + 2] = h.z; hv[4 * j + 3] = h.w;
        mx = fmaxf(mx, fmaxf(fmaxf(fabsf(h.x), fabsf(h.y)), fmaxf(fabsf(h.z), fabsf(h.w)))); }
    }
    const int i0 = IDX[(size_t)t * 128 + lane] & rmask, i1 = IDX[(size_t)t * 128 + 64 + lane] & rmask;
    const float g0 = GATE[(size_t)t * 128 + lane], g1 = GATE[(size_t)t * 128 + 64 + lane];
    const float su0 = US[i0], su1 = US[i1], sv0 = VS[i0], sv1 = VS[i1];
    mx = wave_max(mx);
    const float sx = mx > 0.f ? mx / 127.f : 1.f, isx = 1.f / sx;
    int xq[4]; int xs = 0;
#pragma unroll
    for (int j = 0; j < 4; ++j) { const int q0 = (int)rintf(hv[4 * j] * isx), q1 = (int)rintf(hv[4 * j + 1] * isx), q2 = (int)rintf(hv[4 * j + 2] * isx), q3 = (int)rintf(hv[4 * j + 3] * isx);
        xs += q0 + q1 + q2 + q3;
        xq[j] = (int)((unsigned)(q0 & 255) | ((unsigned)(q1 & 255) << 8) | ((unsigned)(q2 & 255) << 16) | ((unsigned)(q3 & 255) << 24)); }
#pragma unroll
    for (int o = 1; o < 64; o <<= 1) xs += __shfl_xor(xs, o);
    const float xoff = 7.5f * (float)xs;
    const int el = ((lane >> 5) & 1) * 8 + ((lane >> 4) & 1) * 4 + ((lane >> 1) & 1) * 2 + (lane & 1);
    float acc[16];
#pragma unroll
    for (int i = 0; i < 16; ++i) acc[i] = 0.f;
    float sumc = 0.f;
    const unsigned lo16 = (unsigned)lane * 16u;
    u32x4 rb[EB];
#pragma unroll
    for (int e = 0; e < EB; ++e) { const unsigned row = (unsigned)__builtin_amdgcn_readlane(i0, e); rb[e] = *(const u32x4*)(UV + (row * 1024u + lo16)); }
#pragma unroll 1
    for (int bi = 0; bi < 128 / EB; ++bi) {
        u32x4 rn[EB];
        {
            const int nb = (bi + 1) & 7, srcn = (nb < 4) ? i0 : i1, ln = (nb & 3) * EB;
#pragma unroll
            for (int e = 0; e < EB; ++e) { const unsigned row = (unsigned)__builtin_amdgcn_readlane(srcn, ln + e); rn[e] = *(const u32x4*)(UV + (row * 1024u + lo16)); }
        }
        int d[EB];
#pragma unroll
        for (int e = 0; e < EB; ++e) { const unsigned w0 = rb[e].x, w1 = rb[e].y;
            int s = __builtin_amdgcn_sdot4(xq[0], (int)(w0 & 0x0F0F0F0Fu), 0, false); s = __builtin_amdgcn_sdot4(xq[1], (int)((w0 >> 4) & 0x0F0F0F0Fu), s, false);
            s = __builtin_amdgcn_sdot4(xq[2], (int)(w1 & 0x0F0F0F0Fu), s, false); d[e] = __builtin_amdgcn_sdot4(xq[3], (int)((w1 >> 4) & 0x0F0F0F0Fu), s, false); }
        int d8[8], d4[4], d2[2], d1;
#pragma unroll
        for (int k = 0; k < 8; ++k) { const auto r = __builtin_amdgcn_permlane32_swap((unsigned)d[k], (unsigned)d[8 + k], false, false); d8[k] = (int)(r[0] + r[1]); }
#pragma unroll
        for (int k = 0; k < 4; ++k) { const auto r = __builtin_amdgcn_permlane16_swap((unsigned)d8[k], (unsigned)d8[4 + k], false, false); d4[k] = (int)(r[0] + r[1]); }
        { const bool up = (lane & 2) != 0;
#pragma unroll
          for (int k = 0; k < 2; ++k) { const int keep = up ? d4[2 + k] : d4[k], give = up ? d4[k] : d4[2 + k]; d2[k] = keep + __builtin_amdgcn_update_dpp(0, give, 0x4E, 0xF, 0xF, false); } }
        { const bool up = (lane & 1) != 0; const int keep = up ? d2[1] : d2[0], give = up ? d2[0] : d2[1]; d1 = keep + __builtin_amdgcn_update_dpp(0, give, 0xB1, 0xF, 0xF, false); }
        d1 += __builtin_amdgcn_update_dpp(0, d1, 0x128, 0xF, 0xF, false);
        d1 += __builtin_amdgcn_update_dpp(0, d1, 0x124, 0xF, 0xF, false);
        const int ei = bi * EB + el;
        const int ba = (ei & 63) * 4;
        const float gsel = __uint_as_float((unsigned)__builtin_amdgcn_ds_bpermute(ba, (int)__float_as_uint((bi < 4) ? g0 : g1)));
        const float susel = __uint_as_float((unsigned)__builtin_amdgcn_ds_bpermute(ba, (int)__float_as_uint((bi < 4) ? su0 : su1)));
        const float svsel = __uint_as_float((unsigned)__builtin_amdgcn_ds_bpermute(ba, (int)__float_as_uint((bi < 4) ? sv0 : sv1)));
        const float aval = ((float)d1 - xoff) * sx * susel;
        const float cl = gsel * gelu_as(aval) * svsel;
#pragma unroll
        for (int e = 0; e < EB; ++e) {
            const float ce = __uint_as_float((unsigned)__builtin_amdgcn_readlane((int)__float_as_uint(cl), ((e >> 3) & 1) * 32 + ((e >> 2) & 1) * 16 + ((e >> 1) & 1) * 2 + (e & 1)));
            sumc += ce;
#pragma unroll
            for (int m = 0; m < 2; ++m) { const unsigned w = rb[e][2 + m], lo = w & 0x0F0F0F0Fu, hi = (w >> 4) & 0x0F0F0F0Fu;
                float f[8];
                asm("v_cvt_f32_ubyte0 %0, %1" : "=v"(f[0]) : "v"(lo)); asm("v_cvt_f32_ubyte1 %0, %1" : "=v"(f[1]) : "v"(lo)); asm("v_cvt_f32_ubyte2 %0, %1" : "=v"(f[2]) : "v"(lo)); asm("v_cvt_f32_ubyte3 %0, %1" : "=v"(f[3]) : "v"(lo));
                asm("v_cvt_f32_ubyte0 %0, %1" : "=v"(f[4]) : "v"(hi)); asm("v_cvt_f32_ubyte1 %0, %1" : "=v"(f[5]) : "v"(hi)); asm("v_cvt_f32_ubyte2 %0, %1" : "=v"(f[6]) : "v"(hi)); asm("v_cvt_f32_ubyte3 %0, %1" : "=v"(f[7]) : "v"(hi));
#pragma unroll
                for (int i = 0; i < 8; ++i) acc[8 * m + i] += ce * f[i]; }
        }
#pragma unroll
        for (int e = 0; e < EB; ++e) rb[e] = rn[e];
    }
    float sy = 0.f;
#pragma unroll
    for (int i = 0; i < 16; ++i) { acc[i] -= 7.5f * sumc; sy += acc[i] * acc[i]; }
    const float ry = rsqrtf(wave_sum(sy) * (1.f / 1024.f) + EPS);
#pragma unroll
    for (int j = 0; j < 4; ++j) { const f32x4 y = (f32x4){acc[4 * j], acc[4 * j + 1], acc[4 * j + 2], acc[4 * j + 3]};
        float* op = out + (size_t)t * 1024 + 256 * j + 4 * lane;
        const u32x2 xw = *(const u32x2*)(xin + (size_t)t * 1024 + 256 * j + 4 * lane);
        *(f32x4*)op = pscale * (f32x4){__uint_as_float(xw.x << 16), __uint_as_float(xw.x & 0xffff0000u), __uint_as_float(xw.y << 16), __uint_as_float(xw.y & 0xffff0000u)} + pscale * *(const LAS f32x4*)(pv + 2048 + 256 * j + 4 * lane) * (y * ry); }
}

#define CE_DESC(a, b) do { const float _t = fmaxf(a, b); b = fminf(a, b); a = _t; } while (0)
__device__ __forceinline__ void sort16_desc(float (&v)[16]) {
#pragma unroll
    for (int k = 2; k <= 16; k <<= 1)
#pragma unroll
        for (int j = k >> 1; j > 0; j >>= 1)
#pragma unroll
            for (int i = 0; i < 16; ++i) { const int l = i ^ j; if (l > i) { if ((i & k) == 0 || k == 16) CE_DESC(v[i], v[l]); else CE_DESC(v[l], v[i]); } }
}
__device__ __forceinline__ void merge16_desc(float (&a)[16], const float (&b)[16]) {
#pragma unroll
    for (int i = 0; i < 16; ++i) a[i] = fmaxf(a[i], b[15 - i]);
#pragma unroll
    for (int j = 8; j > 0; j >>= 1)
#pragma unroll
        for (int i = 0; i < 16; ++i) { const int l = i ^ j; if (l > i) CE_DESC(a[i], a[l]); }
}
#define CE2_DESC(va, pa, vb, pb) do { const bool _c = (va) >= (vb); const float _tv = _c ? (va) : (vb), _tw = _c ? (vb) : (va); const int _tp = _c ? (pa) : (pb), _tq = _c ? (pb) : (pa); va = _tv; vb = _tw; pa = _tp; pb = _tq; } while (0)
template <int N> __device__ __forceinline__ void bitonic_merge_desc2(float (&v)[N], int (&p)[N]) {
#pragma unroll
    for (int j = N / 2; j > 0; j >>= 1)
#pragma unroll
        for (int i = 0; i < N; ++i) { const int l = i ^ j; if (l > i) CE2_DESC(v[i], p[i], v[l], p[l]); }
}
__device__ __forceinline__ void merge16_desc2(float (&a)[16], int (&pa)[16], const float (&b)[16], const int (&pb)[16]) {
#pragma unroll
    for (int i = 0; i < 16; ++i) { const bool c = a[i] >= b[15 - i]; pa[i] = c ? pa[i] : pb[15 - i]; a[i] = c ? a[i] : b[15 - i]; }
    bitonic_merge_desc2<16>(a, pa);
}
__device__ __forceinline__ void sort8_desc2(float (&v)[8], int (&p)[8]) {
#pragma unroll
    for (int k = 2; k <= 8; k <<= 1)
#pragma unroll
        for (int j = k >> 1; j > 0; j >>= 1)
#pragma unroll
            for (int i = 0; i < 8; ++i) { const int l = i ^ j; if (l > i) { if ((i & k) == 0 || k == 8) CE2_DESC(v[i], p[i], v[l], p[l]); else CE2_DESC(v[l], p[l], v[i], p[i]); } }
}
constexpr int RT_KROW = 272;
__device__ __forceinline__ void route_half(float (&top)[16], LAS const unsigned char* keys_lds, const bf16_t* __restrict__ qrow, int r32, int hi) {
    bf16x8 qf[8]; float ss = 0.f;
#pragma unroll
    for (int ks = 0; ks < 8; ++ks) { qf[ks] = *(const bf16x8*)(qrow + 16 * ks + 8 * hi);
#pragma unroll
        for (int j = 0; j < 8; ++j) { const float f = bf2f((bf16_t)qf[ks][j]); ss += f * f; } }
    ss += __shfl_xor(ss, 32);
    const float rn = rsqrtf(ss * (1.f / 128.f) + EPS);
    f32x16 acc[4];
#pragma unroll
    for (int kt = 0; kt < 4; ++kt) {
#pragma unroll
        for (int r = 0; r < 16; ++r) acc[kt][r] = 0.f;
#pragma unroll
        for (int ks = 0; ks < 8; ++ks) { const bf16x8 kf = *(LAS const bf16x8*)(keys_lds + (32 * kt + r32) * RT_KROW + (16 * ks + 8 * hi) * 2);
            acc[kt] = __builtin_amdgcn_mfma_f32_32x32x16_bf16(kf, qf[ks], acc[kt], 0, 0, 0); }
        __builtin_amdgcn_sched_barrier(0);
    }
    const unsigned hi4 = (unsigned)hi << 2;
    float g[4][16];
#pragma unroll
    for (int kt = 0; kt < 4; ++kt)
#pragma unroll
        for (int r = 0; r < 16; ++r) { const unsigned base = (unsigned)(32 * kt + (r & 3) + 8 * (r >> 2)); g[kt][r] = __uint_as_float((__float_as_uint(acc[kt][r] * rn) & 0xFFFFFF80u) | base); }
#pragma unroll
    for (int kt = 0; kt < 4; ++kt) sort16_desc(g[kt]);
    merge16_desc(g[0], g[1]); merge16_desc(g[2], g[3]); merge16_desc(g[0], g[2]);
    float o[16];
#pragma unroll
    for (int i = 0; i < 16; ++i) { g[0][i] = __uint_as_float(__float_as_uint(g[0][i]) | hi4); o[i] = __shfl_xor(g[0][i], 32); }
    merge16_desc(g[0], o);
#pragma unroll
    for (int i = 0; i < 16; ++i) top[i] = g[0][i];
}
__device__ __forceinline__ void route_final(const float (&A)[16], const float (&B)[16], LAS unsigned char* tab, int* idx_out, float* gate_out, bool writer) {
    {
        unsigned w[8];
#pragma unroll
        for (int q = 0; q < 4; ++q) {
            w[q] = (__float_as_uint(A[4 * q]) & 127u) | ((__float_as_uint(A[4 * q + 1]) & 127u) << 8) | ((__float_as_uint(A[4 * q + 2]) & 127u) << 16) | ((__float_as_uint(A[4 * q + 3]) & 127u) << 24);
            w[4 + q] = (__float_as_uint(B[4 * q]) & 127u) | ((__float_as_uint(B[4 * q + 1]) & 127u) << 8) | ((__float_as_uint(B[4 * q + 2]) & 127u) << 16) | ((__float_as_uint(B[4 * q + 3]) & 127u) << 24);
        }
        *(LAS u32x4*)(tab) = (u32x4){w[0], w[1], w[2], w[3]}; *(LAS u32x4*)(tab + 16) = (u32x4){w[4], w[5], w[6], w[7]};
    }
    const float NEG = -INFINITY;
#define CAND(i, j) __uint_as_float((__float_as_uint(A[i] + B[j]) & 0xFFFFFF00u) | (unsigned)(((i) << 4) | (j)))
    float m1[16], m2[16], m3[16];
#pragma unroll
    for (int j = 0; j < 16; ++j) m1[j] = CAND(0, j);
#pragma unroll
    for (int i = 0; i < 16; ++i) m2[i] = (i < 15) ? CAND((i < 15 ? i + 1 : 0), 0) : NEG;
    merge16_desc(m1, m2);
    __builtin_amdgcn_sched_barrier(0);
#pragma unroll
    for (int j = 0; j < 16; ++j) m3[j] = (j < 7) ? CAND(1, (j < 7 ? j + 1 : 0)) : NEG;
#pragma unroll
    for (int i = 0; i < 16; ++i) m2[i] = (i < 6) ? CAND((i < 6 ? i + 2 : 0), 1) : NEG;
    merge16_desc(m3, m2);
    __builtin_amdgcn_sched_barrier(0);
    m2[0] = CAND(2, 2); m2[1] = CAND(2, 3); m2[2] = CAND(2, 4); m2[3] = CAND(3, 2); m2[4] = CAND(4, 2); m2[5] = CAND(3, 3);
#pragma unroll
    for (int i = 6; i < 16; ++i) m2[i] = NEG;
    sort16_desc(m2);
    merge16_desc(m3, m2);
    merge16_desc(m1, m3);
    __builtin_amdgcn_sched_barrier(0);
#undef CAND
    float e[16], den = 0.f; int ex[16];
#pragma unroll
    for (int i = 0; i < 16; ++i) { e[i] = __expf(m1[i] - m1[0]); den += e[i]; const unsigned r = __float_as_uint(m1[i]) & 255u; ex[i] = (int)tab[r >> 4] * 128 + (int)tab[16 + (r & 15u)]; }
    const float inv = 1.f / den;
    if (writer) {
#pragma unroll
        for (int i = 0; i < 4; ++i) { *(u32x4*)(idx_out + 4 * i) = (u32x4){(unsigned)ex[4 * i], (unsigned)ex[4 * i + 1], (unsigned)ex[4 * i + 2], (unsigned)ex[4 * i + 3]};
            *(f32x4*)(gate_out + 4 * i) = (f32x4){e[4 * i] * inv, e[4 * i + 1] * inv, e[4 * i + 2] * inv, e[4 * i + 3] * inv}; }
    }
}

namespace fa {
typedef short s16x4 __attribute__((ext_vector_type(4)));
constexpr int SLOT_V = 8192, SLOT_F = 16384, SLOT_BYTES = 16384 + 256;
constexpr int LDS_WS = 2 * SLOT_BYTES, LDS_OST = LDS_WS + 8 * 64 * 4, LDS_TOTAL = LDS_OST + 8 * 4096;
__device__ __forceinline__ int crow(int r, int hi) { return (r & 3) + 8 * (r >> 2) + 4 * hi; }
__device__ __forceinline__ void attn_unit(LAS unsigned char* lds, const bf16_t* __restrict__ PROJ, const float* __restrict__ F2T, bf16_t* OCAT, int b, int h, int qb, float kmax) {
    const int tid = ptid(), lane = tid & 63, r32 = lane & 31, hi = lane >> 5; const int wid = __builtin_amdgcn_readfirstlane(tid >> 6);
    const size_t rowbase = (size_t)b * SEQ; const int q0 = qb * 256;
    const bf16_t* Qw = PROJ + (rowbase + q0 + wid * 32) * NPROJ + C_Q + h * 64;
    const bf16_t* Kh = PROJ + rowbase * NPROJ + C_K + h * 64;
    const bf16_t* Vh = PROJ + rowbase * NPROJ + C_V + h * 64;
    const float* Fh = F2T + (size_t)(b * 8 + h) * SEQ;
    LAS float* wsf = (LAS float*)(lds + LDS_WS) + wid * 64;
    bf16x8 qr[4];
#pragma unroll
    for (int d0 = 0; d0 < 4; ++d0) qr[d0] = *(const bf16x8*)(Qw + (size_t)r32 * NPROJ + d0 * 16 + hi * 8);
    const float Fq = Fh[q0 + wid * 32 + r32];
    const int NT = 4 * qb + 4;
    int t0; float c0;
    {
        float qs = 0.f;
#pragma unroll
        for (int d0 = 0; d0 < 4; ++d0)
#pragma unroll
            for (int j = 0; j < 8; ++j) { const float f = bf2f((bf16_t)qr[d0][j]); qs += f * f; }
        qs += __shfl_xor(qs, 32);
        qs = wave_max(qs);
        if (lane == 0) wsf[0] = qs;
        __syncthreads();
        float qm = 0.f;
#pragma unroll
        for (int w = 0; w < 8; ++w) qm = fmaxf(qm, ((LAS float*)(lds + LDS_WS))[w * 64]);
        c0 = sqrtf(qm) * kmax;
        const float bound = 2.f * c0 + Fh[q0] + 40.f;
        const bool skip = (lane < NT - 4) && (bound - Fh[64 * lane + 63] < 0.f);
        const unsigned long long bal = __ballot(skip);
        t0 = __builtin_amdgcn_readfirstlane((int)__builtin_ctzll(~bal));
        __syncthreads();
    }
    const int krow = 8 * wid + (lane >> 3), kch = lane & 7;
    const bf16_t* ksrc = Kh + (size_t)krow * NPROJ + kch * 8;
    const int kdst = krow * 128 + ((kch ^ (krow & 7)) * 16);
    const bf16_t* vsrc = Vh + (size_t)(16 * (wid & 3) + (lane >> 2)) * NPROJ + (wid >> 2) * 32 + (lane & 3) * 8;
    const int sdst = wid * 1024 + lane * 16;
    u32x4 kreg = *(const u32x4*)(ksrc + (size_t)t0 * 64 * NPROJ), vreg = *(const u32x4*)(vsrc + (size_t)t0 * 64 * NPROJ);
    float freg = (wid == 0) ? Fh[t0 * 64 + lane] : 0.f;
    *(LAS u32x4*)(lds + kdst) = kreg; *(LAS u32x4*)(lds + SLOT_V + sdst) = vreg; if (wid == 0) *(LAS float*)(lds + SLOT_F + lane * 4) = freg;
    if (t0 + 1 < NT) { kreg = *(const u32x4*)(ksrc + (size_t)(t0 + 1) * 64 * NPROJ); vreg = *(const u32x4*)(vsrc + (size_t)(t0 + 1) * 64 * NPROJ); if (wid == 0) freg = Fh[(t0 + 1) * 64 + lane]; }
    __syncthreads();
    float l = 0.f; f32x16 o[2]; const float Fqs = Fq - c0;
#pragma unroll
    for (int r = 0; r < 16; ++r) { o[0][r] = 0.f; o[1][r] = 0.f; }
    const int qrel = wid * 32 + r32;
    int cur = 0;
    for (int t = t0; t < NT; ++t) {
        const bool more = (t + 1 < NT);
        u32x4 kreg2 = kreg, vreg2 = vreg; float freg2 = freg;
        if (t + 2 < NT) { kreg2 = *(const u32x4*)(ksrc + (size_t)(t + 2) * 64 * NPROJ); vreg2 = *(const u32x4*)(vsrc + (size_t)(t + 2) * 64 * NPROJ); if (wid == 0) freg2 = Fh[(t + 2) * 64 + lane]; }
        LAS unsigned char* slot = lds + cur * SLOT_BYTES;
        f32x16 p0, p1;
        { const LAS float* fk = (const LAS float*)(slot + SLOT_F);
#pragma unroll
          for (int g = 0; g < 4; ++g) { const f32x4 a = *(const LAS f32x4*)(fk + 8 * g + 4 * hi), c = *(const LAS f32x4*)(fk + 32 + 8 * g + 4 * hi);
#pragma unroll
              for (int i = 0; i < 4; ++i) { p0[4 * g + i] = Fqs - a[i]; p1[4 * g + i] = Fqs - c[i]; } } }
        { const LAS unsigned char* kb = slot + r32 * 128; const int sw = r32 & 7;
#pragma unroll
          for (int d0 = 0; d0 < 4; ++d0) { const int co = ((2 * d0 + hi) ^ sw) * 16; const bf16x8 b0 = *(const LAS bf16x8*)(kb + co), b1 = *(const LAS bf16x8*)(kb + co + 4096);
              p0 = __builtin_amdgcn_mfma_f32_32x32x16_bf16(b0, qr[d0], p0, 0, 0, 0); p1 = __builtin_amdgcn_mfma_f32_32x32x16_bf16(b1, qr[d0], p1, 0, 0, 0); } }
        const int jb = t - (NT - 4);
        if (jb >= 0) { const int kb0 = 64 * jb + 4 * hi;
#pragma unroll
            for (int r = 0; r < 16; ++r) { const int kv = kb0 + (r & 3) + 8 * (r >> 2); if (kv > qrel) p0[r] = -INFINITY; if (kv + 32 > qrel) p1[r] = -INFINITY; } }
        float rs = 0.f;
#pragma unroll
        for (int r = 0; r < 16; ++r) { p0[r] = __builtin_amdgcn_exp2f(p0[r]); p1[r] = __builtin_amdgcn_exp2f(p1[r]); rs += p0[r] + p1[r]; }
        l += rs;
        u32x4 pw0, pw1, pw2, pw3;
        pw0 = (u32x4){cvt_pk_bf16(p0[0], p0[1]), cvt_pk_bf16(p0[2], p0[3]), cvt_pk_bf16(p0[4], p0[5]), cvt_pk_bf16(p0[6], p0[7])};
        pw1 = (u32x4){cvt_pk_bf16(p0[8], p0[9]), cvt_pk_bf16(p0[10], p0[11]), cvt_pk_bf16(p0[12], p0[13]), cvt_pk_bf16(p0[14], p0[15])};
        pw2 = (u32x4){cvt_pk_bf16(p1[0], p1[1]), cvt_pk_bf16(p1[2], p1[3]), cvt_pk_bf16(p1[4], p1[5]), cvt_pk_bf16(p1[6], p1[7])};
        pw3 = (u32x4){cvt_pk_bf16(p1[8], p1[9]), cvt_pk_bf16(p1[10], p1[11]), cvt_pk_bf16(p1[12], p1[13]), cvt_pk_bf16(p1[14], p1[15])};
        { const int vb = (int)(unsigned)(size_t)(slot + SLOT_V) + ((lane >> 4) & 1) * 32 + (lane & 3) * 8 + (4 * hi + ((lane & 15) >> 2)) * 64;
#pragma unroll
          for (int d0 = 0; d0 < 2; ++d0) { s16x4 lo4[4], hi4[4];
#pragma unroll
              for (int ks = 0; ks < 4; ++ks) {
                  asm volatile("ds_read_b64_tr_b16 %0,%1 offset:%c2" : "=&v"(lo4[ks]) : "v"(vb), "i"(d0 * 4096 + ks * 1024) : "memory");
                  asm volatile("ds_read_b64_tr_b16 %0,%1 offset:%c2" : "=&v"(hi4[ks]) : "v"(vb), "i"(d0 * 4096 + ks * 1024 + 512) : "memory"); }
              asm volatile("s_waitcnt lgkmcnt(0)" ::: "memory"); __builtin_amdgcn_sched_barrier(0);
#define FA_PK(k) (bf16x8){lo4[k][0], lo4[k][1], lo4[k][2], lo4[k][3], hi4[k][0], hi4[k][1], hi4[k][2], hi4[k][3]}
              o[d0] = __builtin_amdgcn_mfma_f32_32x32x16_bf16(__builtin_bit_cast(bf16x8, pw0), FA_PK(0), o[d0], 0, 0, 0);
              o[d0] = __builtin_amdgcn_mfma_f32_32x32x16_bf16(__builtin_bit_cast(bf16x8, pw1), FA_PK(1), o[d0], 0, 0, 0);
              o[d0] = __builtin_amdgcn_mfma_f32_32x32x16_bf16(__builtin_bit_cast(bf16x8, pw2), FA_PK(2), o[d0], 0, 0, 0);
              o[d0] = __builtin_amdgcn_mfma_f32_32x32x16_bf16(__builtin_bit_cast(bf16x8, pw3), FA_PK(3), o[d0], 0, 0, 0);
#undef FA_PK
          } }
        if (more) { LAS unsigned char* nslot = lds + (cur ^ 1) * SLOT_BYTES;
            *(LAS u32x4*)(nslot + kdst) = kreg; *(LAS u32x4*)(nslot + SLOT_V + sdst) = vreg; if (wid == 0) *(LAS float*)(nslot + SLOT_F + lane * 4) = freg; }
        __syncthreads();
        cur ^= 1; kreg = kreg2; vreg = vreg2; freg = freg2;
    }
    l += __shfl_xor(l, 32);
    if (hi == 0) wsf[32 + r32] = l;
    asm volatile("s_waitcnt lgkmcnt(0)" ::: "memory");
    float rli[16];
#pragma unroll
    for (int r = 0; r < 16; ++r) rli[r] = __builtin_amdgcn_rcpf(wsf[32 + crow(r, hi)]);
    bf16_t* Ow = OCAT + (rowbase + q0 + wid * 32) * 1024 + h * 64;
    LAS bf16_t* stg = (LAS bf16_t*)(lds + LDS_OST) + wid * 2048;
#pragma unroll
    for (int r = 0; r < 16; ++r) { const int orow = crow(r, hi);
#pragma unroll
        for (int d0 = 0; d0 < 2; ++d0) stg[orow * 64 + d0 * 32 + r32] = f2bf(o[d0][r] * rli[r]); }
    asm volatile("s_waitcnt lgkmcnt(0)" ::: "memory");
#pragma unroll
    for (int i = 0; i < 4; ++i) { const int row = i * 8 + (lane >> 3), ch = lane & 7; const u32x4 v = *(const LAS u32x4*)(stg + row * 64 + ch * 8); *(u32x4*)(Ow + (size_t)row * 1024 + ch * 8) = v; }
    __syncthreads();
}
}

namespace hg {
constexpr int P272 = 272, P144 = 144;
constexpr int L_SEGT = 0, L_RAW = 2048, L_RLF = L_RAW, L_RQ = L_RAW + 16384, L_RKK = L_RAW + 32768, L_RI = L_RAW + 49152;
constexpr int L_QJ = 2048, L_KH = L_QJ + 160 * P272;
constexpr int L_KT = L_RI + 64 * P272, L_IT = L_KT + 128 * P144, L_P = L_IT + 128 * P144, L_END = L_P + 64 * P144;
static_assert(L_KH + 64 * P272 <= L_KT && L_END <= RING_BYTES, "hgrn LDS");
__device__ __forceinline__ int crow(int r, int hi) { return (r & 3) + 8 * (r >> 2) + 4 * hi; }
__device__ __forceinline__ int qj_row0(int j) { return (j == 0) ? 0 : (j == 1) ? 64 : (j == 2) ? 112 : 144; }
struct RawRegs { u32x4 lf[2], q[2], kk[2], iv[2]; };
__device__ __forceinline__ void raw_load(RawRegs& R, const bf16_t* __restrict__ PROJ, const bf16_t* __restrict__ KK, int unit, int tid) {
    const int bh = unit >> 6, cch = unit & 63, b = bh >> 2, h = bh & 3; const size_t row0 = (size_t)b * SEQ + cch * 64;
#pragma unroll
    for (int it = 0; it < 2; ++it) { const int id = tid + 512 * it, t = id >> 4, ch = id & 15;
        const bf16_t* pr = PROJ + (row0 + t) * NPROJ + h * 128 + 8 * ch;
        R.lf[it] = *(const u32x4*)(pr + C_LF); R.q[it] = *(const u32x4*)(pr + C_HQ); R.iv[it] = *(const u32x4*)(pr + C_HI);
        R.kk[it] = *(const u32x4*)(KK + (row0 + t) * 512 + h * 128 + 8 * ch); }
}
template <bool DRY> __device__ __forceinline__ void pass_a_all(LAS unsigned char* lds, bf16_t* PROJ, const bf16_t* __restrict__ KK, bf16_t* HST, float* HD, int u0, int ustep, int uend) {
    const int tid = ptid(), lane = tid & 63, r32 = lane & 31, hi = lane >> 5; const int wid = __builtin_amdgcn_readfirstlane(tid >> 6);
    const int k = tid & 127, seg = tid >> 7;
    LAS float* segt = (LAS float*)(lds + L_SEGT);
    RawRegs R;
    if (u0 < uend) raw_load(R, PROJ, KK, u0, tid);
    for (int unit = u0; unit < uend; unit += ustep) {
        const int bh = unit >> 6, cch = unit & 63, b = bh >> 2, h = bh & 3;
        const size_t row0 = (size_t)b * SEQ + cch * 64;
#pragma unroll
        for (int it = 0; it < 2; ++it) { const int id = tid + 512 * it, t = id >> 4, ch = id & 15;
            *(LAS u32x4*)(lds + L_RLF + t * 256 + ch * 16) = R.lf[it]; *(LAS u32x4*)(lds + L_RQ + t * 256 + ch * 16) = R.q[it];
            *(LAS u32x4*)(lds + L_RKK + t * 256 + ch * 16) = R.kk[it]; *(LAS u32x4*)(lds + L_RI + t * P272 + ch * 16) = R.iv[it]; }
        __syncthreads();
        if (unit + ustep < uend) raw_load(R, PROJ, KK, unit + ustep, tid);
        float Aa[16], qv[16], kv[16];
        { float run = 0.f;
#pragma unroll
          for (int i = 0; i < 16; ++i) { const int off = (16 * seg + i) * 256 + k * 2;
              run += h2f(*(const LAS unsigned short*)(lds + L_RLF + off)); Aa[i] = run; qv[i] = bf2f(*(const LAS bf16_t*)(lds + L_RQ + off)); kv[i] = bf2f(*(const LAS bf16_t*)(lds + L_RKK + off)); }
          segt[seg * 128 + k] = run; }
#pragma unroll
        for (int it = 0; it < 2; ++it) { const int vc = 2 * wid + it;
            const bf16x8 v8 = *(const LAS bf16x8*)(lds + L_RI + lane * P272 + vc * 16);
#pragma unroll
            for (int e = 0; e < 8; ++e) *(LAS bf16_t*)(lds + L_IT + (8 * vc + e) * P144 + lane * 2) = (bf16_t)v8[e]; }
        __syncthreads();
        float E[4];
        { float s = 0.f;
#pragma unroll
          for (int j = 0; j < 4; ++j) { s += segt[j * 128 + k]; E[j] = s; } }
        const float pre = (seg == 0) ? 0.f : (seg == 1) ? E[0] : (seg == 2) ? E[1] : E[2];
        const float Eown = (seg == 0) ? E[0] : (seg == 1) ? E[1] : (seg == 2) ? E[2] : E[3];
        {
            bf16_t* pq = PROJ + (row0 + 16 * seg) * NPROJ + C_HQ + h * 128 + k;
            unsigned kt[8];
            float fj[4];
#pragma unroll
            for (int j = 0; j < 4; ++j) fj[j] = __expf(Eown - E[j]);
            const float f0 = __expf(Eown), f3 = __expf(E[3] - Eown);
#pragma unroll
            for (int i = 0; i < 16; ++i) {
                const float A = pre + Aa[i]; const int t = 16 * seg + i;
                const float e1 = __expf(A - Eown), r1 = __builtin_amdgcn_rcpf(e1);
                const float qe = qv[i] * e1, ke1 = kv[i] * r1;
                if (!DRY) pq[(size_t)i * NPROJ] = f2bf(qe * f0);
#pragma unroll
                for (int j = 0; j < 4; ++j) if (j <= seg) *(LAS bf16_t*)(lds + L_QJ + (qj_row0(j) + t - 16 * j) * P272 + k * 2) = f2bf(j == seg ? qe : qe * fj[j]);
                *(LAS bf16_t*)(lds + L_KH + t * P272 + k * 2) = f2bf(ke1);
                const unsigned ke = f2bf(ke1 * f3);
                if (i & 1) kt[i >> 1] |= ke << 16; else kt[i >> 1] = ke;
            }
            *(LAS u32x4*)(lds + L_KT + k * P144 + seg * 32) = (u32x4){kt[0], kt[1], kt[2], kt[3]};
            *(LAS u32x4*)(lds + L_KT + k * P144 + seg * 32 + 16) = (u32x4){kt[4], kt[5], kt[6], kt[7]};
            if (seg == 0) HD[(size_t)unit * 128 + k] = __expf(E[3]);
        }
        __syncthreads();
        {
            const int fr = lane & 15, fq = lane >> 4;
#pragma unroll
            for (int bb = 0; bb < 2; ++bb) {
                const int blk = 2 * wid + bb, bi = blk >> 2, bj = blk & 3;
                f32x4 acc = (f32x4){0.f, 0.f, 0.f, 0.f};
                if (bj <= bi) {
                    const LAS unsigned char* ap = lds + L_QJ + (qj_row0(bj) + 16 * (bi - bj) + fr) * P272 + fq * 16;
                    const LAS unsigned char* bp = lds + L_KH + (16 * bj + fr) * P272 + fq * 16;
#pragma unroll
                    for (int s = 0; s < 4; ++s) acc = __builtin_amdgcn_mfma_f32_16x16x32_bf16(*(const LAS bf16x8*)(ap + s * 64), *(const LAS bf16x8*)(bp + s * 64), acc, 0, 0, 0);
                }
#pragma unroll
                for (int r = 0; r < 4; ++r) { const int tl = 4 * fq + r; float v = acc[r]; if (bi == bj && fr > tl) v = 0.f;
                    *(LAS bf16_t*)(lds + L_P + (16 * bi + tl) * P144 + (16 * bj + fr) * 2) = f2bf(v); }
            }
        }
        __syncthreads();
        constexpr int L_SU = L_QJ, L_SO = L_QJ + 128 * P272;
        {
            const int vt = wid & 3, tt = wid >> 2;
            f32x16 acc;
#pragma unroll
            for (int r = 0; r < 16; ++r) acc[r] = 0.f;
#pragma unroll
            for (int ks = 0; ks < 4; ++ks) acc = __builtin_amdgcn_mfma_f32_32x32x16_bf16(*(const LAS bf16x8*)(lds + L_IT + (32 * vt + r32) * P144 + (16 * ks + 8 * hi) * 2), *(const LAS bf16x8*)(lds + L_P + (32 * tt + r32) * P144 + (16 * ks + 8 * hi) * 2), acc, 0, 0, 0);
#pragma unroll
            for (int g = 0; g < 4; ++g) { u32x2 w; w.x = cvt_pk_bf16(acc[4 * g], acc[4 * g + 1]); w.y = cvt_pk_bf16(acc[4 * g + 2], acc[4 * g + 3]); *(LAS u32x2*)(lds + L_SO + (32 * tt + r32) * P272 + (32 * vt + 8 * g + 4 * hi) * 2) = w; }
        }
        {
            const int kt_ = wid & 3;
#pragma unroll
            for (int vv = 0; vv < 2; ++vv) { const int vt = 2 * (wid >> 2) + vv;
                f32x16 acc;
#pragma unroll
                for (int r = 0; r < 16; ++r) acc[r] = 0.f;
#pragma unroll
                for (int ks = 0; ks < 4; ++ks) acc = __builtin_amdgcn_mfma_f32_32x32x16_bf16(*(const LAS bf16x8*)(lds + L_KT + (32 * kt_ + r32) * P144 + (16 * ks + 8 * hi) * 2), *(const LAS bf16x8*)(lds + L_IT + (32 * vt + r32) * P144 + (16 * ks + 8 * hi) * 2), acc, 0, 0, 0);
#pragma unroll
                for (int g = 0; g < 4; ++g) { u32x2 w; w.x = cvt_pk_bf16(acc[4 * g], acc[4 * g + 1]); w.y = cvt_pk_bf16(acc[4 * g + 2], acc[4 * g + 3]); *(LAS u32x2*)(lds + L_SU + (32 * vt + r32) * P272 + (32 * kt_ + 8 * g + 4 * hi) * 2) = w; } }
        }
        __syncthreads();
#pragma unroll
        for (int it = 0; it < 4; ++it) { const int id = tid + 512 * it, v = id >> 4, ch = id & 15;
            *(u32x4*)(HST + (size_t)unit * 16384 + (size_t)id * 8) = *(const LAS u32x4*)(lds + L_SU + v * P272 + ch * 16); }
        if (!DRY) {
#pragma unroll
            for (int it = 0; it < 2; ++it) { const int id = tid + 512 * it, t = id >> 4, ch = id & 15;
                *(u32x4*)(PROJ + (row0 + t) * NPROJ + C_LF + h * 128 + 8 * ch) = *(const LAS u32x4*)(lds + L_SO + t * P272 + ch * 16); }
        }
        __syncthreads();
    }
}
__device__ __forceinline__ void pass_b(bf16_t* HST, const float* __restrict__ HD, int grp) {
    const int bh = grp >> 12, rem = grp & 4095;
    float s0 = 0.f, s1 = 0.f, s2 = 0.f, s3 = 0.f;
    bf16_t* p = HST + (size_t)bh * 64 * 16384 + rem * 4;
    const float* pd = HD + (size_t)bh * 64 * 128 + (rem & 31) * 4;
#pragma unroll 8
    for (int cch = 0; cch < 64; ++cch) {
        const u32x2 u = *(const u32x2*)(p + (size_t)cch * 16384); const f32x4 d = *(const f32x4*)(pd + cch * 128);
        u32x2 w; w.x = pk2(s0, s1); w.y = pk2(s2, s3); *(u32x2*)(p + (size_t)cch * 16384) = w;
        s0 = d.x * s0 + __uint_as_float(u.x << 16); s1 = d.y * s1 + __uint_as_float(u.x & 0xffff0000u);
        s2 = d.z * s2 + __uint_as_float(u.y << 16); s3 = d.w * s3 + __uint_as_float(u.y & 0xffff0000u);
    }
}
constexpr int CL_PART = 0, CL_ST = 2048, CL_QT = CL_ST + 128 * P272, CL_OI = CL_QT + 64 * P272, CL_SG = CL_OI + 64 * P272, CL_END = CL_SG + 64 * P272;
static_assert(CL_END <= RING_BYTES, "hgrn pass C LDS");
struct CRegs { u32x4 st[4], qt[2], oi[2], sg[2]; };
__device__ __forceinline__ void c_load(CRegs& R, const bf16_t* __restrict__ PROJ, const bf16_t* __restrict__ HST, int unit, int tid) {
    const int bh = unit >> 6, cch = unit & 63, b = bh >> 2, h = bh & 3; const size_t row0 = (size_t)b * SEQ + cch * 64;
#pragma unroll
    for (int it = 0; it < 4; ++it) R.st[it] = *(const u32x4*)(HST + (size_t)unit * 16384 + (size_t)(tid + 512 * it) * 8);
#pragma unroll
    for (int it = 0; it < 2; ++it) { const int id = tid + 512 * it, t = id >> 4, ch = id & 15;
        const bf16_t* pr = PROJ + (row0 + t) * NPROJ + h * 128 + 8 * ch;
        R.qt[it] = *(const u32x4*)(pr + C_HQ); R.oi[it] = *(const u32x4*)(pr + C_LF); R.sg[it] = *(const u32x4*)(pr + C_SG); }
}
__device__ __forceinline__ void pass_c_all(LAS unsigned char* lds, const bf16_t* __restrict__ PROJ, const bf16_t* __restrict__ HST, const float* __restrict__ gn, bf16_t* OCAT, int u0, int ustep, int uend) {
    const int tid = ptid(), lane = tid & 63, r32 = lane & 31, hi = lane >> 5; const int wid = __builtin_amdgcn_readfirstlane(tid >> 6);
    const int vt = wid & 3, tt = wid >> 2, tl = 32 * tt + r32;
    LAS float* part = (LAS float*)(lds + CL_PART);
    CRegs R;
    if (u0 < uend) c_load(R, PROJ, HST, u0, tid);
    int par = 0;
    for (int unit = u0; unit < uend; unit += ustep, par ^= 1) {
        const int bh = unit >> 6, cch = unit & 63, b = bh >> 2, h = bh & 3;
        const size_t row0 = (size_t)b * SEQ + cch * 64;
#pragma unroll
        for (int it = 0; it < 4; ++it) { const int id = tid + 512 * it, v = id >> 4, ch = id & 15; *(LAS u32x4*)(lds + CL_ST + v * P272 + ch * 16) = R.st[it]; }
#pragma unroll
        for (int it = 0; it < 2; ++it) { const int id = tid + 512 * it, t = id >> 4, ch = id & 15;
            *(LAS u32x4*)(lds + CL_QT + t * P272 + ch * 16) = R.qt[it]; *(LAS u32x4*)(lds + CL_OI + t * P272 + ch * 16) = R.oi[it]; *(LAS u32x4*)(lds + CL_SG + t * P272 + ch * 16) = R.sg[it]; }
        __syncthreads();
        if (unit + ustep < uend) c_load(R, PROJ, HST, unit + ustep, tid);
        f32x16 acc;
#pragma unroll
        for (int g = 0; g < 4; ++g) { const u32x2 w = *(const LAS u32x2*)(lds + CL_OI + tl * P272 + (32 * vt + 8 * g + 4 * hi) * 2);
            acc[4 * g] = __uint_as_float(w.x << 16); acc[4 * g + 1] = __uint_as_float(w.x & 0xffff0000u); acc[4 * g + 2] = __uint_as_float(w.y << 16); acc[4 * g + 3] = __uint_as_float(w.y & 0xffff0000u); }
#pragma unroll
        for (int ks = 0; ks < 8; ++ks) acc = __builtin_amdgcn_mfma_f32_32x32x16_bf16(*(const LAS bf16x8*)(lds + CL_ST + (32 * vt + r32) * P272 + (16 * ks + 8 * hi) * 2), *(const LAS bf16x8*)(lds + CL_QT + tl * P272 + (16 * ks + 8 * hi) * 2), acc, 0, 0, 0);
        float ss = 0.f;
#pragma unroll
        for (int r = 0; r < 16; ++r) ss += acc[r] * acc[r];
        ss += __shfl_xor(ss, 32);
        LAS float* pp = part + par * 256;
        if (hi == 0) pp[vt * 64 + tl] = ss;
        __syncthreads();
        const float rn = rsqrtf((pp[tl] + pp[64 + tl] + pp[128 + tl] + pp[192 + tl]) * (1.f / 128.f) + EPS);
        const float* pg = gn + h * 128 + 32 * vt + 4 * hi;
#pragma unroll
        for (int g = 0; g < 4; ++g) { const u32x2 sw = *(const LAS u32x2*)(lds + CL_SG + tl * P272 + (32 * vt + 8 * g + 4 * hi) * 2); const f32x4 gv = *(const f32x4*)(pg + 8 * g);
            u32x2 w; w.x = cvt_pk_bf16(acc[4 * g] * rn * gv.x * __uint_as_float(sw.x << 16), acc[4 * g + 1] * rn * gv.y * __uint_as_float(sw.x & 0xffff0000u));
            w.y = cvt_pk_bf16(acc[4 * g + 2] * rn * gv.z * __uint_as_float(sw.y << 16), acc[4 * g + 3] * rn * gv.w * __uint_as_float(sw.y & 0xffff0000u));
            *(LAS u32x2*)(lds + CL_OI + tl * P272 + (32 * vt + 8 * g + 4 * hi) * 2) = w; }
        __syncthreads();
#pragma unroll
        for (int it = 0; it < 2; ++it) { const int id = tid + 512 * it, t = id >> 4, ch = id & 15;
            *(u32x4*)(OCAT + (row0 + t) * 1024 + 512 + h * 128 + 8 * ch) = *(const LAS u32x4*)(lds + CL_OI + t * P272 + ch * 16); }
        __syncthreads();
    }
}
}

__global__ void __launch_bounds__(NTHREADS, 2) mega(Args a) {
    extern __shared__ __attribute__((aligned(16))) unsigned char lds_raw[];
    LAS unsigned char* lds = (LAS unsigned char*)lds_raw;
    volatile LAS unsigned* MISC = (volatile LAS unsigned*)(lds + MISC_OFF);
    const int tid0 = threadIdx.x, wave = __builtin_amdgcn_readfirstlane(tid0 >> 6);
    const int G = gridDim.x, bx = blockIdx.x, vcu = (G % 8 == 0) ? (bx % 8) * (G / 8) + bx / 8 : bx;
    const int gw = vcu * NWAVES + wave, NGW = G * NWAVES;
    unsigned* ctl = (unsigned*)(a.ws + WS_CTL);
    for (int u = tid0; u < (LDS_BYTES - RING_BYTES) / 4; u += NTHREADS) ((LAS unsigned*)(lds + RING_BYTES))[u] = 0u;
    __syncthreads();
    XcdBarrier bar = xcd_barrier_post(ctl + CW_BAR + a.li * XCD_BAR_WORDS, MISC + 8);
    const int lo = a.ph_lo, hi = a.ph_hi;
    if (TPROBE >= 0 && blockIdx.x == 0 && threadIdx.x == 0) ((unsigned long long*)(ctl + 8192))[0] = __builtin_amdgcn_s_memrealtime();
#ifndef PH_COMPILE
#define PH_COMPILE 0x7FF
#endif
#define IN(k) ((((PH_COMPILE) >> (k)) & 1) && lo <= (k) && (k) < hi)
#define STAMP(i) do { if (TPROBE >= 0 && bx == 0 && tid0 == 0) ((unsigned long long*)(ctl + 8192))[i] = __builtin_amdgcn_s_memrealtime(); } while (0)
#define SEAM(k) do { if (IN(k) && IN((k) + 1)) xcd_barrier(bar); STAMP((k) + 1); } while (0)

    typedef const __attribute__((address_space(4))) Args* KArgs;
#define PHASE_PTRS \
    KArgs ka = (KArgs)__builtin_amdgcn_kernarg_segment_ptr(); asm volatile("" : "+s"(ka)); \
    const int tid = ptid(), lane = tid & 63; (void)lane; \
    unsigned char* ws = ka->ws; (void)ws; \
    const float* x = ka->in[0]; const float* c_in = ka->in[1]; const float* w_ada = ka->in[2]; const float* b_ada = ka->in[3]; \
    const float* pre_mix_g = ka->in[4]; const float* w_in = ka->in[6]; const float* b_fox_f = ka->in[7]; const float* gamma = ka->in[8]; \
    const float* w_out = ka->in[10]; const float* w_q = ka->in[13]; const float* sub_keys = ka->in[14]; const float* U = ka->in[15]; const float* V = ka->in[16]; \
    float* MOD = (float*)(ws + WS_MOD); float* LB = (float*)(ws + WS_LB); float* WFF = (float*)(ws + WS_WFF); \
    bf16_t* WIN = (bf16_t*)(ws + WS_WIN); bf16_t* WOUT = (bf16_t*)(ws + WS_WOUT); bf16_t* WQ = (bf16_t*)(ws + WS_WQ); bf16_t* KEYS = (bf16_t*)(ws + WS_KEYS); \
    float* LOGF = (float*)(ws + WS_F); float* F2T = (float*)(ws + WS_F2T); bf16_t* H = (bf16_t*)(ws + WS_H); bf16_t* PROJ = (bf16_t*)(ws + WS_PROJ); bf16_t* KK = (bf16_t*)(ws + WS_KK); \
    bf16_t* OCAT = (bf16_t*)(ws + WS_OCAT); bf16_t* MIX = H; bf16_t* H2 = OCAT; bf16_t* Q2 = (bf16_t*)(ws + WS_Q2); \
    (void)x; (void)c_in; (void)w_ada; (void)b_ada; (void)pre_mix_g; (void)w_in; (void)b_fox_f; (void)gamma; (void)w_out; (void)w_q; (void)sub_keys; (void)U; (void)V; \
    (void)MOD; (void)LB; (void)WFF; (void)WIN; (void)WOUT; (void)WQ; (void)KEYS; (void)LOGF; (void)F2T; (void)H; (void)PROJ; (void)KK; (void)OCAT; (void)MIX; (void)H2; (void)Q2;
    const int flags = a.flags;

    for (int rep_ = 0; rep_ < ((DUP_PHASE == 0) ? 2 : 1); ++rep_) if (IN(0)) { PHASE_PTRS
        LAS float* condl = (LAS float*)lds;
        for (int i = tid; i < 8192; i += NTHREADS) { const float cv = c_in[i]; condl[i] = cv * sigmoidf_(cv); }
        __syncthreads();
        for (int it = gw; it < 768; it += NGW) {
            const int j = it * 8 + (lane & 7), ks = lane >> 3;
            float acc[8];
#pragma unroll
            for (int b = 0; b < 8; ++b) acc[b] = 0.f;
            const float* wp = w_ada + (size_t)ks * 6144 + j;
#pragma unroll 8
            for (int i = 0; i < 128; ++i) { const float w = wp[(size_t)i * 8 * 6144]; const int k = ks + 8 * i;
#pragma unroll
                for (int b = 0; b < 8; ++b) acc[b] += condl[b * 1024 + k] * w; }
#pragma unroll
            for (int b = 0; b < 8; ++b) { float v = acc[b]; v += __shfl_xor(v, 8); v += __shfl_xor(v, 16); v += __shfl_xor(v, 32); acc[b] = v; }
            if (lane < 8) { const float bb = b_ada[j];
#pragma unroll
                for (int b = 0; b < 8; ++b) MOD[b * 6144 + j] = acc[b] + bb; }
        }
        if (gw == NGW - 1) { for (int i = lane; i < 512; i += 64) LB[i] = 1.f / (1.f + __expf(gamma[512 + i] - gamma[i])); ((float*)(ws + WS_LB + 4096))[lane] = 0.f; ((float*)(ws + WS_LB + 4096))[64 + lane] = 0.f; }
        LAS float* scr = (LAS float*)(lds + 32768 + wave * 8448);
        for (int it = gw; it < 3328; it += NGW) {
            int r = it;
            if (r < 768) { transpose_item(w_in, 3592, 0, WIN, 0, scr, r, 48, lane); continue; } r -= 768;
            if (r < 1024) { transpose_item(w_in, 3592, 1544, WIN, 1536, scr, r, 64, lane); continue; } r -= 1024;
            if (r < 512) { transpose_item(w_out, 1024, 0, WOUT, 0, scr, r, 32, lane); continue; } r -= 512;
            transpose_item(w_q, 2048, 0, WQ, 0, scr, r, 64, lane);
        }
        for (int i = gw * 64 + lane; i < 8192; i += NGW * 64) { const int jj = i >> 10, k = i & 1023; WFF[i] = w_in[(size_t)k * 3592 + 1536 + jj]; }
        for (int i = gw * 64 + lane; i < 65536; i += NGW * 64) { const f32x4 v = *(const f32x4*)(sub_keys + (size_t)i * 4); u32x2 o; o.x = pk2(v.x, v.y); o.y = pk2(v.z, v.w); *(u32x2*)(KEYS + (size_t)i * 4) = o; }
    }
    SEAM(0);
    for (int rep_ = 0; rep_ < ((DUP_PHASE == 1) ? 2 : 1); ++rep_) if (IN(1)) { PHASE_PTRS const int rpw = (T + NGW - 1) / NGW; h_rows(x, pre_mix_g, MOD, WFF, b_fox_f, H, LOGF, gw * rpw, (gw * rpw + rpw < T) ? gw * rpw + rpw : T, lane); }
    SEAM(1);
    if (DUP_PHASE == 99) { for (int i = 0; i < 10; ++i) xcd_barrier(bar); }
    for (int rep_ = 0; rep_ < ((DUP_PHASE == 2) ? 2 : 1); ++rep_) if (IN(2)) { PHASE_PTRS
        if (bx < 64) {
            const int bh = bx, b = bh >> 3, h = bh & 7;
            LAS float* wtot = (LAS float*)lds;
            const float* p = LOGF + ((size_t)b * SEQ + tid * 8) * 8 + h;
            float v[8], tot = 0.f;
#pragma unroll
            for (int i = 0; i < 8; ++i) { v[i] = p[i * 8]; tot += v[i]; }
            float incl = tot;
#pragma unroll
            for (int o = 1; o < 64; o <<= 1) { const float n = __shfl_up(incl, o); if (lane >= o) incl += n; }
            if (lane == 63) wtot[wave] = incl;
            __syncthreads();
            float base = incl - tot;
            for (int w = 0; w < wave; ++w) base += wtot[w];
            u32x4 dummy; (void)dummy;
            float run = base;
            float* o = F2T + (size_t)bh * SEQ + tid * 8;
#pragma unroll
            for (int i = 0; i < 8; ++i) { run += v[i]; o[i] = run * LOG2E; }
            __syncthreads();
        }
        pg8::Gemm g{H, WIN, T, NPROJ, 1024}; pg8::StaticOrder S; S.init(T, NPROJ, G, bx, WGM_G1);
        EpiProjT E{PROJ, KK, LB, (unsigned*)(ws + WS_LB + 4096)};
        pg8::gemm_phase<EpiProjT, pg8::StaticOrder, true, true>(lds, g, S, E);
    }
    SEAM(2);
    if (IN(3)) { PHASE_PTRS
        const float* KMAXH = (const float*)(ws + WS_LB + 4096);
        if (flags & FL_HGRN) hg::pass_a_all<false>(lds, PROJ, KK, (bf16_t*)(ws + WS_HST), (float*)(ws + WS_HD), vcu, G, 2048);
        xcd_barrier(bar); STAMP(20);
        if (flags & FL_HGRN) { for (int g = vcu * NTHREADS + tid; g < 32 * 4096; g += G * NTHREADS) hg::pass_b((bf16_t*)(ws + WS_HST), (const float*)(ws + WS_HD), g); }
        if (flags & FL_ATTN) {
            unsigned* qctr = ctl + CW_ATTNQ;
            LAS int* ubox = (LAS int*)(lds + RING_BYTES + 64);
            for (int rep_ = 0; rep_ < ((DUP_PHASE == 3) ? 2 : 1); ++rep_)
            for (;;) {
                if (tid == 0) *ubox = (int)atomicAdd(qctr + 64 * rep_, 1u);
                __syncthreads();
                const int u = *ubox;
                __syncthreads();
                if (u >= 1024) break;
                const int qb = 15 - (u >> 6), bh = u & 63;
                fa::attn_unit(lds, PROJ, F2T, OCAT, bh >> 3, bh & 7, qb, sqrtf(KMAXH[2 * bh] + KMAXH[2 * bh + 1]));
            }
        }
    }
    SEAM(3);
    for (int rep_ = 0; rep_ < ((DUP_PHASE == 5) ? 2 : 1); ++rep_) if (IN(5) && (flags & FL_HGRN)) { PHASE_PTRS hg::pass_c_all(lds, PROJ, (const bf16_t*)(ws + WS_HST), ka->in[9], OCAT, vcu, G, 2048); }
    SEAM(5);
    for (int rep_ = 0; rep_ < ((DUP_PHASE == 6) ? 2 : 1); ++rep_) if (IN(6)) { PHASE_PTRS
        pg8::Gemm g{OCAT, WOUT, T, 1024, 1024}; pg8::StaticOrder S; S.init(T, 1024, G, bx, WGM_G2);
        EpiPlainT E{MIX, 1024};
        pg8::gemm_phase<EpiPlainT, pg8::StaticOrder, true, true>(lds, g, S, E);
    }
    SEAM(6);
    for (int rep_ = 0; rep_ < ((DUP_PHASE == 7) ? 2 : 1); ++rep_) if (IN(7)) { PHASE_PTRS const int rpw = (T + NGW - 1) / NGW; row_passes(x, MIX, MOD, ka->in[5], ka->in[11], (bf16_t*)(ws + WS_HST), H2, gw * rpw, (gw * rpw + rpw < T) ? gw * rpw + rpw : T, lane); }
    SEAM(7);
    for (int rep_ = 0; rep_ < ((DUP_PHASE == 8) ? 2 : 1); ++rep_) if (IN(8)) { PHASE_PTRS
        pg8::Gemm g{H2, WQ, T, NQ2, 1024}; pg8::StaticOrder S; S.init(T, NQ2, G, bx, WGM_G3);
        EpiPlainT E{Q2, NQ2};
        pg8::gemm_phase<EpiPlainT, pg8::StaticOrder, true, true>(lds, g, S, E);
    }
    SEAM(8);
    for (int rep_ = 0; rep_ < ((DUP_PHASE == 9) ? 2 : 1); ++rep_) if (IN(9)) { PHASE_PTRS
        const int h = vcu & 7;
        {
            const bf16_t* ksrc = KEYS + (size_t)h * 2 * 128 * 128;
            for (int i = tid; i < 4096; i += NTHREADS) { const int row = i >> 4, ch = i & 15; *(LAS u32x4*)(lds + row * RT_KROW + ch * 16) = *(const u32x4*)(ksrc + row * 128 + ch * 8); }
        }
        __syncthreads();
        const int r32 = lane & 31, hi = lane >> 5;
        int* IDXw = (int*)(ws + WS_IDX); float* GATEw = (float*)(ws + WS_GATE);
        int qi = 0;
        const int qrows = (NEXP + NGW - 1) / NGW;
        for (int tb = (vcu >> 3); tb < T / 256; tb += G / 8) {
            const int t = tb * 256 + wave * 32 + r32;
            const bf16_t* qrow = Q2 + (size_t)t * NQ2 + h * 256;
            float A[16], B[16];
            f32x4 qa[4], qb[4];
            const int ra = gw * qrows + qi, rb_ = ra + 1; const bool oka = (qi < qrows) && (ra < NEXP), okb = (qi + 1 < qrows) && (rb_ < NEXP);
            if (oka) qrow_load(qa, U, ra, lane); if (okb) qrow_load(qb, U, rb_, lane);
            route_half(A, lds, qrow, r32, hi);
            __builtin_amdgcn_sched_barrier(0);
            if (oka) qrow_store(qa, ws + WS_UQ, (float*)(ws + WS_US), ra, lane); if (okb) qrow_store(qb, ws + WS_UQ, (float*)(ws + WS_US), rb_, lane);
            if (oka) qrow_load(qa, V, ra, lane); if (okb) qrow_load(qb, V, rb_, lane);
            route_half(B, lds + 128 * RT_KROW, qrow + 128, r32, hi);
            __builtin_amdgcn_sched_barrier(0);
            if (oka) qrow_store(qa, ws + WS_UQ + 8, (float*)(ws + WS_VS), ra, lane); if (okb) qrow_store(qb, ws + WS_UQ + 8, (float*)(ws + WS_VS), rb_, lane);
            qi += 2;
            route_final(A, B, lds + 256 * RT_KROW + tid * 32, IDXw + (size_t)t * 128 + h * 16, GATEw + (size_t)t * 128 + h * 16, hi == 0);
        }
        for (; qi < qrows; ++qi) { const int r = gw * qrows + qi; if (r < NEXP) { f32x4 qa[4]; qrow_load(qa, U, r, lane); qrow_store(qa, ws + WS_UQ, (float*)(ws + WS_US), r, lane); qrow_load(qa, V, r, lane); qrow_store(qa, ws + WS_UQ + 8, (float*)(ws + WS_VS), r, lane); } }
    }
    SEAM(9);
    if (IN(10)) { PHASE_PTRS
        const int* IDX = (const int*)(ws + WS_IDX); const float* GATE = (const float*)(ws + WS_GATE);
        for (int rep_ = ((DUP_PHASE == 10) ? 0 : 1); rep_ < 2; ++rep_) { float* outp = rep_ ? ka->out : (float*)(ws + 280 * MiB);
            const int rmask = (rep_ == 0 && DUP_MODE == 1) ? 255 : 0x3FFF;
            float pd = 0.f;
            if (TPROBE >= 0) { const unsigned long long* ts = (const unsigned long long*)(ctl + 8192); const int i0_ = (TPROBE == 30) ? 3 : (TPROBE == 31) ? 20 : (TPROBE == 5) ? 4 : TPROBE, i1_ = (TPROBE == 30) ? 20 : (TPROBE == 31) ? 4 : TPROBE + 1;
                const float dus = (float)(long long)(__hip_atomic_load(ts + i1_, __ATOMIC_RELAXED, __HIP_MEMORY_SCOPE_AGENT) - __hip_atomic_load(ts + i0_, __ATOMIC_RELAXED, __HIP_MEMORY_SCOPE_AGENT)) * 0.01f;
                pd = sqrtf(16.f * 0.004f * fminf(fmaxf(dus, 0.f), TPROBE_FS) / TPROBE_FS); }
            {
                const int tpw = (T + NGW - 1) / NGW, tb0 = vcu * NWAVES * tpw, b = (tb0 < T ? tb0 : 0) / SEQ;
                LAS float* pv = (LAS float*)lds; const float* md = MOD + b * 6144; const float* g_pre = ka->in[11]; const float* g_post = ka->in[12];
                for (int i = tid; i < 1024; i += NTHREADS) { pv[i] = g_pre[i] * (md[4096 + i] + 1.f); pv[1024 + i] = md[3072 + i]; pv[2048 + i] = md[5120 + i] * g_post[i]; }
                __syncthreads();
                const int t0 = gw * tpw, t1 = (t0 + tpw < T) ? t0 + tpw : T;
#pragma unroll 1
                for (int t = t0; t < t1; ++t) expert_token((const unsigned char*)(ws + WS_UQ), (const float*)(ws + WS_US), (const float*)(ws + WS_VS), IDX, GATE, pv, (const bf16_t*)(ws + WS_HST), outp, t, lane, rmask, (t < 2048) ? 1.f + pd : 1.f);
                __syncthreads();
            } }
    }
#undef IN
#undef SEAM
}

extern "C" void kernel_launch(void* const* d_in, const int* in_sizes, int n_in, void* d_out, int out_size, void* d_ws, size_t ws_size, hipStream_t stream) {
    if (n_in != 17 || in_sizes[0] != T * DM || out_size != T * DM || ws_size < WS_END) { fprintf(stderr, "kernel_launch: unexpected inputs (n_in %d, ws %zu); nothing launched\n", n_in, ws_size); return; }
    static int grid = 0;
    if (grid == 0) {
        int dev = 0, cus = 0, per_cu = 0;
        if (hipGetDevice(&dev) != hipSuccess || hipDeviceGetAttribute(&cus, hipDeviceAttributeMultiprocessorCount, dev) != hipSuccess) { grid = -1; return; }
        if (hipFuncSetAttribute((const void*)mega, hipFuncAttributeMaxDynamicSharedMemorySize, LDS_BYTES) != hipSuccess) { fprintf(stderr, "kernel_launch: hipFuncSetAttribute failed\n"); grid = -1; return; }
        if (hipOccupancyMaxActiveBlocksPerMultiprocessor(&per_cu, (const void*)mega, NTHREADS, LDS_BYTES) != hipSuccess || per_cu < 1) { fprintf(stderr, "kernel_launch: occupancy query says %d\n", per_cu); (void)hipGetLastError(); grid = -1; return; }
        grid = cus;
        { const int rpw = (T + grid * NWAVES - 1) / (grid * NWAVES); if (SEQ % rpw != 0) { fprintf(stderr, "kernel_launch: %d CUs: the row passes give each wave %d consecutive rows, which must not straddle a batch; nothing launched\n", grid, rpw); grid = -1; return; } }
        if (grid % 8 != 0) { fprintf(stderr, "kernel_launch: %d CUs: the routing phase deals heads over groups of 8 workgroups; nothing launched\n", grid); grid = -1; return; }
    }
    if (grid < 0) return;
    if (hipMemsetAsync((unsigned char*)d_ws + WS_CTL, 0, CTL_ZERO_BYTES, stream) != hipSuccess) return;
    Args a{}; for (int i = 0; i < 17; ++i) a.in[i] = (const float*)d_in[i];
    a.out = (float*)d_out; a.ws = (unsigned char*)d_ws; a.ph_lo = 0; a.ph_hi = 11; a.li = 0; a.flags = FL_ATTN | FL_HGRN;
    hipLaunchKernelGGL(mega, dim3(grid), dim3(NTHREADS), LDS_BYTES, stream, a);
}
```

```cpp
#include <hip/hip_runtime.h>
#include <stdint.h>
#include <cstdio>

typedef unsigned short bf16_t;
typedef short bf16x8 __attribute__((ext_vector_type(8)));
typedef float f32x4 __attribute__((ext_vector_type(4)));
typedef float f32x16 __attribute__((ext_vector_type(16)));
typedef unsigned u32x4 __attribute__((ext_vector_type(4)));
typedef unsigned u32x2 __attribute__((ext_vector_type(2)));

constexpr int BATCH = 8, SEQ = 4096, DM = 1024, T = BATCH * SEQ;
constexpr int NPROJ = 3584;
constexpr int C_Q = 0, C_K = 512, C_V = 1024, C_HQ = 1536, C_LF = 2048, C_HI = 2560, C_SG = 3072;
constexpr int NQ2 = 2048, NEXP = 16384;
constexpr float EPS = 1e-6f;
constexpr float LOG2E = 1.4426950408889634f;
constexpr float QSCALE = 0.125f * LOG2E;
constexpr float HQSCALE = 0.08838834764831845f;

constexpr size_t MiB = 1u << 20;
constexpr size_t WS_CTL = 0;
constexpr size_t WS_MOD = 1 * MiB;
constexpr size_t WS_LB = WS_MOD + 256 * 1024;
constexpr size_t WS_WFF = WS_MOD + 512 * 1024;
constexpr size_t WS_WIN = 2 * MiB;
constexpr size_t WS_WOUT = 10 * MiB;
constexpr size_t WS_WQ = 12 * MiB;
constexpr size_t WS_KEYS = 16 * MiB;
constexpr size_t WS_US = 17 * MiB;
constexpr size_t WS_VS = WS_US + 256 * 1024;
constexpr size_t WS_UQ = 18 * MiB;
constexpr size_t WS_F = 50 * MiB;
constexpr size_t WS_F2T = 52 * MiB;
constexpr size_t WS_H = 56 * MiB;
constexpr size_t WS_PROJ = 120 * MiB;
constexpr size_t WS_KK = 344 * MiB;
constexpr size_t WS_OCAT = 376 * MiB;
constexpr size_t WS_HST = 440 * MiB;
constexpr size_t WS_HD = 504 * MiB;
constexpr size_t WS_Q2 = WS_PROJ;
constexpr size_t WS_IDX = WS_PROJ + 128 * MiB;
constexpr size_t WS_GATE = WS_PROJ + 144 * MiB;
constexpr size_t WS_END = 505 * MiB;

__device__ __forceinline__ float bf2f(bf16_t v) { return __uint_as_float(((unsigned)v) << 16); }
typedef float f32x2_t __attribute__((ext_vector_type(2))); typedef __bf16 bf16x2_t __attribute__((ext_vector_type(2)));
__device__ __forceinline__ unsigned pk2(float lo, float hi) { f32x2_t v = {lo, hi}; bf16x2_t b = __builtin_convertvector(v, bf16x2_t); return __builtin_bit_cast(unsigned, b); }
__device__ __forceinline__ bf16_t f2bf(float f) { return (bf16_t)(pk2(f, 0.f) & 0xffffu); }
__device__ __forceinline__ unsigned short f2h(float f) { _Float16 h = (_Float16)f; return __builtin_bit_cast(unsigned short, h); }
__device__ __forceinline__ float h2f(unsigned short u) { _Float16 h = __builtin_bit_cast(_Float16, u); return (float)h; }
#define WAVE_DPP(v, ctrl) __int_as_float(__builtin_amdgcn_update_dpp(0, __float_as_int(v), ctrl, 0xF, 0xF, false))
__device__ __forceinline__ float wave_sum(float v) {
    v += WAVE_DPP(v, 0xB1);
    v += WAVE_DPP(v, 0x4E);
    v += WAVE_DPP(v, 0x124);
    v += WAVE_DPP(v, 0x128);
    { const auto r = __builtin_amdgcn_permlane16_swap(__float_as_uint(v), __float_as_uint(v), false, false); v = __uint_as_float(r[0]) + __uint_as_float(r[1]); }
    { const auto r = __builtin_amdgcn_permlane32_swap(__float_as_uint(v), __float_as_uint(v), false, false); v = __uint_as_float(r[0]) + __uint_as_float(r[1]); }
    return v;
}
__device__ __forceinline__ float wave_max(float v) {
    v = fmaxf(v, WAVE_DPP(v, 0xB1));
    v = fmaxf(v, WAVE_DPP(v, 0x4E));
    v = fmaxf(v, WAVE_DPP(v, 0x124));
    v = fmaxf(v, WAVE_DPP(v, 0x128));
    { const auto r = __builtin_amdgcn_permlane16_swap(__float_as_uint(v), __float_as_uint(v), false, false); v = fmaxf(__uint_as_float(r[0]), __uint_as_float(r[1])); }
    { const auto r = __builtin_amdgcn_permlane32_swap(__float_as_uint(v), __float_as_uint(v), false, false); v = fmaxf(__uint_as_float(r[0]), __uint_as_float(r[1])); }
    return v;
}
__device__ __forceinline__ float sigmoidf_(float z) { return __builtin_amdgcn_rcpf(1.f + __expf(-z)); }
__device__ __forceinline__ float gelu_erf(float a) { return 0.5f * a * (1.f + erff(a * 0.7071067811865476f)); }

#define DUP_PHASE (-1)
#define DUP_MODE 0
#define TPROBE_FS 300.f
namespace pg8 {
__device__ __forceinline__ int ptid_() { int t = threadIdx.x; asm volatile("" : "+v"(t)); return t; }
#define PG8_LAS __attribute__((address_space(3)))
typedef unsigned short bf16_t;
typedef short bf16x8 __attribute__((ext_vector_type(8)));
typedef float f32x4 __attribute__((ext_vector_type(4)));
typedef unsigned u32x4 __attribute__((ext_vector_type(4)));
constexpr int BM = 256, BK = 64, HALF = 128, HTB = HALF * BK * 2  , STAGE_BYTES = 8 * HTB, NXCD = 8, WGM = 4;

__host__ __device__ __forceinline__ int lds_byte(int r, int c) { const int st = (r >> 4) * 2 + (c >> 5), rr = r & 15, cc = c & 31, ob = rr * 64 + cc * 2; return st * 1024 + (ob ^ (((ob >> 9) & 1) << 5)); }
__host__ __device__ __forceinline__ void stage_rc(int b, int& R, int& C) { const int st = b / 1024, sb = b % 1024, swz = sb ^ (((sb >> 9) & 1) << 5); R = (st >> 1) * 16 + swz / 64; C = (st & 1) * 32 + (swz % 64) / 2; }
__host__ __device__ __forceinline__ int perm32(int rho) { const int n = rho >> 4, i = rho & 15; return 8 * (i >> 2) + 4 * n + (i & 3); }

struct Unit { int pm, pn; };
struct Gemm { const bf16_t* A; const bf16_t* Bt; int M, N, K; };

struct StaticOrder {
    int nM, nN, nwg, G, c, wgm;
    __host__ __device__ void init(int M, int N, int G_, int c_, int wgm_ = WGM) { nM = M / BM; nN = N / BM; nwg = nM * nN; G = G_; c = c_; wgm = wgm_; }
    __host__ __device__ bool next(int i, Unit& u) const {
        const long L = (long)i * G + c; if (L >= nwg) return false;
        int wgid = (int)L; { const int q = nwg / NXCD, r = nwg % NXCD, xcd = wgid % NXCD, off = wgid / NXCD; wgid = (xcd < r ? xcd * (q + 1) : r * (q + 1) + (xcd - r) * q) + off; }
        const int nig = wgm * nN, gid = wgid / nig, fm = gid * wgm, gsz = (nM - fm) < wgm ? (nM - fm) : wgm;
        u.pm = fm + ((wgid % nig) % gsz); u.pn = (wgid % nig) / gsz; return true;
    }
    __device__ __forceinline__ void a_ready(const Unit&) const {}
    __device__ __forceinline__ void done(const Unit&) const {}
};

template <class Epi, class Sched, bool ALIGN_EPI = false, bool SP2 = false>
__device__ __forceinline__ void gemm_phase(PG8_LAS unsigned char* lds, const Gemm g, const Sched& S, const Epi& E) {
    const int tid = ptid_(), wid = __builtin_amdgcn_readfirstlane(tid >> 6), lane = tid & 63, wr = wid >> 2, wc = wid & 3, fr = lane & 15, fq = lane >> 4;
    const int K = g.K, nt = K / BK;
    unsigned voffA[2], voffB[2];
#pragma unroll
    for (int i = 0; i < 2; ++i) { int R, C; stage_rc(tid * 16 + i * 8192, R, C); const int Rb = Epi::PERM ? ((R & ~31) + perm32(R & 31)) : R;
        voffA[i] = (unsigned)(R * K + C) * 2u; voffB[i] = (unsigned)(Rb * K + C) * 2u; }
    const size_t kstep = (size_t)(BK * 2);
    const size_t hstep = (size_t)HALF * K * 2;
    const size_t tstep = 2 * hstep;
    const unsigned ldsw = (unsigned)wid * 1024u;
    const int aoff = lds_byte(wr * 64 + fr, fq * 8), boff = lds_byte(wc * 32 + fr, fq * 8);
#define PG8_SA(b, h) (((b) * 2 + (h)) * HTB)
#define PG8_SB(b, h) ((4 + (b) * 2 + (h)) * HTB)
#define PG8_STAGE(bufoff, gbase, voff) do { _Pragma("unroll") for (int _i = 0; _i < 2; ++_i) \
        __builtin_amdgcn_global_load_lds((const unsigned*)((const char*)(gbase) + (voff)[_i]), (PG8_LAS unsigned*)(lds + (bufoff) + ldsw + _i * 8192), 16, 0, 0); } while (0)
#define PG8_LDA(dst, b, h) do { _Pragma("unroll") for (int m = 0; m < 4; ++m) _Pragma("unroll") for (int k = 0; k < 2; ++k) dst[m][k] = *(const PG8_LAS bf16x8*)(lds + PG8_SA(b, h) + aoff + m * 2048 + k * 1024); } while (0)
#define PG8_LDB(dst, b, h) do { _Pragma("unroll") for (int n = 0; n < 2; ++n) _Pragma("unroll") for (int k = 0; k < 2; ++k) dst[n][k] = *(const PG8_LAS bf16x8*)(lds + PG8_SB(b, h) + boff + n * 2048 + k * 1024); } while (0)
#define PG8_MMA(ai, bj, At, Bt) do { __builtin_amdgcn_s_setprio(1); _Pragma("unroll") for (int m = 0; m < 4; ++m) _Pragma("unroll") for (int n = 0; n < 2; ++n) _Pragma("unroll") for (int k = 0; k < 2; ++k) \
        acc[ai][bj][m][n] = __builtin_amdgcn_mfma_f32_16x16x32_bf16(Bt[n][k], At[m][k], acc[ai][bj][m][n], 0, 0, 0); __builtin_amdgcn_s_setprio(0); } while (0)
#define PG8_WAIT_V(n) asm volatile("s_waitcnt vmcnt(" #n ")" ::: "memory")
#define PG8_WAIT_L(n) asm volatile("s_waitcnt lgkmcnt(" #n ")" ::: "memory")
#define PG8_BAR __builtin_amdgcn_s_barrier()
#define PG8_SCHED __builtin_amdgcn_sched_barrier(0)
    Unit cur, nxt; int ui = 0;
    if (!S.next(0, cur)) return;
    f32x4 acc[2][2][4][2];
#pragma unroll
    for (int a = 0; a < 2; ++a)
#pragma unroll
        for (int b = 0; b < 2; ++b)
#pragma unroll
            for (int m = 0; m < 4; ++m)
#pragma unroll
                for (int n = 0; n < 2; ++n) acc[a][b][m][n] = (f32x4){0.f, 0.f, 0.f, 0.f};
    bf16x8 At[4][2], B0[2][2], B1[2][2];
    const char* cA = (const char*)g.A + (size_t)cur.pm * tstep; const char* cB = (const char*)g.Bt + (size_t)cur.pn * tstep;
    S.a_ready(cur);
    if constexpr (SP2) {
        PG8_STAGE(PG8_SB(0, 0), cB, voffB); PG8_STAGE(PG8_SB(0, 1), cB + hstep, voffB); PG8_STAGE(PG8_SA(0, 0), cA, voffA); PG8_STAGE(PG8_SA(0, 1), cA + hstep, voffA);
        if (wr == 1) PG8_BAR;
        PG8_WAIT_V(2); PG8_BAR;
        PG8_STAGE(PG8_SB(1, 0), cB + kstep, voffB); PG8_STAGE(PG8_SA(1, 0), cA + kstep, voffA); PG8_STAGE(PG8_SB(1, 1), cB + hstep + kstep, voffB);
        PG8_WAIT_V(6); PG8_BAR;
    } else {
        PG8_STAGE(PG8_SB(0, 0), cB, voffB); PG8_STAGE(PG8_SA(0, 0), cA, voffA); PG8_STAGE(PG8_SB(0, 1), cB + hstep, voffB); PG8_STAGE(PG8_SA(0, 1), cA + hstep, voffA);
        if (wr == 1) PG8_BAR;
        PG8_WAIT_V(4); PG8_BAR;
        PG8_STAGE(PG8_SB(1, 0), cB + kstep, voffB); PG8_STAGE(PG8_SA(1, 0), cA + kstep, voffA); PG8_STAGE(PG8_SB(1, 1), cB + hstep + kstep, voffB);
        PG8_WAIT_V(6); PG8_BAR;
    }
    for (;;) {
        const bool has_next = S.next(ui + 1, nxt);
        const char* nA = has_next ? (const char*)g.A + (size_t)nxt.pm * tstep : cA; const char* nB = has_next ? (const char*)g.Bt + (size_t)nxt.pn * tstep : cB;
        for (int t = 0; t < nt; t += 2) {
            const bool last = (t == nt - 2);
            const char* a1 = cA + (size_t)(t + 1) * kstep;
            const char* a2 = last ? nA : cA + (size_t)(t + 2) * kstep; const char* b2 = last ? nB : cB + (size_t)(t + 2) * kstep;
            const char* a3 = a2 + kstep; const char* b3 = b2 + kstep;
            if (last && has_next) S.a_ready(nxt);
            if constexpr (SP2) {
            PG8_LDB(B0, 0, 0); PG8_LDB(B1, 0, 1); PG8_SCHED; PG8_LDA(At, 0, 0); PG8_STAGE(PG8_SA(1, 1), a1 + hstep, voffA);
            PG8_WAIT_V(8); PG8_WAIT_L(0); PG8_BAR; PG8_MMA(0, 0, At, B0); PG8_MMA(0, 1, At, B1); PG8_BAR; PG8_SCHED;
            PG8_LDA(At, 0, 1); PG8_STAGE(PG8_SB(0, 0), b2, voffB); PG8_STAGE(PG8_SB(0, 1), b2 + hstep, voffB); PG8_STAGE(PG8_SA(0, 0), a2, voffA);
            PG8_WAIT_V(8); PG8_WAIT_L(0); PG8_BAR; PG8_MMA(1, 0, At, B0); PG8_MMA(1, 1, At, B1); PG8_BAR; PG8_SCHED;
            PG8_LDB(B0, 1, 0); PG8_LDB(B1, 1, 1); PG8_SCHED; PG8_LDA(At, 1, 0); PG8_STAGE(PG8_SA(0, 1), a2 + hstep, voffA);
            PG8_WAIT_V(8); PG8_WAIT_L(0); PG8_BAR; PG8_MMA(0, 0, At, B0); PG8_MMA(0, 1, At, B1); PG8_BAR; PG8_SCHED;
            PG8_LDA(At, 1, 1); PG8_STAGE(PG8_SB(1, 0), b3, voffB); PG8_STAGE(PG8_SB(1, 1), b3 + hstep, voffB); PG8_STAGE(PG8_SA(1, 0), a3, voffA);
            PG8_WAIT_V(8); PG8_WAIT_L(0); PG8_BAR; PG8_MMA(1, 0, At, B0); PG8_MMA(1, 1, At, B1); PG8_BAR; PG8_SCHED;
            } else {
            PG8_LDB(B0, 0, 0); PG8_SCHED; PG8_LDA(At, 0, 0); PG8_STAGE(PG8_SA(1, 1), a1 + hstep, voffA);
            PG8_WAIT_L(8); PG8_BAR; PG8_WAIT_L(0); PG8_MMA(0, 0, At, B0); PG8_BAR; PG8_SCHED;
            PG8_LDB(B1, 0, 1); PG8_STAGE(PG8_SB(0, 0), b2, voffB);
            PG8_BAR; PG8_WAIT_L(0); PG8_MMA(0, 1, At, B1); PG8_BAR;
            PG8_LDA(At, 0, 1); PG8_STAGE(PG8_SA(0, 0), a2, voffA);
            PG8_BAR; PG8_WAIT_L(0); PG8_MMA(1, 0, At, B0); PG8_BAR; PG8_SCHED;
            PG8_STAGE(PG8_SB(0, 1), b2 + hstep, voffB);
            PG8_WAIT_V(6); PG8_BAR; PG8_MMA(1, 1, At, B1); PG8_BAR;
            PG8_LDB(B0, 1, 0); PG8_SCHED; PG8_LDA(At, 1, 0); PG8_STAGE(PG8_SA(0, 1), a2 + hstep, voffA);
            PG8_WAIT_L(8); PG8_BAR; PG8_WAIT_L(0); PG8_MMA(0, 0, At, B0); PG8_BAR; PG8_SCHED;
            PG8_LDB(B1, 1, 1); PG8_STAGE(PG8_SB(1, 0), b3, voffB);
            PG8_BAR; PG8_WAIT_L(0); PG8_MMA(0, 1, At, B1); PG8_BAR;
            PG8_LDA(At, 1, 1); PG8_STAGE(PG8_SA(1, 0), a3, voffA);
            PG8_BAR; PG8_WAIT_L(0); PG8_MMA(1, 0, At, B0); PG8_BAR; PG8_SCHED;
            PG8_STAGE(PG8_SB(1, 1), b3 + hstep, voffB);
            PG8_WAIT_V(6); PG8_BAR; PG8_MMA(1, 1, At, B1); PG8_BAR;
            }
        }
        if constexpr (ALIGN_EPI) { if (wr == 0) PG8_BAR; }
        if constexpr (!Epi::AFTER_DRAIN) { E(acc, cur, wr, wc, fr, fq); S.done(cur); }
        if (!has_next) break;
#pragma unroll
        for (int a = 0; a < 2; ++a)
#pragma unroll
            for (int b = 0; b < 2; ++b)
#pragma unroll
                for (int m = 0; m < 4; ++m)
#pragma unroll
                    for (int n = 0; n < 2; ++n) acc[a][b][m][n] = (f32x4){0.f, 0.f, 0.f, 0.f};
        cur = nxt; cA = nA; cB = nB; ++ui;
        if constexpr (ALIGN_EPI) { if (wr == 1) PG8_BAR; }
    }
    PG8_WAIT_V(0);
    if constexpr (!ALIGN_EPI) { if (wr == 0) PG8_BAR; }
    PG8_BAR;
    if constexpr (Epi::AFTER_DRAIN) { E.fused(acc, cur, wr, wc, fr, fq, lds, wid, lane); S.done(cur); }
#undef PG8_SA
#undef PG8_SB
#undef PG8_STAGE
#undef PG8_LDA
#undef PG8_LDB
#undef PG8_MMA
#undef PG8_WAIT_V
#undef PG8_WAIT_L
#undef PG8_BAR
#undef PG8_SCHED
}
}

#define LAS __attribute__((address_space(3)))
#ifndef WGM_G1
#define WGM_G1 4
#define WGM_G2 4
#define WGM_G3 4
#endif
#ifndef TPROBE
#define TPROBE (-1)
#endif
__device__ __forceinline__ int ptid() { int t = threadIdx.x; asm volatile("" : "+v"(t)); return t; }
constexpr int NWAVES = 8, NTHREADS = 512;
constexpr int RING_BYTES = 131072;
constexpr int MISC_OFF = RING_BYTES + 320;
constexpr int LDS_BYTES = 147456;
constexpr int CW_BAR = 4096;
constexpr size_t CTL_ZERO_BYTES = 40 * 1024;
constexpr int CW_ATTNQ = 7680;

#define XB_TMO      128
#define XB_XCNT(j)  (256  + 64 * (j))
#define XB_XSUB(j)  (1280 + 64 * (j))
#define XB_XGEN(j)  (2304 + 64 * (j))
#define XB_TOP      3328
#define XB_TOPGEN   3392
#define XCD_BAR_WORDS 3456
#define XB_SPIN_CAP (1u << 20)
__device__ __forceinline__ unsigned xb_ld(unsigned* p)              { return __hip_atomic_load(p, __ATOMIC_RELAXED, __HIP_MEMORY_SCOPE_AGENT); }
__device__ __forceinline__ unsigned xb_add(unsigned* p, unsigned v) { return __hip_atomic_fetch_add(p, v, __ATOMIC_RELAXED, __HIP_MEMORY_SCOPE_AGENT); }
__device__ __forceinline__ unsigned xb_xcc_id() { return (unsigned)__builtin_amdgcn_s_getreg((3 << 11) | 20) & 0xFu; }
#define XB_SPIN(cond, bar) do { unsigned _sp = 0; while (cond) { __builtin_amdgcn_s_sleep(1); \
    if ((++_sp & 255u) == 0u) { if (xb_ld(&(bar)[XB_TMO])) break; if (_sp > XB_SPIN_CAP) { atomicAdd(&(bar)[XB_TMO], 1u); break; } } } } while (0)
struct XcdBarrier { unsigned* bar; unsigned x; volatile LAS unsigned* st; };
__device__ __forceinline__ XcdBarrier xcd_barrier_post(unsigned* bar, volatile LAS unsigned* st) {
    XcdBarrier b; b.bar = bar; b.x = xb_xcc_id(); b.st = st;
    if (threadIdx.x == 0) (void)xb_add(&bar[XB_XCNT(b.x)], 1u);
    return b;
}
__device__ __forceinline__ void xcd_barrier_complete(unsigned* bar, unsigned x, unsigned& nloc, unsigned& nx) {
    const unsigned G = gridDim.x * gridDim.y * gridDim.z;
    unsigned sum, cnt, mine, sp = 0u;
    for (;;) {
        sum = 0u; cnt = 0u; mine = 0u;
#pragma unroll
        for (unsigned j = 0; j < 16; ++j) { const unsigned c = xb_ld(&bar[XB_XCNT(j)]); sum += c; cnt += (c > 0u) ? 1u : 0u; mine = (j == x) ? c : mine; }
        if (sum == G) break;
        __builtin_amdgcn_s_sleep(1);
        if ((++sp & 255u) == 0u) { if (xb_ld(&bar[XB_TMO])) break; if (sp > XB_SPIN_CAP) { atomicAdd(&bar[XB_TMO], 1u); break; } }
    }
    nloc = mine > 0u ? mine : 1u; nx = cnt > 0u ? cnt : 1u;
}
__device__ __forceinline__ void xcd_barrier(const XcdBarrier& b) {
    asm volatile("s_waitcnt vmcnt(0)" ::: "memory");
    __syncthreads();
    if (threadIdx.x == 0) {
        unsigned* bar = b.bar;
        __builtin_amdgcn_s_waitcnt(0);
        unsigned nloc = b.st[0], nx = b.st[1];
        if (nloc == 0u) { xcd_barrier_complete(bar, b.x, nloc, nx); b.st[0] = nloc; b.st[1] = nx; }
        const unsigned old = xb_add(&bar[XB_XSUB(b.x)], 1u);
        const unsigned gen = old / nloc;
        if (old + 1u == (gen + 1u) * nloc) {
            __builtin_amdgcn_fence(__ATOMIC_RELEASE, "agent");
            asm volatile("s_waitcnt vmcnt(0)" ::: "memory");
            const unsigned og = xb_add(&bar[XB_TOP], 1u);
            const unsigned tg = og / nx;
            if (og + 1u == (tg + 1u) * nx) xb_add(&bar[XB_TOPGEN], 1u);
            else XB_SPIN(xb_ld(&bar[XB_TOPGEN]) == tg, bar);
            __builtin_amdgcn_fence(__ATOMIC_ACQUIRE, "agent");
            xb_add(&bar[XB_XGEN(b.x)], 1u);
            asm volatile("s_waitcnt vmcnt(0)" ::: "memory");
        } else {
            XB_SPIN(xb_ld(&bar[XB_XGEN(b.x)]) == gen, bar);
            __builtin_amdgcn_fence(__ATOMIC_ACQUIRE, "agent");
            asm volatile("s_waitcnt vmcnt(0)" ::: "memory");
        }
    }
    __syncthreads();
}

struct Args { const float* in[17]; float* out; unsigned char* ws; int ph_lo, ph_hi, li, flags; };
enum { FL_ATTN = 1, FL_HGRN = 2 };

__device__ __forceinline__ unsigned cvt_pk_bf16(float lo, float hi) { f32x2_t v = {lo, hi}; bf16x2_t b = __builtin_convertvector(v, bf16x2_t); return __builtin_bit_cast(unsigned, b); }
struct EpiPlainT {
    static constexpr bool PERM = true, AFTER_DRAIN = false;
    bf16_t* O; int ld;
    __device__ __forceinline__ void operator()(const pg8::f32x4 (&acc)[2][2][4][2], const pg8::Unit& u, int wr, int wc, int fr, int fq) const {
        const int row0 = u.pm * 256 + wr * 64 + fr, col0 = u.pn * 256 + wc * 32 + 8 * fq;
#pragma unroll
        for (int ai = 0; ai < 2; ++ai)
#pragma unroll
            for (int m = 0; m < 4; ++m) { bf16_t* rowp = O + (size_t)(row0 + ai * 128 + m * 16) * ld + col0;
#pragma unroll
                for (int bj = 0; bj < 2; ++bj) { const pg8::f32x4 v0 = acc[ai][bj][m][0], v1 = acc[ai][bj][m][1];
                    u32x4 w; w.x = cvt_pk_bf16(v0[0], v0[1]); w.y = cvt_pk_bf16(v0[2], v0[3]); w.z = cvt_pk_bf16(v1[0], v1[1]); w.w = cvt_pk_bf16(v1[2], v1[3]);
                    *(u32x4*)(rowp + bj * 128) = w; } }
    }
};
struct EpiProjT {
    static constexpr bool PERM = true, AFTER_DRAIN = false;
    bf16_t* proj; bf16_t* kk; const float* lb; unsigned* kmaxh;
    __device__ __forceinline__ void operator()(const pg8::f32x4 (&acc)[2][2][4][2], const pg8::Unit& u, int wr, int wc, int fr, int fq) const {
        const int row0 = u.pm * 256 + wr * 64 + fr, col0 = u.pn * 256 + wc * 32 + 8 * fq, seg = (u.pn * 256) >> 9;
        float kmx[2] = {0.f, 0.f};
        float lbv[2][8];
        if (seg == 4) {
#pragma unroll
            for (int bj = 0; bj < 2; ++bj)
#pragma unroll
                for (int i = 0; i < 8; ++i) lbv[bj][i] = lb[col0 - C_LF + bj * 128 + i];
        }
        const float sc = (seg == 0) ? QSCALE : (seg == 3) ? HQSCALE : 1.f;
#pragma unroll
        for (int ai = 0; ai < 2; ++ai)
#pragma unroll
            for (int m = 0; m < 4; ++m) { const size_t row = (size_t)(row0 + ai * 128 + m * 16);
#pragma unroll
                for (int bj = 0; bj < 2; ++bj) {
                    float v[8];
#pragma unroll
                    for (int i = 0; i < 4; ++i) { v[i] = acc[ai][bj][m][0][i]; v[4 + i] = acc[ai][bj][m][1][i]; }
                    u32x4 w;
                    if (seg == 4) {
                        float k1[8]; unsigned short hh[8];
#pragma unroll
                        for (int i = 0; i < 8; ++i) { const float l = lbv[bj][i], f = l + (1.f - l) * sigmoidf_(v[i]); k1[i] = 1.f - f; hh[i] = f2h(__builtin_amdgcn_logf(f) * 0.69314718056f); }
                        w.x = hh[0] | ((unsigned)hh[1] << 16); w.y = hh[2] | ((unsigned)hh[3] << 16); w.z = hh[4] | ((unsigned)hh[5] << 16); w.w = hh[6] | ((unsigned)hh[7] << 16);
                        (void)k1;
                    } else {
                        if (seg == 6) {
#pragma unroll
                            for (int i = 0; i < 8; ++i) v[i] = v[i] * sigmoidf_(v[i]);
                        } else {
#pragma unroll
                            for (int i = 0; i < 8; ++i) v[i] *= sc;
                        }
                        w.x = cvt_pk_bf16(v[0], v[1]); w.y = cvt_pk_bf16(v[2], v[3]); w.z = cvt_pk_bf16(v[4], v[5]); w.w = cvt_pk_bf16(v[6], v[7]);
                        if (seg == 1) {
                            float s = 0.f;
#pragma unroll
                            for (int i = 0; i < 4; ++i) { const float a = __uint_as_float(w[i] << 16), b = __uint_as_float(w[i] & 0xffff0000u); s += a * a + b * b; }
                            s += __shfl_xor(s, 16); s += __shfl_xor(s, 32);
                            kmx[bj] = fmaxf(kmx[bj], s);
                        }
                    }
                    *(u32x4*)(proj + row * NPROJ + col0 + bj * 128) = w;
                } }
        if (seg == 1) {
#pragma unroll
            for (int bj = 0; bj < 2; ++bj) { float m = kmx[bj]; m = fmaxf(m, __shfl_xor(m, 1)); m = fmaxf(m, __shfl_xor(m, 2)); m = fmaxf(m, __shfl_xor(m, 4)); m = fmaxf(m, __shfl_xor(m, 8));
                const int head = (u.pn - 2) * 4 + bj * 2 + (wc >> 1), b = (u.pm * 256) / SEQ;
                if (fr == 0 && fq == 0) atomicMax(kmaxh + ((b * 8 + head) * 2 + (wc & 1)), __float_as_uint(m)); }
        }
    }
};

__device__ __forceinline__ void transpose_item(const float* __restrict__ W, int ldw, int c0, bf16_t* WT, int r0, LAS float* scr, int item, int nblk, int lane) {
    const int k0 = 64 * (item / nblk), n0 = 32 * (item % nblk);
#pragma unroll 8
    for (int i = 0; i < 32; ++i) { const int kk = 2 * i + (lane >> 5); scr[kk * 33 + (lane & 31)] = W[(size_t)(k0 + kk) * ldw + c0 + n0 + (lane & 31)]; }
    asm volatile("s_waitcnt lgkmcnt(0)" ::: "memory");
    const int c = lane & 7;
#pragma unroll
    for (int j = 0; j < 4; ++j) { const int n = (lane >> 3) + 8 * j; const LAS float* s = scr + (8 * c) * 33 + n;
        u32x4 o; o.x = pk2(s[0 * 33], s[1 * 33]); o.y = pk2(s[2 * 33], s[3 * 33]); o.z = pk2(s[4 * 33], s[5 * 33]); o.w = pk2(s[6 * 33], s[7 * 33]);
        *(u32x4*)(WT + (size_t)(r0 + n0 + n) * 1024 + k0 + 8 * c) = o; }
    asm volatile("s_waitcnt lgkmcnt(0)" ::: "memory");
}
__device__ __forceinline__ void qrow_load(f32x4 (&v)[4], const float* __restrict__ src, int row, int lane) {
#pragma unroll
    for (int j = 0; j < 4; ++j) v[j] = *(const f32x4*)(src + (size_t)row * 1024 + 256 * j + 4 * lane);
}
__device__ __forceinline__ void qrow_store(const f32x4 (&v)[4], unsigned char* q, float* scale, int row, int lane) {
    float ss = 0.f;
#pragma unroll
    for (int j = 0; j < 4; ++j) ss += v[j].x * v[j].x + v[j].y * v[j].y + v[j].z * v[j].z + v[j].w * v[j].w;
    ss = wave_sum(ss);
    const float sc = ss > 0.f ? 0.3352f * sqrtf(ss * (1.f / 1024.f)) : 1.f, inv = __builtin_amdgcn_rcpf(sc);
    unsigned n[16];
#pragma unroll
    for (int j = 0; j < 4; ++j) {
#pragma unroll
        for (int i = 0; i < 4; ++i) { const float f = floorf(v[j][i] * inv) + 8.f; n[4 * j + i] = (unsigned)fminf(fmaxf(f, 0.f), 15.f); } }
    u32x2 o;
#pragma unroll
    for (int m = 0; m < 2; ++m) { unsigned w = 0;
#pragma unroll
        for (int b = 0; b < 4; ++b) w |= (n[8 * m + b] | (n[8 * m + 4 + b] << 4)) << (8 * b);
        o[m] = w; }
    *(u32x2*)(q + (size_t)row * 1024 + lane * 16) = o;
    if (lane == 0) scale[row] = sc;
}
__device__ __forceinline__ void h_rows(const float* __restrict__ x, const float* __restrict__ g, const float* __restrict__ mod, const float* __restrict__ wff, const float* __restrict__ bf, bf16_t* H, float* logf, int t0, int t1, int lane) {
    if (t0 >= t1) return;
    const int b = t0 / SEQ;
    const float* shift = mod + b * 6144, * scale = shift + 1024;
    f32x4 gm[4], sh[4];
#pragma unroll
    for (int j = 0; j < 4; ++j) { const int c0 = 256 * j + 4 * lane; gm[j] = *(const f32x4*)(g + c0) * (*(const f32x4*)(scale + c0) + 1.f); sh[j] = *(const f32x4*)(shift + c0); }
    const float bfl = (lane < 8) ? bf[lane] : 0.f;
    f32x4 nx[4];
#pragma unroll
    for (int j = 0; j < 4; ++j) nx[j] = *(const f32x4*)(x + (size_t)t0 * 1024 + 256 * j + 4 * lane);
    for (int t = t0; t < t1; ++t) {
        f32x4 v[4]; float s = 0.f;
#pragma unroll
        for (int j = 0; j < 4; ++j) { v[j] = nx[j]; s += v[j].x * v[j].x + v[j].y * v[j].y + v[j].z * v[j].z + v[j].w * v[j].w; }
        if (t + 1 < t1) {
#pragma unroll
            for (int j = 0; j < 4; ++j) nx[j] = *(const f32x4*)(x + (size_t)(t + 1) * 1024 + 256 * j + 4 * lane);
        }
        const float rstd = rsqrtf(wave_sum(s) * (1.f / 1024.f) + EPS);
        float ff[8];
#pragma unroll
        for (int i = 0; i < 8; ++i) ff[i] = 0.f;
#pragma unroll
        for (int j = 0; j < 4; ++j) {
            const int c0 = 256 * j + 4 * lane;
            const f32x4 h = v[j] * rstd * gm[j] + sh[j];
            u32x2 o; o.x = pk2(h.x, h.y); o.y = pk2(h.z, h.w);
            *(u32x2*)(H + (size_t)t * 1024 + c0) = o;
#pragma unroll
            for (int i = 0; i < 8; ++i) { const f32x4 w = *(const f32x4*)(wff + i * 1024 + c0); ff[i] += h.x * w.x + h.y * w.y + h.z * w.z + h.w * w.w; }
        }
#pragma unroll
        for (int i = 0; i < 8; ++i) ff[i] = wave_sum(ff[i]);
        if (lane < 8) {
            float z = 0.f;
#pragma unroll
            for (int i = 0; i < 8; ++i) z = (lane == i) ? ff[i] : z;
            z += bfl;
            logf[(size_t)t * 8 + lane] = fminf(z, 0.f) - log1pf(__expf(-fabsf(z)));
        }
    }
}

__device__ __forceinline__ void row_passes(const float* __restrict__ x, const bf16_t* __restrict__ mix, const float* __restrict__ mod, const float* __restrict__ g_post, const float* __restrict__ g_pre, bf16_t* XB, bf16_t* H2, int t0, int t1, int lane) {
    if (t0 >= t1) return;
    const int b = t0 / SEQ; const float* md = mod + b * 6144;
    f32x4 ga[4], gp[4], shf[4];
#pragma unroll
    for (int j = 0; j < 4; ++j) { const int c0 = 256 * j + 4 * lane; ga[j] = *(const f32x4*)(md + 2048 + c0) * *(const f32x4*)(g_post + c0);
        gp[j] = *(const f32x4*)(g_pre + c0) * (*(const f32x4*)(md + 4096 + c0) + 1.f); shf[j] = *(const f32x4*)(md + 3072 + c0); }
    f32x4 nx[4]; u32x2 nm[4];
#pragma unroll
    for (int j = 0; j < 4; ++j) { const int c0 = 256 * j + 4 * lane; nx[j] = *(const f32x4*)(x + (size_t)t0 * 1024 + c0); nm[j] = *(const u32x2*)(mix + (size_t)t0 * 1024 + c0); }
    for (int t = t0; t < t1; ++t) {
        f32x4 m[4], xv[4]; float s = 0.f;
#pragma unroll
        for (int j = 0; j < 4; ++j) { const u32x2 w = nm[j]; xv[j] = nx[j];
            m[j] = (f32x4){__uint_as_float(w.x << 16), __uint_as_float(w.x & 0xffff0000u), __uint_as_float(w.y << 16), __uint_as_float(w.y & 0xffff0000u)};
            s += m[j].x * m[j].x + m[j].y * m[j].y + m[j].z * m[j].z + m[j].w * m[j].w; }
        if (t + 1 < t1) {
#pragma unroll
            for (int j = 0; j < 4; ++j) { const int c0 = 256 * j + 4 * lane; nx[j] = *(const f32x4*)(x + (size_t)(t + 1) * 1024 + c0); nm[j] = *(const u32x2*)(mix + (size_t)(t + 1) * 1024 + c0); }
        }
        const float r1 = rsqrtf(wave_sum(s) * (1.f / 1024.f) + EPS);
        float s2 = 0.f;
#pragma unroll
        for (int j = 0; j < 4; ++j) { const int c0 = 256 * j + 4 * lane;
            xv[j] = xv[j] + ga[j] * (m[j] * r1);
            { u32x2 xo; xo.x = pk2(xv[j].x, xv[j].y); xo.y = pk2(xv[j].z, xv[j].w); *(u32x2*)(XB + (size_t)t * 1024 + c0) = xo; }
            s2 += xv[j].x * xv[j].x + xv[j].y * xv[j].y + xv[j].z * xv[j].z + xv[j].w * xv[j].w; }
        const float r2 = rsqrtf(wave_sum(s2) * (1.f / 1024.f) + EPS);
#pragma unroll
        for (int j = 0; j < 4; ++j) { const int c0 = 256 * j + 4 * lane;
            const f32x4 h = xv[j] * r2 * gp[j] + shf[j];
            u32x2 o; o.x = pk2(h.x, h.y); o.y = pk2(h.z, h.w);
            *(u32x2*)(H2 + (size_t)t * 1024 + c0) = o; }
    }
}

__device__ __forceinline__ float gelu_as(float v) {
    const float av = fabsf(v), t = __builtin_amdgcn_rcpf(av * 0.2316418882f + 1.0f);
    float q = t * 0.5307027145f + (-0.7265760135f); q = q * t + 0.7107068705f; q = q * t + (-0.142248368f); q = q * t + 0.127414796f; q = q * t;
    const float m = v * (q * __builtin_amdgcn_exp2f((v * v) * (-0.72134752044f)));
    return v < 0.f ? m : v - m;
}
constexpr int EB = 16;
__device__ __forceinline__ void expert_token(const unsigned char* __restrict__ UV, const float* __restrict__ US, const float* __restrict__ VS,
                                             const int* __restrict__ IDX, const float* __restrict__ GATE, const LAS float* pv  ,
                                             const bf16_t* __restrict__ xin, float* out, int t, int lane, int rmask, float pscale) {
    float s2 = 0.f;
    float hv[16]; float mx = 0.f;
    {
    f32x4 x1[4];
#pragma unroll
    for (int j = 0; j < 4; ++j) { const u32x2 xw = *(const u32x2*)(xin + (size_t)t * 1024 + 256 * j + 4 * lane);
        x1[j] = (f32x4){__uint_as_float(xw.x << 16), __uint_as_float(xw.x & 0xffff0000u), __uint_as_float(xw.y << 16), __uint_as_float(xw.y & 0xffff0000u)}; s2 += x1[j].x * x1[j].x + x1[j].y * x1[j].y + x1[j].z * x1[j].z + x1[j].w * x1[j].w; }
    const float r2 = rsqrtf(wave_sum(s2) * (1.f / 1024.f) + EPS);
#pragma unroll
    for (int j = 0; j < 4; ++j) { const f32x4 h = x1[j] * r2 * *(const LAS f32x4*)(pv + 256 * j + 4 * lane) + *(const LAS f32x4*)(pv + 1024 + 256 * j + 4 * lane);
        hv[4 * j] = h.x; hv[4 * j + 1] = h.y; hv[4 * j + 2] = h.z; hv[4 * j + 3] = h.w;
        mx = fmaxf(mx, fmaxf(fmaxf(fabsf(h.x), fabsf(h.y)), fmaxf(fabsf(h.z), fabsf(h.w)))); }
    }
    const int i0 = IDX[(size_t)t * 128 + lane] & rmask, i1 = IDX[(size_t)t * 128 + 64 + lane] & rmask;
    const float g0 = GATE[(size_t)t * 128 + lane], g1 = GATE[(size_t)t * 128 + 64 + lane];
    const float su0 = US[i0], su1 = US[i1], sv0 = VS[i0], sv1 = VS[i1];
    mx = wave_max(mx);
    const float sx = mx > 0.f ? mx / 127.f : 1.f, isx = 1.f / sx;
    int xq[4]; int xs = 0;
#pragma unroll
    for (int j = 0; j < 4; ++j) { const int q0 = (int)rintf(hv[4 * j] * isx), q1 = (int)rintf(hv[4 * j + 1] * isx), q2 = (int)rintf(hv[4 * j + 2] * isx), q3 = (int)rintf(hv[4 * j + 3] * isx);
        xs += q0 + q1 + q2 + q3;
        xq[j] = (int)((unsigned)(q0 & 255) | ((unsigned)(q1 & 255) << 8) | ((unsigned)(q2 & 255) << 16) | ((unsigned)(q3 & 255) << 24)); }
#pragma unroll
    for (int o = 1; o < 64; o <<= 1) xs += __shfl_xor(xs, o);
    const float xoff = 7.5f * (float)xs;
    const int el = ((lane >> 5) & 1) * 8 + ((lane >> 4) & 1) * 4 + ((lane >> 1) & 1) * 2 + (lane & 1);
    float acc[16];
#pragma unroll
    for (int i = 0; i < 16; ++i) acc[i] = 0.f;
    float sumc = 0.f;
    const unsigned lo16 = (unsigned)lane * 16u;
    u32x4 rb[EB];
#pragma unroll
    for (int e = 0; e < EB; ++e) { const unsigned row = (unsigned)__builtin_amdgcn_readlane(i0, e); rb[e] = *(const u32x4*)(UV + (row * 1024u + lo16)); }
#pragma unroll 1
    for (int bi = 0; bi < 128 / EB; ++bi) {
        u32x4 rn[EB];
        {
            const int nb = (bi + 1) & 7, srcn = (nb < 4) ? i0 : i1, ln = (nb & 3) * EB;
#pragma unroll
            for (int e = 0; e < EB; ++e) { const unsigned row = (unsigned)__builtin_amdgcn_readlane(srcn, ln + e); rn[e] = *(const u32x4*)(UV + (row * 1024u + lo16)); }
        }
        int d[EB];
#pragma unroll
        for (int e = 0; e < EB; ++e) { const unsigned w0 = rb[e].x, w1 = rb[e].y;
            int s = __builtin_amdgcn_sdot4(xq[0], (int)(w0 & 0x0F0F0F0Fu), 0, false); s = __builtin_amdgcn_sdot4(xq[1], (int)((w0 >> 4) & 0x0F0F0F0Fu), s, false);
            s = __builtin_amdgcn_sdot4(xq[2], (int)(w1 & 0x0F0F0F0Fu), s, false); d[e] = __builtin_amdgcn_sdot4(xq[3], (int)((w1 >> 4) & 0x0F0F0F0Fu), s, false); }
        int d8[8], d4[4], d2[2], d1;
#pragma unroll
        for (int k = 0; k < 8; ++k) { const auto r = __builtin_amdgcn_permlane32_swap((unsigned)d[k], (unsigned)d[8 + k], false, false); d8[k] = (int)(r[0] + r[1]); }
#pragma unroll
        for (int k = 0; k < 4; ++k) { const auto r = __builtin_amdgcn_permlane16_swap((unsigned)d8[k], (unsigned)d8[4 + k], false, false); d4[k] = (int)(r[0] + r[1]); }
        { const bool up = (lane & 2) != 0;
#pragma unroll
          for (int k = 0; k < 2; ++k) { const int keep = up ? d4[2 + k] : d4[k], give = up ? d4[k] : d4[2 + k]; d2[k] = keep + __builtin_amdgcn_update_dpp(0, give, 0x4E, 0xF, 0xF, false); } }
        { const bool up = (lane & 1) != 0; const int keep = up ? d2[1] : d2[0], give = up ? d2[0] : d2[1]; d1 = keep + __builtin_amdgcn_update_dpp(0, give, 0xB1, 0xF, 0xF, false); }
        d1 += __builtin_amdgcn_update_dpp(0, d1, 0x128, 0xF, 0xF, false);
        d1 += __builtin_amdgcn_update_dpp(0, d1, 0x124, 0xF, 0xF, false);
        const int ei = bi * EB + el;
        const int ba = (ei & 63) * 4;
        const float gsel = __uint_as_float((unsigned)__builtin_amdgcn_ds_bpermute(ba, (int)__float_as_uint((bi < 4) ? g0 : g1)));
        const float susel = __uint_as_float((unsigned)__builtin_amdgcn_ds_bpermute(ba, (int)__float_as_uint((bi < 4) ? su0 : su1)));
        const float svsel = __uint_as_float((unsigned)__builtin_amdgcn_ds_bpermute(ba, (int)__float_as_uint((bi < 4) ? sv0 : sv1)));
        const float aval = ((float)d1 - xoff) * sx * susel;
        const float cl = gsel * gelu_as(aval) * svsel;
#pragma unroll
        for (int e = 0; e < EB; ++e) {
            const float ce = __uint_as_float((unsigned)__builtin_amdgcn_readlane((int)__float_as_uint(cl), ((e >> 3) & 1) * 32 + ((e >> 2) & 1) * 16 + ((e >> 1) & 1) * 2 + (e & 1)));
            sumc += ce;
#pragma unroll
            for (int m = 0; m < 2; ++m) { const unsigned w = rb[e][2 + m], lo = w & 0x0F0F0F0Fu, hi = (w >> 4) & 0x0F0F0F0Fu;
                float f[8];
                asm("v_cvt_f32_ubyte0 %0, %1" : "=v"(f[0]) : "v"(lo)); asm("v_cvt_f32_ubyte1 %0, %1" : "=v"(f[1]) : "v"(lo)); asm("v_cvt_f32_ubyte2 %0, %1" : "=v"(f[2]) : "v"(lo)); asm("v_cvt_f32_ubyte3 %0, %1" : "=v"(f[3]) : "v"(lo));
                asm("v_cvt_f32_ubyte0 %0, %1" : "=v"(f[4]) : "v"(hi)); asm("v_cvt_f32_ubyte1 %0, %1" : "=v"(f[5]) : "v"(hi)); asm("v_cvt_f32_ubyte2 %0, %1" : "=v"(f[6]) : "v"(hi)); asm("v_cvt_f32_ubyte3 %0, %1" : "=v"(f[7]) : "v"(hi));
#pragma unroll
                for (int i = 0; i < 8; ++i) acc[8 * m + i] += ce * f[i]; }
        }
#pragma unroll
        for (int e = 0; e < EB; ++e) rb[e] = rn[e];
    }
    float sy = 0.f;
#pragma unroll
    for (int i = 0; i < 16; ++i) { acc[i] -= 7.5f * sumc; sy += acc[i] * acc[i]; }
    const float ry = rsqrtf(wave_sum(sy) * (1.f / 1024.f) + EPS);
#pragma unroll
    for (int j = 0; j < 4; ++j) { const f32x4 y = (f32x4){acc[4 * j], acc[4 * j + 1], acc[4 * j + 2], acc[4 * j + 3]};
        float* op = out + (size_t)t * 1024 + 256 * j + 4 * lane;
        const u32x2 xw = *(const u32x2*)(xin + (size_t)t * 1024 + 256 * j + 4 * lane);
        *(f32x4*)op = pscale * (f32x4){__uint_as_float(xw.x << 16), __uint_as_float(xw.x & 0xffff0000u), __uint_as_float(xw.y << 16), __uint_as_float(xw.y & 0xffff0000u)} + pscale * *(const LAS f32x4*)(pv + 2048 + 256 * j + 4 * lane) * (y * ry); }
}

#define CE_DESC(a, b) do { const float _t = fmaxf(a, b); b = fminf(a, b); a = _t; } while (0)
__device__ __forceinline__ void sort16_desc(float (&v)[16]) {
#pragma unroll
    for (int k = 2; k <= 16; k <<= 1)
#pragma unroll
        for (int j = k >> 1; j > 0; j >>= 1)
#pragma unroll
            for (int i = 0; i < 16; ++i) { const int l = i ^ j; if (l > i) { if ((i & k) == 0 || k == 16) CE_DESC(v[i], v[l]); else CE_DESC(v[l], v[i]); } }
}
__device__ __forceinline__ void merge16_desc(float (&a)[16], const float (&b)[16]) {
#pragma unroll
    for (int i = 0; i < 16; ++i) a[i] = fmaxf(a[i], b[15 - i]);
#pragma unroll
    for (int j = 8; j > 0; j >>= 1)
#pragma unroll
        for (int i = 0; i < 16; ++i) { const int l = i ^ j; if (l > i) CE_DESC(a[i], a[l]); }
}
#define CE2_DESC(va, pa, vb, pb) do { const bool _c = (va) >= (vb); const float _tv = _c ? (va) : (vb), _tw = _c ? (vb) : (va); const int _tp = _c ? (pa) : (pb), _tq = _c ? (pb) : (pa); va = _tv; vb = _tw; pa = _tp; pb = _tq; } while (0)
template <int N> __device__ __forceinline__ void bitonic_merge_desc2(float (&v)[N], int (&p)[N]) {
#pragma unroll
    for (int j = N / 2; j > 0; j >>= 1)
#pragma unroll
        for (int i = 0; i < N; ++i) { const int l = i ^ j; if (l > i) CE2_DESC(v[i], p[i], v[l], p[l]); }
}
__device__ __forceinline__ void merge16_desc2(float (&a)[16], int (&pa)[16], const float (&b)[16], const int (&pb)[16]) {
#pragma unroll
    for (int i = 0; i < 16; ++i) { const bool c = a[i] >= b[15 - i]; pa[i] = c ? pa[i] : pb[15 - i]; a[i] = c ? a[i] : b[15 - i]; }
    bitonic_merge_desc2<16>(a, pa);
}
__device__ __forceinline__ void sort8_desc2(float (&v)[8], int (&p)[8]) {
#pragma unroll
    for (int k = 2; k <= 8; k <<= 1)
#pragma unroll
        for (int j = k >> 1; j > 0; j >>= 1)
#pragma unroll
            for (int i = 0; i < 8; ++i) { const int l = i ^ j; if (l > i) { if ((i & k) == 0 || k == 8) CE2_DESC(v[i], p[i], v[l], p[l]); else CE2_DESC(v[l], p[l], v[i], p[i]); } }
}
constexpr int RT_KROW = 272;
__device__ __forceinline__ void route_half(float (&top)[16], LAS const unsigned char* keys_lds, const bf16_t* __restrict__ qrow, int r32, int hi) {
    bf16x8 qf[8]; float ss = 0.f;
#pragma unroll
    for (int ks = 0; ks < 8; ++ks) { qf[ks] = *(const bf16x8*)(qrow + 16 * ks + 8 * hi);
#pragma unroll
        for (int j = 0; j < 8; ++j) { const float f = bf2f((bf16_t)qf[ks][j]); ss += f * f; } }
    ss += __shfl_xor(ss, 32);
    const float rn = rsqrtf(ss * (1.f / 128.f) + EPS);
    f32x16 acc[4];
#pragma unroll
    for (int kt = 0; kt < 4; ++kt) {
#pragma unroll
        for (int r = 0; r < 16; ++r) acc[kt][r] = 0.f;
#pragma unroll
        for (int ks = 0; ks < 8; ++ks) { const bf16x8 kf = *(LAS const bf16x8*)(keys_lds + (32 * kt + r32) * RT_KROW + (16 * ks + 8 * hi) * 2);
            acc[kt] = __builtin_amdgcn_mfma_f32_32x32x16_bf16(kf, qf[ks], acc[kt], 0, 0, 0); }
        __builtin_amdgcn_sched_barrier(0);
    }
    const unsigned hi4 = (unsigned)hi << 2;
    float g[4][16];
#pragma unroll
    for (int kt = 0; kt < 4; ++kt)
#pragma unroll
        for (int r = 0; r < 16; ++r) { const unsigned base = (unsigned)(32 * kt + (r & 3) + 8 * (r >> 2)); g[kt][r] = __uint_as_float((__float_as_uint(acc[kt][r] * rn) & 0xFFFFFF80u) | base); }
#pragma unroll
    for (int kt = 0; kt < 4; ++kt) sort16_desc(g[kt]);
    merge16_desc(g[0], g[1]); merge16_desc(g[2], g[3]); merge16_desc(g[0], g[2]);
    float o[16];
#pragma unroll
    for (int i = 0; i < 16; ++i) { g[0][i] = __uint_as_float(__float_as_uint(g[0][i]) | hi4); o[i] = __shfl_xor(g[0][i], 32); }
    merge16_desc(g[0], o);
#pragma unroll
    for (int i = 0; i < 16; ++i) top[i] = g[0][i];
}
__device__ __forceinline__ void route_final(const float (&A)[16], const float (&B)[16], LAS unsigned char* tab, int* idx_out, float* gate_out, bool writer) {
    {
        unsigned w[8];
#pragma unroll
        for (int q = 0; q < 4; ++q) {
            w[q] = (__float_as_uint(A[4 * q]) & 127u) | ((__float_as_uint(A[4 * q + 1]) & 127u) << 8) | ((__float_as_uint(A[4 * q + 2]) & 127u) << 16) | ((__float_as_uint(A[4 * q + 3]) & 127u) << 24);
            w[4 + q] = (__float_as_uint(B[4 * q]) & 127u) | ((__float_as_uint(B[4 * q + 1]) & 127u) << 8) | ((__float_as_uint(B[4 * q + 2]) & 127u) << 16) | ((__float_as_uint(B[4 * q + 3]) & 127u) << 24);
        }
        *(LAS u32x4*)(tab) = (u32x4){w[0], w[1], w[2], w[3]}; *(LAS u32x4*)(tab + 16) = (u32x4){w[4], w[5], w[6], w[7]};
    }
    const float NEG = -INFINITY;
#define CAND(i, j) __uint_as_float((__float_as_uint(A[i] + B[j]) & 0xFFFFFF00u) | (unsigned)(((i) << 4) | (j)))
    float m1[16], m2[16], m3[16];
#pragma unroll
    for (int j = 0; j < 16; ++j) m1[j] = CAND(0, j);
#pragma unroll
    for (int i = 0; i < 16; ++i) m2[i] = (i < 15) ? CAND((i < 15 ? i + 1 : 0), 0) : NEG;
    merge16_desc(m1, m2);
    __builtin_amdgcn_sched_barrier(0);
#pragma unroll
    for (int j = 0; j < 16; ++j) m3[j] = (j < 7) ? CAND(1, (j < 7 ? j + 1 : 0)) : NEG;
#pragma unroll
    for (int i = 0; i < 16; ++i) m2[i] = (i < 6) ? CAND((i < 6 ? i + 2 : 0), 1) : NEG;
    merge16_desc(m3, m2);
    __builtin_amdgcn_sched_barrier(0);
    m2[0] = CAND(2, 2); m2[1] = CAND(2, 3); m2[2] = CAND(2, 4); m2[3] = CAND(3, 2); m2[4] = CAND(4, 2); m2[5] = CAND(3, 3);
#pragma unroll
    for (int i = 6; i < 16; ++i) m2[i] = NEG;
    sort16_desc(m2);
    merge16_desc(m3, m2);
    merge16_desc(m1, m3);
    __builtin_amdgcn_sched_barrier(0);
#undef CAND
    float e[16], den = 0.f; int ex[16];
#pragma unroll
    for (int i = 0; i < 16; ++i) { e[i] = __expf(m1[i] - m1[0]); den += e[i]; const unsigned r = __float_as_uint(m1[i]) & 255u; ex[i] = (int)tab[r >> 4] * 128 + (int)tab[16 + (r & 15u)]; }
    const float inv = 1.f / den;
    if (writer) {
#pragma unroll
        for (int i = 0; i < 4; ++i) { *(u32x4*)(idx_out + 4 * i) = (u32x4){(unsigned)ex[4 * i], (unsigned)ex[4 * i + 1], (unsigned)ex[4 * i + 2], (unsigned)ex[4 * i + 3]};
            *(f32x4*)(gate_out + 4 * i) = (f32x4){e[4 * i] * inv, e[4 * i + 1] * inv, e[4 * i + 2] * inv, e[4 * i + 3] * inv}; }
    }
}

namespace fa {
typedef short s16x4 __attribute__((ext_vector_type(4)));
constexpr int SLOT_V = 8192, SLOT_F = 16384, SLOT_BYTES = 16384 + 256;
constexpr int LDS_WS = 2 * SLOT_BYTES, LDS_OST = LDS_WS + 8 * 64 * 4, LDS_TOTAL = LDS_OST + 8 * 4096;
__device__ __forceinline__ int crow(int r, int hi) { return (r & 3) + 8 * (r >> 2) + 4 * hi; }
__device__ __forceinline__ void attn_unit(LAS unsigned char* lds, const bf16_t* __restrict__ PROJ, const float* __restrict__ F2T, bf16_t* OCAT, int b, int h, int qb, float kmax) {
    const int tid = ptid(), lane = tid & 63, r32 = lane & 31, hi = lane >> 5; const int wid = __builtin_amdgcn_readfirstlane(tid >> 6);
    const size_t rowbase = (size_t)b * SEQ; const int q0 = qb * 256;
    const bf16_t* Qw = PROJ + (rowbase + q0 + wid * 32) * NPROJ + C_Q + h * 64;
    const bf16_t* Kh = PROJ + rowbase * NPROJ + C_K + h * 64;
    const bf16_t* Vh = PROJ + rowbase * NPROJ + C_V + h * 64;
    const float* Fh = F2T + (size_t)(b * 8 + h) * SEQ;
    LAS float* wsf = (LAS float*)(lds + LDS_WS) + wid * 64;
    bf16x8 qr[4];
#pragma unroll
    for (int d0 = 0; d0 < 4; ++d0) qr[d0] = *(const bf16x8*)(Qw + (size_t)r32 * NPROJ + d0 * 16 + hi * 8);
    const float Fq = Fh[q0 + wid * 32 + r32];
    const int NT = 4 * qb + 4;
    int t0; float c0;
    {
        float qs = 0.f;
#pragma unroll
        for (int d0 = 0; d0 < 4; ++d0)
#pragma unroll
            for (int j = 0; j < 8; ++j) { const float f = bf2f((bf16_t)qr[d0][j]); qs += f * f; }
        qs += __shfl_xor(qs, 32);
        qs = wave_max(qs);
        if (lane == 0) wsf[0] = qs;
        __syncthreads();
        float qm = 0.f;
#pragma unroll
        for (int w = 0; w < 8; ++w) qm = fmaxf(qm, ((LAS float*)(lds + LDS_WS))[w * 64]);
        c0 = sqrtf(qm) * kmax;
        const float bound = 2.f * c0 + Fh[q0] + 40.f;
        const bool skip = (lane < NT - 4) && (bound - Fh[64 * lane + 63] < 0.f);
        const unsigned long long bal = __ballot(skip);
        t0 = __builtin_amdgcn_readfirstlane((int)__builtin_ctzll(~bal));
        __syncthreads();
    }
    const int krow = 8 * wid + (lane >> 3), kch = lane & 7;
    const bf16_t* ksrc = Kh + (size_t)krow * NPROJ + kch * 8;
    const int kdst = krow * 128 + ((kch ^ (krow & 7)) * 16);
    const bf16_t* vsrc = Vh + (size_t)(16 * (wid & 3) + (lane >> 2)) * NPROJ + (wid >> 2) * 32 + (lane & 3) * 8;
    const int sdst = wid * 1024 + lane * 16;
    u32x4 kreg = *(const u32x4*)(ksrc + (size_t)t0 * 64 * NPROJ), vreg = *(const u32x4*)(vsrc + (size_t)t0 * 64 * NPROJ);
    float freg = (wid == 0) ? Fh[t0 * 64 + lane] : 0.f;
    *(LAS u32x4*)(lds + kdst) = kreg; *(LAS u32x4*)(lds + SLOT_V + sdst) = vreg; if (wid == 0) *(LAS float*)(lds + SLOT_F + lane * 4) = freg;
    if (t0 + 1 < NT) { kreg = *(const u32x4*)(ksrc + (size_t)(t0 + 1) * 64 * NPROJ); vreg = *(const u32x4*)(vsrc + (size_t)(t0 + 1) * 64 * NPROJ); if (wid == 0) freg = Fh[(t0 + 1) * 64 + lane]; }
    __syncthreads();
    float l = 0.f; f32x16 o[2]; const float Fqs = Fq - c0;
#pragma unroll
    for (int r = 0; r < 16; ++r) { o[0][r] = 0.f; o[1][r] = 0.f; }
    const int qrel = wid * 32 + r32;
    int cur = 0;
    for (int t = t0; t < NT; ++t) {
        const bool more = (t + 1 < NT);
        u32x4 kreg2 = kreg, vreg2 = vreg; float freg2 = freg;
        if (t + 2 < NT) { kreg2 = *(const u32x4*)(ksrc + (size_t)(t + 2) * 64 * NPROJ); vreg2 = *(const u32x4*)(vsrc + (size_t)(t + 2) * 64 * NPROJ); if (wid == 0) freg2 = Fh[(t + 2) * 64 + lane]; }
        LAS unsigned char* slot = lds + cur * SLOT_BYTES;
        f32x16 p0, p1;
        { const LAS float* fk = (const LAS float*)(slot + SLOT_F);
#pragma unroll
          for (int g = 0; g < 4; ++g) { const f32x4 a = *(const LAS f32x4*)(fk + 8 * g + 4 * hi), c = *(const LAS f32x4*)(fk + 32 + 8 * g + 4 * hi);
#pragma unroll
              for (int i = 0; i < 4; ++i) { p0[4 * g + i] = Fqs - a[i]; p1[4 * g + i] = Fqs - c[i]; } } }
        { const LAS unsigned char* kb = slot + r32 * 128; const int sw = r32 & 7;
#pragma unroll
          for (int d0 = 0; d0 < 4; ++d0) { const int co = ((2 * d0 + hi) ^ sw) * 16; const bf16x8 b0 = *(const LAS bf16x8*)(kb + co), b1 = *(const LAS bf16x8*)(kb + co + 4096);
              p0 = __builtin_amdgcn_mfma_f32_32x32x16_bf16(b0, qr[d0], p0, 0, 0, 0); p1 = __builtin_amdgcn_mfma_f32_32x32x16_bf16(b1, qr[d0], p1, 0, 0, 0); } }
        const int jb = t - (NT - 4);
        if (jb >= 0) { const int kb0 = 64 * jb + 4 * hi;
#pragma unroll
            for (int r = 0; r < 16; ++r) { const int kv = kb0 + (r & 3) + 8 * (r >> 2); if (kv > qrel) p0[r] = -INFINITY; if (kv + 32 > qrel) p1[r] = -INFINITY; } }
        float rs = 0.f;
#pragma unroll
        for (int r = 0; r < 16; ++r) { p0[r] = __builtin_amdgcn_exp2f(p0[r]); p1[r] = __builtin_amdgcn_exp2f(p1[r]); rs += p0[r] + p1[r]; }
        l += rs;
        u32x4 pw0, pw1, pw2, pw3;
        pw0 = (u32x4){cvt_pk_bf16(p0[0], p0[1]), cvt_pk_bf16(p0[2], p0[3]), cvt_pk_bf16(p0[4], p0[5]), cvt_pk_bf16(p0[6], p0[7])};
        pw1 = (u32x4){cvt_pk_bf16(p0[8], p0[9]), cvt_pk_bf16(p0[10], p0[11]), cvt_pk_bf16(p0[12], p0[13]), cvt_pk_bf16(p0[14], p0[15])};
        pw2 = (u32x4){cvt_pk_bf16(p1[0], p1[1]), cvt_pk_bf16(p1[2], p1[3]), cvt_pk_bf16(p1[4], p1[5]), cvt_pk_bf16(p1[6], p1[7])};
        pw3 = (u32x4){cvt_pk_bf16(p1[8], p1[9]), cvt_pk_bf16(p1[10], p1[11]), cvt_pk_bf16(p1[12], p1[13]), cvt_pk_bf16(p1[14], p1[15])};
        { const int vb = (int)(unsigned)(size_t)(slot + SLOT_V) + ((lane >> 4) & 1) * 32 + (lane & 3) * 8 + (4 * hi + ((lane & 15) >> 2)) * 64;
#pragma unroll
          for (int d0 = 0; d0 < 2; ++d0) { s16x4 lo4[4], hi4[4];
#pragma unroll
              for (int ks = 0; ks < 4; ++ks) {
                  asm volatile("ds_read_b64_tr_b16 %0,%1 offset:%c2" : "=&v"(lo4[ks]) : "v"(vb), "i"(d0 * 4096 + ks * 1024) : "memory");
                  asm volatile("ds_read_b64_tr_b16 %0,%1 offset:%c2" : "=&v"(hi4[ks]) : "v"(vb), "i"(d0 * 4096 + ks * 1024 + 512) : "memory"); }
              asm volatile("s_waitcnt lgkmcnt(0)" ::: "memory"); __builtin_amdgcn_sched_barrier(0);
#define FA_PK(k) (bf16x8){lo4[k][0], lo4[k][1], lo4[k][2], lo4[k][3], hi4[k][0], hi4[k][1], hi4[k][2], hi4[k][3]}
              o[d0] = __builtin_amdgcn_mfma_f32_32x32x16_bf16(__builtin_bit_cast(bf16x8, pw0), FA_PK(0), o[d0], 0, 0, 0);
              o[d0] = __builtin_amdgcn_mfma_f32_32x32x16_bf16(__builtin_bit_cast(bf16x8, pw1), FA_PK(1), o[d0], 0, 0, 0);
              o[d0] = __builtin_amdgcn_mfma_f32_32x32x16_bf16(__builtin_bit_cast(bf16x8, pw2), FA_PK(2), o[d0], 0, 0, 0);
              o[d0] = __builtin_amdgcn_mfma_f32_32x32x16_bf16(__builtin_bit_cast(bf16x8, pw3), FA_PK(3), o[d0], 0, 0, 0);
#undef FA_PK
          } }
        if (more) { LAS unsigned char* nslot = lds + (cur ^ 1) * SLOT_BYTES;
            *(LAS u32x4*)(nslot + kdst) = kreg; *(LAS u32x4*)(nslot + SLOT_V + sdst) = vreg; if (wid == 0) *(LAS float*)(nslot + SLOT_F + lane * 4) = freg; }
        __syncthreads();
        cur ^= 1; kreg = kreg2; vreg = vreg2; freg = freg2;
    }
    l += __shfl_xor(l, 32);
    if (hi == 0) wsf[32 + r32] = l;
    asm volatile("s_waitcnt lgkmcnt(0)" ::: "memory");
    float rli[16];
#pragma unroll
    for (int r = 0; r < 16; ++r) rli[r] = __builtin_amdgcn_rcpf(wsf[32 + crow(r, hi)]);
    bf16_t* Ow = OCAT + (rowbase + q0 + wid * 32) * 1024 + h * 64;
    LAS bf16_t* stg = (LAS bf16_t*)(lds + LDS_OST) + wid * 2048;
#pragma unroll
    for (int r = 0; r < 16; ++r) { const int orow = crow(r, hi);
#pragma unroll
        for (int d0 = 0; d0 < 2; ++d0) stg[orow * 64 + d0 * 32 + r32] = f2bf(o[d0][r] * rli[r]); }
    asm volatile("s_waitcnt lgkmcnt(0)" ::: "memory");
#pragma unroll
    for (int i = 0; i < 4; ++i) { const int row = i * 8 + (lane >> 3), ch = lane & 7; const u32x4 v = *(const LAS u32x4*)(stg + row * 64 + ch * 8); *(u32x4*)(Ow + (size_t)row * 1024 + ch * 8) = v; }
    __syncthreads();
}
}

namespace hg {
constexpr int P272 = 272, P144 = 144;
constexpr int L_RAW = 2048, L_RLF = L_RAW, L_RQ = L_RAW + 16384, L_RKK = L_RAW + 32768, L_RI = L_RAW + 49152;
constexpr int L_QJ = 2048, L_KH = L_QJ + 160 * P272;
constexpr int L_KT = L_RI + 64 * P272, L_IT = L_KT + 128 * P144, L_P = L_IT + 128 * P144, L_SEGT = L_P + 64 * P144  , L_END = L_SEGT + 4096;
static_assert(L_KH + 64 * P272 <= L_KT && L_END <= RING_BYTES, "hgrn LDS");
__device__ __forceinline__ int crow(int r, int hi) { return (r & 3) + 8 * (r >> 2) + 4 * hi; }
__device__ __forceinline__ int qj_row0(int j) { return (j == 0) ? 0 : (j == 1) ? 64 : (j == 2) ? 112 : 144; }
struct RawRegs { u32x4 lf[2], q[2], iv[2]; };
__device__ __forceinline__ void raw_load(RawRegs& R, const bf16_t* __restrict__ PROJ, const bf16_t* __restrict__ KK, int unit, int tid) {
    const int bh = unit >> 6, cch = unit & 63, b = bh >> 2, h = bh & 3; const size_t row0 = (size_t)b * SEQ + cch * 64;
#pragma unroll
    for (int it = 0; it < 2; ++it) { const int id = tid + 512 * it, t = id >> 4, ch = id & 15;
        const bf16_t* pr = PROJ + (row0 + t) * NPROJ + h * 128 + 8 * ch;
        R.lf[it] = *(const u32x4*)(pr + C_LF); R.q[it] = *(const u32x4*)(pr + C_HQ); R.iv[it] = *(const u32x4*)(pr + C_HI);
        }
}
template <bool DRY> __device__ __forceinline__ void pass_a_all(LAS unsigned char* lds, bf16_t* PROJ, const bf16_t* __restrict__ KK, bf16_t* HST, float* HD, int u0, int ustep, int uend) {
    const int tid = ptid(), lane = tid & 63, r32 = lane & 31, hi = lane >> 5; const int wid = __builtin_amdgcn_readfirstlane(tid >> 6);
    LAS float* segt = (LAS float*)(lds + L_SEGT);
    RawRegs R;
    if (u0 < uend) raw_load(R, PROJ, KK, u0, tid);
    for (int unit = u0; unit < uend; unit += ustep) {
        const int bh = unit >> 6, cch = unit & 63, b = bh >> 2, h = bh & 3;
        const size_t row0 = (size_t)b * SEQ + cch * 64;
#pragma unroll
        for (int it = 0; it < 2; ++it) { const int id = tid + 512 * it, t = id >> 4, ch = id & 15;
            *(LAS u32x4*)(lds + L_RLF + t * 256 + ch * 16) = R.lf[it]; *(LAS u32x4*)(lds + L_RQ + t * 256 + ch * 16) = R.q[it];
            *(LAS u32x4*)(lds + L_RI + t * P272 + ch * 16) = R.iv[it]; }
        __syncthreads();
        if (unit + ustep < uend) raw_load(R, PROJ, KK, unit + ustep, tid);
        const int kp = tid & 63, sg8 = wid;
        float Aa[8][2], qv[8][2], kv[8][2];
        { float run0 = 0.f, run1 = 0.f;
#pragma unroll
          for (int i = 0; i < 8; ++i) { const int off = (8 * sg8 + i) * 256 + kp * 4;
              const unsigned wl = *(const LAS unsigned*)(lds + L_RLF + off), wq = *(const LAS unsigned*)(lds + L_RQ + off);
              const float l0 = h2f((unsigned short)(wl & 0xffffu)), l1 = h2f((unsigned short)(wl >> 16));
              run0 += l0; run1 += l1; Aa[i][0] = run0; Aa[i][1] = run1;
              qv[i][0] = __uint_as_float(wq << 16); qv[i][1] = __uint_as_float(wq & 0xffff0000u); kv[i][0] = 1.f - __expf(l0); kv[i][1] = 1.f - __expf(l1); }
          *(LAS f32x2_t*)(segt + sg8 * 128 + 2 * kp) = (f32x2_t){run0, run1}; }
        { const int tp = tid & 31, vc = tid >> 5;
            const bf16x8 r0 = *(const LAS bf16x8*)(lds + L_RI + (2 * tp) * P272 + vc * 16), r1 = *(const LAS bf16x8*)(lds + L_RI + (2 * tp + 1) * P272 + vc * 16);
#pragma unroll
            for (int e8 = 0; e8 < 8; ++e8) *(LAS unsigned*)(lds + L_IT + (8 * vc + e8) * P144 + tp * 4) = (unsigned)(unsigned short)r0[e8] | ((unsigned)(unsigned short)r1[e8] << 16); }
        __syncthreads();
        float E[4][2], pre[2] = {0.f, 0.f};
        { float s0 = 0.f, s1 = 0.f;
#pragma unroll
          for (int sgi = 0; sgi < 8; ++sgi) { const f32x2_t v = *(const LAS f32x2_t*)(segt + sgi * 128 + 2 * kp); if (sgi < sg8) { pre[0] += v.x; pre[1] += v.y; } s0 += v.x; s1 += v.y; if (sgi & 1) { E[sgi >> 1][0] = s0; E[sgi >> 1][1] = s1; } } }
        const int jo = sg8 >> 1;
        float Eown[2];
#pragma unroll
        for (int k2 = 0; k2 < 2; ++k2) Eown[k2] = (jo == 0) ? E[0][k2] : (jo == 1) ? E[1][k2] : (jo == 2) ? E[2][k2] : E[3][k2];
        {
            bf16_t* pq = PROJ + (row0 + 8 * sg8) * NPROJ + C_HQ + h * 128 + 2 * kp;
            unsigned kt[2][4];
            float fj[4][2], f0[2], f3[2];
#pragma unroll
            for (int k2 = 0; k2 < 2; ++k2) { f0[k2] = __expf(Eown[k2]); f3[k2] = __expf(E[3][k2] - Eown[k2]);
#pragma unroll
                for (int j = 0; j < 4; ++j) fj[j][k2] = __expf(Eown[k2] - E[j][k2]); }
#pragma unroll
            for (int i = 0; i < 8; ++i) {
                const int t = 8 * sg8 + i;
                float qe[2], ke1[2];
#pragma unroll
                for (int k2 = 0; k2 < 2; ++k2) { const float A = pre[k2] + Aa[i][k2]; const float e1 = __expf(A - Eown[k2]), r1 = __builtin_amdgcn_rcpf(e1);
                    qe[k2] = qv[i][k2] * e1; ke1[k2] = kv[i][k2] * r1; }
                if (!DRY) *(unsigned*)(pq + (size_t)i * NPROJ) = pk2(qe[0] * f0[0], qe[1] * f0[1]);
#pragma unroll
                for (int j = 0; j < 4; ++j) if (j <= jo) *(LAS unsigned*)(lds + L_QJ + (qj_row0(j) + t - 16 * j) * P272 + kp * 4) = (j == jo) ? pk2(qe[0], qe[1]) : pk2(qe[0] * fj[j][0], qe[1] * fj[j][1]);
                *(LAS unsigned*)(lds + L_KH + t * P272 + kp * 4) = pk2(ke1[0], ke1[1]);
#pragma unroll
                for (int k2 = 0; k2 < 2; ++k2) { const unsigned ke = f2bf(ke1[k2] * f3[k2]); if (i & 1) kt[k2][i >> 1] |= ke << 16; else kt[k2][i >> 1] = ke; }
            }
#pragma unroll
            for (int k2 = 0; k2 < 2; ++k2) *(LAS u32x4*)(lds + L_KT + (2 * kp + k2) * P144 + sg8 * 16) = (u32x4){kt[k2][0], kt[k2][1], kt[k2][2], kt[k2][3]};
            if (sg8 == 0) *(f32x2_t*)(HD + (size_t)unit * 128 + 2 * kp) = (f32x2_t){__expf(E[3][0]), __expf(E[3][1])};
        }
        __syncthreads();
        {
            const int fr = lane & 15, fq = lane >> 4;
#pragma unroll
            for (int bb = 0; bb < 2; ++bb) {
                const int blk = 2 * wid + bb, bi = blk >> 2, bj = blk & 3;
                f32x4 acc = (f32x4){0.f, 0.f, 0.f, 0.f};
                if (bj <= bi) {
                    const LAS unsigned char* ap = lds + L_QJ + (qj_row0(bj) + 16 * (bi - bj) + fr) * P272 + fq * 16;
                    const LAS unsigned char* bp = lds + L_KH + (16 * bj + fr) * P272 + fq * 16;
#pragma unroll
                    for (int s = 0; s < 4; ++s) acc = __builtin_amdgcn_mfma_f32_16x16x32_bf16(*(const LAS bf16x8*)(ap + s * 64), *(const LAS bf16x8*)(bp + s * 64), acc, 0, 0, 0);
                }
#pragma unroll
                for (int r = 0; r < 4; ++r) { const int tl = 4 * fq + r; float v = acc[r]; if (bi == bj && fr > tl) v = 0.f;
                    *(LAS bf16_t*)(lds + L_P + (16 * bi + tl) * P144 + (16 * bj + fr) * 2) = f2bf(v); }
            }
        }
        __syncthreads();
        constexpr int L_SU = L_QJ, L_SO = L_QJ + 128 * P272;
        {
            const int vt = wid & 3, tt = wid >> 2;
            f32x16 acc;
#pragma unroll
            for (int r = 0; r < 16; ++r) acc[r] = 0.f;
#pragma unroll
            for (int ks = 0; ks < 4; ++ks) acc = __builtin_amdgcn_mfma_f32_32x32x16_bf16(*(const LAS bf16x8*)(lds + L_IT + (32 * vt + r32) * P144 + (16 * ks + 8 * hi) * 2), *(const LAS bf16x8*)(lds + L_P + (32 * tt + r32) * P144 + (16 * ks + 8 * hi) * 2), acc, 0, 0, 0);
#pragma unroll
            for (int g = 0; g < 4; ++g) { u32x2 w; w.x = cvt_pk_bf16(acc[4 * g], acc[4 * g + 1]); w.y = cvt_pk_bf16(acc[4 * g + 2], acc[4 * g + 3]); *(LAS u32x2*)(lds + L_SO + (32 * tt + r32) * P272 + (32 * vt + 8 * g + 4 * hi) * 2) = w; }
        }
        {
            const int kt_ = wid & 3;
#pragma unroll
            for (int vv = 0; vv < 2; ++vv) { const int vt = 2 * (wid >> 2) + vv;
                f32x16 acc;
#pragma unroll
                for (int r = 0; r < 16; ++r) acc[r] = 0.f;
#pragma unroll
                for (int ks = 0; ks < 4; ++ks) acc = __builtin_amdgcn_mfma_f32_32x32x16_bf16(*(const LAS bf16x8*)(lds + L_KT + (32 * kt_ + r32) * P144 + (16 * ks + 8 * hi) * 2), *(const LAS bf16x8*)(lds + L_IT + (32 * vt + r32) * P144 + (16 * ks + 8 * hi) * 2), acc, 0, 0, 0);
#pragma unroll
                for (int g = 0; g < 4; ++g) { u32x2 w; w.x = cvt_pk_bf16(acc[4 * g], acc[4 * g + 1]); w.y = cvt_pk_bf16(acc[4 * g + 2], acc[4 * g + 3]); *(LAS u32x2*)(lds + L_SU + (32 * vt + r32) * P272 + (32 * kt_ + 8 * g + 4 * hi) * 2) = w; } }
        }
        __syncthreads();
#pragma unroll
        for (int it = 0; it < 4; ++it) { const int id = tid + 512 * it, v = id >> 4, ch = id & 15;
            *(u32x4*)(HST + (size_t)unit * 16384 + (size_t)id * 8) = *(const LAS u32x4*)(lds + L_SU + v * P272 + ch * 16); }
        if (!DRY) {
#pragma unroll
            for (int it = 0; it < 2; ++it) { const int id = tid + 512 * it, t = id >> 4, ch = id & 15;
                *(u32x4*)(PROJ + (row0 + t) * NPROJ + C_LF + h * 128 + 8 * ch) = *(const LAS u32x4*)(lds + L_SO + t * P272 + ch * 16); }
        }
        __syncthreads();
    }
}
__device__ __forceinline__ void pass_b(bf16_t* HST, const float* __restrict__ HD, int grp) {
    const int bh = grp >> 12, rem = grp & 4095;
    float s0 = 0.f, s1 = 0.f, s2 = 0.f, s3 = 0.f;
    bf16_t* p = HST + (size_t)bh * 64 * 16384 + rem * 4;
    const float* pd = HD + (size_t)bh * 64 * 128 + (rem & 31) * 4;
#pragma unroll 8
    for (int cch = 0; cch < 64; ++cch) {
        const u32x2 u = *(const u32x2*)(p + (size_t)cch * 16384); const f32x4 d = *(const f32x4*)(pd + cch * 128);
        u32x2 w; w.x = pk2(s0, s1); w.y = pk2(s2, s3); *(u32x2*)(p + (size_t)cch * 16384) = w;
        s0 = d.x * s0 + __uint_as_float(u.x << 16); s1 = d.y * s1 + __uint_as_float(u.x & 0xffff0000u);
        s2 = d.z * s2 + __uint_as_float(u.y << 16); s3 = d.w * s3 + __uint_as_float(u.y & 0xffff0000u);
    }
}
constexpr int CL_PART = 0, CL_ST = 2048, CL_QT = CL_ST + 128 * P272, CL_OI = CL_QT + 64 * P272, CL_SG = CL_OI + 64 * P272, CL_END = CL_SG + 64 * P272;
static_assert(CL_END <= RING_BYTES, "hgrn pass C LDS");
struct CRegs { u32x4 st[4], qt[2], oi[2], sg[2]; };
__device__ __forceinline__ void c_load(CRegs& R, const bf16_t* __restrict__ PROJ, const bf16_t* __restrict__ HST, int unit, int tid) {
    const int bh = unit >> 6, cch = unit & 63, b = bh >> 2, h = bh & 3; const size_t row0 = (size_t)b * SEQ + cch * 64;
#pragma unroll
    for (int it = 0; it < 4; ++it) R.st[it] = *(const u32x4*)(HST + (size_t)unit * 16384 + (size_t)(tid + 512 * it) * 8);
#pragma unroll
    for (int it = 0; it < 2; ++it) { const int id = tid + 512 * it, t = id >> 4, ch = id & 15;
        const bf16_t* pr = PROJ + (row0 + t) * NPROJ + h * 128 + 8 * ch;
        R.qt[it] = *(const u32x4*)(pr + C_HQ); R.oi[it] = *(const u32x4*)(pr + C_LF); R.sg[it] = *(const u32x4*)(pr + C_SG); }
}
__device__ __forceinline__ void pass_c_all(LAS unsigned char* lds, const bf16_t* __restrict__ PROJ, const bf16_t* __restrict__ HST, const float* __restrict__ gn, bf16_t* OCAT, int u0, int ustep, int uend) {
    const int tid = ptid(), lane = tid & 63, r32 = lane & 31, hi = lane >> 5; const int wid = __builtin_amdgcn_readfirstlane(tid >> 6);
    const int vt = wid & 3, tt = wid >> 2, tl = 32 * tt + r32;
    LAS float* part = (LAS float*)(lds + CL_PART);
    CRegs R;
    if (u0 < uend) c_load(R, PROJ, HST, u0, tid);
    int par = 0;
    for (int unit = u0; unit < uend; unit += ustep, par ^= 1) {
        const int bh = unit >> 6, cch = unit & 63, b = bh >> 2, h = bh & 3;
        const size_t row0 = (size_t)b * SEQ + cch * 64;
#pragma unroll
        for (int it = 0; it < 4; ++it) { const int id = tid + 512 * it, v = id >> 4, ch = id & 15; *(LAS u32x4*)(lds + CL_ST + v * P272 + ch * 16) = R.st[it]; }
#pragma unroll
        for (int it = 0; it < 2; ++it) { const int id = tid + 512 * it, t = id >> 4, ch = id & 15;
            *(LAS u32x4*)(lds + CL_QT + t * P272 + ch * 16) = R.qt[it]; *(LAS u32x4*)(lds + CL_OI + t * P272 + ch * 16) = R.oi[it]; *(LAS u32x4*)(lds + CL_SG + t * P272 + ch * 16) = R.sg[it]; }
        __syncthreads();
        if (unit + ustep < uend) c_load(R, PROJ, HST, unit + ustep, tid);
        f32x16 acc;
#pragma unroll
        for (int g = 0; g < 4; ++g) { const u32x2 w = *(const LAS u32x2*)(lds + CL_OI + tl * P272 + (32 * vt + 8 * g + 4 * hi) * 2);
            acc[4 * g] = __uint_as_float(w.x << 16); acc[4 * g + 1] = __uint_as_float(w.x & 0xffff0000u); acc[4 * g + 2] = __uint_as_float(w.y << 16); acc[4 * g + 3] = __uint_as_float(w.y & 0xffff0000u); }
#pragma unroll
        for (int ks = 0; ks < 8; ++ks) acc = __builtin_amdgcn_mfma_f32_32x32x16_bf16(*(const LAS bf16x8*)(lds + CL_ST + (32 * vt + r32) * P272 + (16 * ks + 8 * hi) * 2), *(const LAS bf16x8*)(lds + CL_QT + tl * P272 + (16 * ks + 8 * hi) * 2), acc, 0, 0, 0);
        float ss = 0.f;
#pragma unroll
        for (int r = 0; r < 16; ++r) ss += acc[r] * acc[r];
        ss += __shfl_xor(ss, 32);
        LAS float* pp = part + par * 256;
        if (hi == 0) pp[vt * 64 + tl] = ss;
        __syncthreads();
        const float rn = rsqrtf((pp[tl] + pp[64 + tl] + pp[128 + tl] + pp[192 + tl]) * (1.f / 128.f) + EPS);
        const float* pg = gn + h * 128 + 32 * vt + 4 * hi;
#pragma unroll
        for (int g = 0; g < 4; ++g) { const u32x2 sw = *(const LAS u32x2*)(lds + CL_SG + tl * P272 + (32 * vt + 8 * g + 4 * hi) * 2); const f32x4 gv = *(const f32x4*)(pg + 8 * g);
            u32x2 w; w.x = cvt_pk_bf16(acc[4 * g] * rn * gv.x * __uint_as_float(sw.x << 16), acc[4 * g + 1] * rn * gv.y * __uint_as_float(sw.x & 0xffff0000u));
            w.y = cvt_pk_bf16(acc[4 * g + 2] * rn * gv.z * __uint_as_float(sw.y << 16), acc[4 * g + 3] * rn * gv.w * __uint_as_float(sw.y & 0xffff0000u));
            *(LAS u32x2*)(lds + CL_OI + tl * P272 + (32 * vt + 8 * g + 4 * hi) * 2) = w; }
        __syncthreads();
#pragma unroll
        for (int it = 0; it < 2; ++it) { const int id = tid + 512 * it, t = id >> 4, ch = id & 15;
            *(u32x4*)(OCAT + (row0 + t) * 1024 + 512 + h * 128 + 8 * ch) = *(const LAS u32x4*)(lds + CL_OI + t * P272 + ch * 16); }
        __syncthreads();
    }
}
}

__global__ void __launch_bounds__(NTHREADS, 2) mega(Args a) {
    extern __shared__ __attribute__((aligned(16))) unsigned char lds_raw[];
    LAS unsigned char* lds = (LAS unsigned char*)lds_raw;
    volatile LAS unsigned* MISC = (volatile LAS unsigned*)(lds + MISC_OFF);
    const int tid0 = threadIdx.x, wave = __builtin_amdgcn_readfirstlane(tid0 >> 6);
    const int G = gridDim.x, bx = blockIdx.x, vcu = (G % 8 == 0) ? (bx % 8) * (G / 8) + bx / 8 : bx;
    const int gw = vcu * NWAVES + wave, NGW = G * NWAVES;
    unsigned* ctl = (unsigned*)(a.ws + WS_CTL);
    for (int u = tid0; u < (LDS_BYTES - RING_BYTES) / 4; u += NTHREADS) ((LAS unsigned*)(lds + RING_BYTES))[u] = 0u;
    __syncthreads();
    XcdBarrier bar = xcd_barrier_post(ctl + CW_BAR + a.li * XCD_BAR_WORDS, MISC + 8);
    const int lo = a.ph_lo, hi = a.ph_hi;
    if (TPROBE >= 0 && blockIdx.x == 0 && threadIdx.x == 0) ((unsigned long long*)(ctl + 8192))[0] = __builtin_amdgcn_s_memrealtime();
#ifndef PH_COMPILE
#define PH_COMPILE 0x7FF
#endif
#define IN(k) ((((PH_COMPILE) >> (k)) & 1) && lo <= (k) && (k) < hi)
#define STAMP(i) do { if (TPROBE >= 0 && bx == 0 && tid0 == 0) ((unsigned long long*)(ctl + 8192))[i] = __builtin_amdgcn_s_memrealtime(); } while (0)
#define SEAM(k) do { if (IN(k) && IN((k) + 1)) xcd_barrier(bar); STAMP((k) + 1); } while (0)

    typedef const __attribute__((address_space(4))) Args* KArgs;
#define PHASE_PTRS \
    KArgs ka = (KArgs)__builtin_amdgcn_kernarg_segment_ptr(); asm volatile("" : "+s"(ka)); \
    const int tid = ptid(), lane = tid & 63; (void)lane; \
    unsigned char* ws = ka->ws; (void)ws; \
    const float* x = ka->in[0]; const float* c_in = ka->in[1]; const float* w_ada = ka->in[2]; const float* b_ada = ka->in[3]; \
    const float* pre_mix_g = ka->in[4]; const float* w_in = ka->in[6]; const float* b_fox_f = ka->in[7]; const float* gamma = ka->in[8]; \
    const float* w_out = ka->in[10]; const float* w_q = ka->in[13]; const float* sub_keys = ka->in[14]; const float* U = ka->in[15]; const float* V = ka->in[16]; \
    float* MOD = (float*)(ws + WS_MOD); float* LB = (float*)(ws + WS_LB); float* WFF = (float*)(ws + WS_WFF); \
    bf16_t* WIN = (bf16_t*)(ws + WS_WIN); bf16_t* WOUT = (bf16_t*)(ws + WS_WOUT); bf16_t* WQ = (bf16_t*)(ws + WS_WQ); bf16_t* KEYS = (bf16_t*)(ws + WS_KEYS); \
    float* LOGF = (float*)(ws + WS_F); float* F2T = (float*)(ws + WS_F2T); bf16_t* H = (bf16_t*)(ws + WS_H); bf16_t* PROJ = (bf16_t*)(ws + WS_PROJ); bf16_t* KK = (bf16_t*)(ws + WS_KK); \
    bf16_t* OCAT = (bf16_t*)(ws + WS_OCAT); bf16_t* MIX = H; bf16_t* H2 = OCAT; bf16_t* Q2 = (bf16_t*)(ws + WS_Q2); \
    (void)x; (void)c_in; (void)w_ada; (void)b_ada; (void)pre_mix_g; (void)w_in; (void)b_fox_f; (void)gamma; (void)w_out; (void)w_q; (void)sub_keys; (void)U; (void)V; \
    (void)MOD; (void)LB; (void)WFF; (void)WIN; (void)WOUT; (void)WQ; (void)KEYS; (void)LOGF; (void)F2T; (void)H; (void)PROJ; (void)KK; (void)OCAT; (void)MIX; (void)H2; (void)Q2;
    const int flags = a.flags;

    for (int rep_ = 0; rep_ < ((DUP_PHASE == 0) ? 2 : 1); ++rep_) if (IN(0)) { PHASE_PTRS
        LAS float* condl = (LAS float*)lds;
        for (int i = tid; i < 8192; i += NTHREADS) { const float cv = c_in[i]; condl[i] = cv * sigmoidf_(cv); }
        __syncthreads();
        for (int it = gw; it < 768; it += NGW) {
            const int j = it * 8 + (lane & 7), ks = lane >> 3;
            float acc[8];
#pragma unroll
            for (int b = 0; b < 8; ++b) acc[b] = 0.f;
            const float* wp = w_ada + (size_t)ks * 6144 + j;
#pragma unroll 8
            for (int i = 0; i < 128; ++i) { const float w = wp[(size_t)i * 8 * 6144]; const int k = ks + 8 * i;
#pragma unroll
                for (int b = 0; b < 8; ++b) acc[b] += condl[b * 1024 + k] * w; }
#pragma unroll
            for (int b = 0; b < 8; ++b) { float v = acc[b]; v += __shfl_xor(v, 8); v += __shfl_xor(v, 16); v += __shfl_xor(v, 32); acc[b] = v; }
            if (lane < 8) { const float bb = b_ada[j];
#pragma unroll
                for (int b = 0; b < 8; ++b) MOD[b * 6144 + j] = acc[b] + bb; }
        }
        if (gw == NGW - 1) { for (int i = lane; i < 512; i += 64) LB[i] = 1.f / (1.f + __expf(gamma[512 + i] - gamma[i])); ((float*)(ws + WS_LB + 4096))[lane] = 0.f; ((float*)(ws + WS_LB + 4096))[64 + lane] = 0.f; }
        LAS float* scr = (LAS float*)(lds + 32768 + wave * 8448);
        for (int it = gw; it < 3328; it += NGW) {
            int r = it;
            if (r < 768) { transpose_item(w_in, 3592, 0, WIN, 0, scr, r, 48, lane); continue; } r -= 768;
            if (r < 1024) { transpose_item(w_in, 3592, 1544, WIN, 1536, scr, r, 64, lane); continue; } r -= 1024;
            if (r < 512) { transpose_item(w_out, 1024, 0, WOUT, 0, scr, r, 32, lane); continue; } r -= 512;
            transpose_item(w_q, 2048, 0, WQ, 0, scr, r, 64, lane);
        }
        for (int i = gw * 64 + lane; i < 8192; i += NGW * 64) { const int jj = i >> 10, k = i & 1023; WFF[i] = w_in[(size_t)k * 3592 + 1536 + jj]; }
        for (int i = gw * 64 + lane; i < 65536; i += NGW * 64) { const f32x4 v = *(const f32x4*)(sub_keys + (size_t)i * 4); u32x2 o; o.x = pk2(v.x, v.y); o.y = pk2(v.z, v.w); *(u32x2*)(KEYS + (size_t)i * 4) = o; }
    }
    SEAM(0);
    for (int rep_ = 0; rep_ < ((DUP_PHASE == 1) ? 2 : 1); ++rep_) if (IN(1)) { PHASE_PTRS const int rpw = (T + NGW - 1) / NGW; h_rows(x, pre_mix_g, MOD, WFF, b_fox_f, H, LOGF, gw * rpw, (gw * rpw + rpw < T) ? gw * rpw + rpw : T, lane); }
    SEAM(1);
    if (DUP_PHASE == 99) { for (int i = 0; i < 10; ++i) xcd_barrier(bar); }
    for (int rep_ = 0; rep_ < ((DUP_PHASE == 2) ? 2 : 1); ++rep_) if (IN(2)) { PHASE_PTRS
        if (bx < 64) {
            const int bh = bx, b = bh >> 3, h = bh & 7;
            LAS float* wtot = (LAS float*)lds;
            const float* p = LOGF + ((size_t)b * SEQ + tid * 8) * 8 + h;
            float v[8], tot = 0.f;
#pragma unroll
            for (int i = 0; i < 8; ++i) { v[i] = p[i * 8]; tot += v[i]; }
            float incl = tot;
#pragma unroll
            for (int o = 1; o < 64; o <<= 1) { const float n = __shfl_up(incl, o); if (lane >= o) incl += n; }
            if (lane == 63) wtot[wave] = incl;
            __syncthreads();
            float base = incl - tot;
            for (int w = 0; w < wave; ++w) base += wtot[w];
            u32x4 dummy; (void)dummy;
            float run = base;
            float* o = F2T + (size_t)bh * SEQ + tid * 8;
#pragma unroll
            for (int i = 0; i < 8; ++i) { run += v[i]; o[i] = run * LOG2E; }
            __syncthreads();
        }
        pg8::Gemm g{H, WIN, T, NPROJ, 1024}; pg8::StaticOrder S; S.init(T, NPROJ, G, bx, WGM_G1);
        EpiProjT E{PROJ, KK, LB, (unsigned*)(ws + WS_LB + 4096)};
        pg8::gemm_phase<EpiProjT, pg8::StaticOrder, true, true>(lds, g, S, E);
    }
    SEAM(2);
    if (IN(3)) { PHASE_PTRS
        const float* KMAXH = (const float*)(ws + WS_LB + 4096);
        if (flags & FL_HGRN) hg::pass_a_all<false>(lds, PROJ, KK, (bf16_t*)(ws + WS_HST), (float*)(ws + WS_HD), vcu, G, 2048);
        xcd_barrier(bar); STAMP(20);
        if (flags & FL_HGRN) { for (int g = vcu * NTHREADS + tid; g < 32 * 4096; g += G * NTHREADS) hg::pass_b((bf16_t*)(ws + WS_HST), (const float*)(ws + WS_HD), g); }
        if (flags & FL_ATTN) {
            unsigned* qctr = ctl + CW_ATTNQ;
            LAS int* ubox = (LAS int*)(lds + RING_BYTES + 64);
            for (int rep_ = 0; rep_ < ((DUP_PHASE == 3) ? 2 : 1); ++rep_)
            for (;;) {
                if (tid == 0) *ubox = (int)atomicAdd(qctr + 64 * rep_, 1u);
                __syncthreads();
                const int u = *ubox;
                __syncthreads();
                if (u >= 1024) break;
                const int qb = 15 - (u >> 6), bh = u & 63;
                fa::attn_unit(lds, PROJ, F2T, OCAT, bh >> 3, bh & 7, qb, sqrtf(KMAXH[2 * bh] + KMAXH[2 * bh + 1]));
            }
        }
    }
    SEAM(3);
    for (int rep_ = 0; rep_ < ((DUP_PHASE == 5) ? 2 : 1); ++rep_) if (IN(5) && (flags & FL_HGRN)) { PHASE_PTRS hg::pass_c_all(lds, PROJ, (const bf16_t*)(ws + WS_HST), ka->in[9], OCAT, vcu, G, 2048); }
    SEAM(5);
    for (int rep_ = 0; rep_ < ((DUP_PHASE == 6) ? 2 : 1); ++rep_) if (IN(6)) { PHASE_PTRS
        pg8::Gemm g{OCAT, WOUT, T, 1024, 1024}; pg8::StaticOrder S; S.init(T, 1024, G, bx, WGM_G2);
        EpiPlainT E{MIX, 1024};
        pg8::gemm_phase<EpiPlainT, pg8::StaticOrder, true, true>(lds, g, S, E);
    }
    SEAM(6);
    for (int rep_ = 0; rep_ < ((DUP_PHASE == 7) ? 2 : 1); ++rep_) if (IN(7)) { PHASE_PTRS const int rpw = (T + NGW - 1) / NGW; row_passes(x, MIX, MOD, ka->in[5], ka->in[11], (bf16_t*)(ws + WS_HST), H2, gw * rpw, (gw * rpw + rpw < T) ? gw * rpw + rpw : T, lane); }
    SEAM(7);
    for (int rep_ = 0; rep_ < ((DUP_PHASE == 8) ? 2 : 1); ++rep_) if (IN(8)) { PHASE_PTRS
        pg8::Gemm g{H2, WQ, T, NQ2, 1024}; pg8::StaticOrder S; S.init(T, NQ2, G, bx, WGM_G3);
        EpiPlainT E{Q2, NQ2};
        pg8::gemm_phase<EpiPlainT, pg8::StaticOrder, true, true>(lds, g, S, E);
    }
    SEAM(8);
    for (int rep_ = 0; rep_ < ((DUP_PHASE == 9) ? 2 : 1); ++rep_) if (IN(9)) { PHASE_PTRS
        const int h = vcu & 7;
        {
            const bf16_t* ksrc = KEYS + (size_t)h * 2 * 128 * 128;
            for (int i = tid; i < 4096; i += NTHREADS) { const int row = i >> 4, ch = i & 15; *(LAS u32x4*)(lds + row * RT_KROW + ch * 16) = *(const u32x4*)(ksrc + row * 128 + ch * 8); }
        }
        __syncthreads();
        const int r32 = lane & 31, hi = lane >> 5;
        int* IDXw = (int*)(ws + WS_IDX); float* GATEw = (float*)(ws + WS_GATE);
        int qi = 0;
        const int qrows = (NEXP + NGW - 1) / NGW;
        for (int tb = (vcu >> 3); tb < T / 256; tb += G / 8) {
            const int t = tb * 256 + wave * 32 + r32;
            const bf16_t* qrow = Q2 + (size_t)t * NQ2 + h * 256;
            float A[16], B[16];
            f32x4 qa[4], qb[4];
            const int ra = gw * qrows + qi, rb_ = ra + 1; const bool oka = (qi < qrows) && (ra < NEXP), okb = (qi + 1 < qrows) && (rb_ < NEXP);
            if (oka) qrow_load(qa, U, ra, lane); if (okb) qrow_load(qb, U, rb_, lane);
            route_half(A, lds, qrow, r32, hi);
            __builtin_amdgcn_sched_barrier(0);
            if (oka) qrow_store(qa, ws + WS_UQ, (float*)(ws + WS_US), ra, lane); if (okb) qrow_store(qb, ws + WS_UQ, (float*)(ws + WS_US), rb_, lane);
            if (oka) qrow_load(qa, V, ra, lane); if (okb) qrow_load(qb, V, rb_, lane);
            route_half(B, lds + 128 * RT_KROW, qrow + 128, r32, hi);
            __builtin_amdgcn_sched_barrier(0);
            if (oka) qrow_store(qa, ws + WS_UQ + 8, (float*)(ws + WS_VS), ra, lane); if (okb) qrow_store(qb, ws + WS_UQ + 8, (float*)(ws + WS_VS), rb_, lane);
            qi += 2;
            route_final(A, B, lds + 256 * RT_KROW + tid * 32, IDXw + (size_t)t * 128 + h * 16, GATEw + (size_t)t * 128 + h * 16, hi == 0);
        }
        for (; qi < qrows; ++qi) { const int r = gw * qrows + qi; if (r < NEXP) { f32x4 qa[4]; qrow_load(qa, U, r, lane); qrow_store(qa, ws + WS_UQ, (float*)(ws + WS_US), r, lane); qrow_load(qa, V, r, lane); qrow_store(qa, ws + WS_UQ + 8, (float*)(ws + WS_VS), r, lane); } }
    }
    SEAM(9);
    if (IN(10)) { PHASE_PTRS
        const int* IDX = (const int*)(ws + WS_IDX); const float* GATE = (const float*)(ws + WS_GATE);
        for (int rep_ = ((DUP_PHASE == 10) ? 0 : 1); rep_ < 2; ++rep_) { float* outp = rep_ ? ka->out : (float*)(ws + 280 * MiB);
            const int rmask = (rep_ == 0 && DUP_MODE == 1) ? 255 : 0x3FFF;
            float pd = 0.f;
            if (TPROBE >= 0) { const unsigned long long* ts = (const unsigned long long*)(ctl + 8192); const int i0_ = (TPROBE == 30) ? 3 : (TPROBE == 31) ? 20 : (TPROBE == 5) ? 4 : TPROBE, i1_ = (TPROBE == 30) ? 20 : (TPROBE == 31) ? 4 : TPROBE + 1;
                const float dus = (float)(long long)(__hip_atomic_load(ts + i1_, __ATOMIC_RELAXED, __HIP_MEMORY_SCOPE_AGENT) - __hip_atomic_load(ts + i0_, __ATOMIC_RELAXED, __HIP_MEMORY_SCOPE_AGENT)) * 0.01f;
                pd = sqrtf(16.f * 0.004f * fminf(fmaxf(dus, 0.f), TPROBE_FS) / TPROBE_FS); }
            {
                const int tpw = (T + NGW - 1) / NGW, tb0 = vcu * NWAVES * tpw, b = (tb0 < T ? tb0 : 0) / SEQ;
                LAS float* pv = (LAS float*)lds; const float* md = MOD + b * 6144; const float* g_pre = ka->in[11]; const float* g_post = ka->in[12];
                for (int i = tid; i < 1024; i += NTHREADS) { pv[i] = g_pre[i] * (md[4096 + i] + 1.f); pv[1024 + i] = md[3072 + i]; pv[2048 + i] = md[5120 + i] * g_post[i]; }
                __syncthreads();
                const int t0 = gw * tpw, t1 = (t0 + tpw < T) ? t0 + tpw : T;
#pragma unroll 1
                for (int t = t0; t < t1; ++t) expert_token((const unsigned char*)(ws + WS_UQ), (const float*)(ws + WS_US), (const float*)(ws + WS_VS), IDX, GATE, pv, (const bf16_t*)(ws + WS_HST), outp, t, lane, rmask, (t < 2048) ? 1.f + pd : 1.f);
                __syncthreads();
            } }
    }
#undef IN
#undef SEAM
}

extern "C" void kernel_launch(void* const* d_in, const int* in_sizes, int n_in, void* d_out, int out_size, void* d_ws, size_t ws_size, hipStream_t stream) {
    if (n_in != 17 || in_sizes[0] != T * DM || out_size != T * DM || ws_size < WS_END) { fprintf(stderr, "kernel_launch: unexpected inputs (n_in %d, ws %zu); nothing launched\n", n_in, ws_size); return; }
    static int grid = 0;
    if (grid == 0) {
        int dev = 0, cus = 0, per_cu = 0;
        if (hipGetDevice(&dev) != hipSuccess || hipDeviceGetAttribute(&cus, hipDeviceAttributeMultiprocessorCount, dev) != hipSuccess) { grid = -1; return; }
        if (hipFuncSetAttribute((const void*)mega, hipFuncAttributeMaxDynamicSharedMemorySize, LDS_BYTES) != hipSuccess) { fprintf(stderr, "kernel_launch: hipFuncSetAttribute failed\n"); grid = -1; return; }
        if (hipOccupancyMaxActiveBlocksPerMultiprocessor(&per_cu, (const void*)mega, NTHREADS, LDS_BYTES) != hipSuccess || per_cu < 1) { fprintf(stderr, "kernel_launch: occupancy query says %d\n", per_cu); (void)hipGetLastError(); grid = -1; return; }
        grid = cus;
        { const int rpw = (T + grid * NWAVES - 1) / (grid * NWAVES); if (SEQ % rpw != 0) { fprintf(stderr, "kernel_launch: %d CUs: the row passes give each wave %d consecutive rows, which must not straddle a batch; nothing launched\n", grid, rpw); grid = -1; return; } }
        if (grid % 8 != 0) { fprintf(stderr, "kernel_launch: %d CUs: the routing phase deals heads over groups of 8 workgroups; nothing launched\n", grid); grid = -1; return; }
    }
    if (grid < 0) return;
    if (hipMemsetAsync((unsigned char*)d_ws + WS_CTL, 0, CTL_ZERO_BYTES, stream) != hipSuccess) return;
    Args a{}; for (int i = 0; i < 17; ++i) a.in[i] = (const float*)d_in[i];
    a.out = (float*)d_out; a.ws = (unsigned char*)d_ws; a.ph_lo = 0; a.ph_hi = 11; a.li = 0; a.flags = FL_ATTN | FL_HGRN;
    hipLaunchKernelGGL(mega, dim3(grid), dim3(NTHREADS), LDS_BYTES, stream, a);
}
```

```cpp
#include <hip/hip_runtime.h>
#include <stdint.h>
#include <cstdio>

typedef unsigned short bf16_t;
typedef short bf16x8 __attribute__((ext_vector_type(8)));
typedef float f32x4 __attribute__((ext_vector_type(4)));
typedef float f32x16 __attribute__((ext_vector_type(16)));
typedef unsigned u32x4 __attribute__((ext_vector_type(4)));
typedef unsigned u32x2 __attribute__((ext_vector_type(2)));

constexpr int BATCH = 8, SEQ = 4096, DM = 1024, T = BATCH * SEQ;
constexpr int NPROJ = 3584;
constexpr int C_Q = 0, C_K = 512, C_V = 1024, C_HQ = 1536, C_LF = 2048, C_HI = 2560, C_SG = 3072;
constexpr int NQ2 = 2048, NEXP = 16384;
constexpr float EPS = 1e-6f;
constexpr float LOG2E = 1.4426950408889634f;
constexpr float QSCALE = 0.125f * LOG2E;
constexpr float HQSCALE = 0.08838834764831845f;

constexpr size_t MiB = 1u << 20;
constexpr size_t WS_CTL = 0;
constexpr size_t WS_MOD = 1 * MiB;
constexpr size_t WS_LB = WS_MOD + 256 * 1024;
constexpr size_t WS_WFF = WS_MOD + 512 * 1024;
constexpr size_t WS_WIN = 2 * MiB;
constexpr size_t WS_WOUT = 10 * MiB;
constexpr size_t WS_WQ = 12 * MiB;
constexpr size_t WS_KEYS = 16 * MiB;
constexpr size_t WS_US = 17 * MiB;
constexpr size_t WS_VS = WS_US + 256 * 1024;
constexpr size_t WS_UQ = 18 * MiB;
constexpr size_t WS_F = 50 * MiB;
constexpr size_t WS_F2T = 52 * MiB;
constexpr size_t WS_H = 56 * MiB;
constexpr size_t WS_PROJ = 120 * MiB;
constexpr size_t WS_KK = 344 * MiB;
constexpr size_t WS_OCAT = 376 * MiB;
constexpr size_t WS_HST = 440 * MiB;
constexpr size_t WS_HD = 504 * MiB;
constexpr size_t WS_Q2 = WS_PROJ;
constexpr size_t WS_IDX = WS_PROJ + 128 * MiB;
constexpr size_t WS_GATE = WS_PROJ + 144 * MiB;
constexpr size_t WS_END = 505 * MiB;

__device__ __forceinline__ float bf2f(bf16_t v) { return __uint_as_float(((unsigned)v) << 16); }
typedef float f32x2_t __attribute__((ext_vector_type(2))); typedef __bf16 bf16x2_t __attribute__((ext_vector_type(2)));
__device__ __forceinline__ unsigned pk2(float lo, float hi) { f32x2_t v = {lo, hi}; bf16x2_t b = __builtin_convertvector(v, bf16x2_t); return __builtin_bit_cast(unsigned, b); }
#ifndef FP8SIM
#define FP8SIM 0
#endif
__device__ __forceinline__ float f8r_(float v) { const int p = __builtin_amdgcn_cvt_pk_fp8_f32(v, v, 0, false); return __builtin_amdgcn_cvt_f32_fp8(p, 0); }
__device__ __forceinline__ unsigned pk4f8(float a, float b, float c, float d) { int p = __builtin_amdgcn_cvt_pk_fp8_f32(a, b, 0, false); p = __builtin_amdgcn_cvt_pk_fp8_f32(c, d, p, true); return (unsigned)p; }
#ifndef G1F8
#define G1F8 1
#endif
#define F8(bit, v) ((FP8SIM & (bit)) ? f8r_(v) : (v))
#define F8W(bit, v) ((FP8SIM & (bit)) ? f8r_((v) * 32.f) * 0.03125f : (v))
__device__ __forceinline__ bf16_t f2bf(float f) { return (bf16_t)(pk2(f, 0.f) & 0xffffu); }
__device__ __forceinline__ unsigned short f2h(float f) { _Float16 h = (_Float16)f; return __builtin_bit_cast(unsigned short, h); }
__device__ __forceinline__ float h2f(unsigned short u) { _Float16 h = __builtin_bit_cast(_Float16, u); return (float)h; }
#define WAVE_DPP(v, ctrl) __int_as_float(__builtin_amdgcn_update_dpp(0, __float_as_int(v), ctrl, 0xF, 0xF, false))
__device__ __forceinline__ float wave_sum(float v) {
    v += WAVE_DPP(v, 0xB1);
    v += WAVE_DPP(v, 0x4E);
    v += WAVE_DPP(v, 0x124);
    v += WAVE_DPP(v, 0x128);
    { const auto r = __builtin_amdgcn_permlane16_swap(__float_as_uint(v), __float_as_uint(v), false, false); v = __uint_as_float(r[0]) + __uint_as_float(r[1]); }
    { const auto r = __builtin_amdgcn_permlane32_swap(__float_as_uint(v), __float_as_uint(v), false, false); v = __uint_as_float(r[0]) + __uint_as_float(r[1]); }
    return v;
}
__device__ __forceinline__ float wave_max(float v) {
    v = fmaxf(v, WAVE_DPP(v, 0xB1));
    v = fmaxf(v, WAVE_DPP(v, 0x4E));
    v = fmaxf(v, WAVE_DPP(v, 0x124));
    v = fmaxf(v, WAVE_DPP(v, 0x128));
    { const auto r = __builtin_amdgcn_permlane16_swap(__float_as_uint(v), __float_as_uint(v), false, false); v = fmaxf(__uint_as_float(r[0]), __uint_as_float(r[1])); }
    { const auto r = __builtin_amdgcn_permlane32_swap(__float_as_uint(v), __float_as_uint(v), false, false); v = fmaxf(__uint_as_float(r[0]), __uint_as_float(r[1])); }
    return v;
}
__device__ __forceinline__ float sigmoidf_(float z) { return __builtin_amdgcn_rcpf(1.f + __expf(-z)); }
__device__ __forceinline__ float gelu_erf(float a) { return 0.5f * a * (1.f + erff(a * 0.7071067811865476f)); }

#define DUP_PHASE (-1)
#define DUP_MODE 0
#define TPROBE_FS 300.f
namespace pg8 {
__device__ __forceinline__ int ptid_() { int t = threadIdx.x; asm volatile("" : "+v"(t)); return t; }
#define PG8_LAS __attribute__((address_space(3)))
typedef unsigned short bf16_t;
typedef short bf16x8 __attribute__((ext_vector_type(8)));
typedef float f32x4 __attribute__((ext_vector_type(4)));
typedef unsigned u32x4 __attribute__((ext_vector_type(4)));
constexpr int BM = 256, BK = 64, HALF = 128, HTB = HALF * BK * 2  , STAGE_BYTES = 8 * HTB, NXCD = 8, WGM = 4;

__host__ __device__ __forceinline__ int lds_byte(int r, int c) { const int st = (r >> 4) * 2 + (c >> 5), rr = r & 15, cc = c & 31, ob = rr * 64 + cc * 2; return st * 1024 + (ob ^ (((ob >> 9) & 1) << 5)); }
__host__ __device__ __forceinline__ void stage_rc(int b, int& R, int& C) { const int st = b / 1024, sb = b % 1024, swz = sb ^ (((sb >> 9) & 1) << 5); R = (st >> 1) * 16 + swz / 64; C = (st & 1) * 32 + (swz % 64) / 2; }
__host__ __device__ __forceinline__ int perm32(int rho) { const int n = rho >> 4, i = rho & 15; return 8 * (i >> 2) + 4 * n + (i & 3); }

struct Unit { int pm, pn; };
struct Gemm { const bf16_t* A; const bf16_t* Bt; int M, N, K; };

struct StaticOrder {
    int nM, nN, nwg, G, c, wgm;
    __host__ __device__ void init(int M, int N, int G_, int c_, int wgm_ = WGM) { nM = M / BM; nN = N / BM; nwg = nM * nN; G = G_; c = c_; wgm = wgm_; }
    __host__ __device__ bool next(int i, Unit& u) const {
        const long L = (long)i * G + c; if (L >= nwg) return false;
        int wgid = (int)L; { const int q = nwg / NXCD, r = nwg % NXCD, xcd = wgid % NXCD, off = wgid / NXCD; wgid = (xcd < r ? xcd * (q + 1) : r * (q + 1) + (xcd - r) * q) + off; }
        const int nig = wgm * nN, gid = wgid / nig, fm = gid * wgm, gsz = (nM - fm) < wgm ? (nM - fm) : wgm;
        u.pm = fm + ((wgid % nig) % gsz); u.pn = (wgid % nig) / gsz; return true;
    }
    __device__ __forceinline__ void a_ready(const Unit&) const {}
    __device__ __forceinline__ void done(const Unit&) const {}
};

typedef int i32x4 __attribute__((ext_vector_type(4)));
typedef int i32x8 __attribute__((ext_vector_type(8)));
template <class Epi, class Sched, bool ALIGN_EPI = false, bool SP2 = false, bool F8 = false, int SCALE_W = 0, int SCALE_A = 0>
__device__ __forceinline__ void gemm_phase(PG8_LAS unsigned char* lds, const Gemm g, const Sched& S, const Epi& E) {
    const int tid = ptid_(), wid = __builtin_amdgcn_readfirstlane(tid >> 6), lane = tid & 63, wr = wid >> 2, wc = wid & 3, fr = lane & 15, fq = lane >> 4;
    const int K = g.K, nt = K / BK;
    unsigned voffA[2], voffB[2];
#pragma unroll
    for (int i = 0; i < 2; ++i) { int R, C; stage_rc(tid * 16 + i * 8192, R, C); const int Rb = Epi::PERM ? ((R & ~31) + perm32(R & 31)) : R;
        voffA[i] = (unsigned)(R * K + C) * 2u; voffB[i] = (unsigned)(Rb * K + C) * 2u; }
    const size_t kstep = (size_t)(BK * 2);
    const size_t hstep = (size_t)HALF * K * 2;
    const size_t tstep = 2 * hstep;
    const unsigned ldsw = (unsigned)wid * 1024u;
    const int aoff = lds_byte(wr * 64 + fr, fq * 8), boff = lds_byte(wc * 32 + fr, fq * 8);
#define PG8_SA(b, h) (((b) * 2 + (h)) * HTB)
#define PG8_SB(b, h) ((4 + (b) * 2 + (h)) * HTB)
#define PG8_STAGE(bufoff, gbase, voff) do { _Pragma("unroll") for (int _i = 0; _i < 2; ++_i) { unsigned _vo = (voff)[_i]; asm volatile("" : "+v"(_vo));     \
        __builtin_amdgcn_global_load_lds((const unsigned*)((const char*)(gbase) + _vo), (PG8_LAS unsigned*)(lds + (bufoff) + ldsw + _i * 8192), 16, 0, 0); } } while (0)
#define PG8_LD8(p) __builtin_shufflevector(*(const PG8_LAS i32x4*)(p), *(const PG8_LAS i32x4*)((p) + 1024), 0, 1, 2, 3, 4, 5, 6, 7)
#define PG8_LDA(dst, b, h) do { if constexpr (F8) { _Pragma("unroll") for (int m = 0; m < 4; ++m) dst##8[m] = PG8_LD8(lds + PG8_SA(b, h) + aoff + m * 2048); } \
        else { _Pragma("unroll") for (int m = 0; m < 4; ++m) _Pragma("unroll") for (int k = 0; k < 2; ++k) dst[m][k] = *(const PG8_LAS bf16x8*)(lds + PG8_SA(b, h) + aoff + m * 2048 + k * 1024); } } while (0)
#define PG8_LDB(dst, b, h) do { if constexpr (F8) { _Pragma("unroll") for (int n = 0; n < 2; ++n) dst##8[n] = PG8_LD8(lds + PG8_SB(b, h) + boff + n * 2048); } \
        else { _Pragma("unroll") for (int n = 0; n < 2; ++n) _Pragma("unroll") for (int k = 0; k < 2; ++k) dst[n][k] = *(const PG8_LAS bf16x8*)(lds + PG8_SB(b, h) + boff + n * 2048 + k * 1024); } } while (0)
#define PG8_MMA(ai, bj, At, Bt) do { __builtin_amdgcn_s_setprio(1); \
        if constexpr (F8) { _Pragma("unroll") for (int m = 0; m < 4; ++m) _Pragma("unroll") for (int n = 0; n < 2; ++n) \
            acc[ai][bj][m][n] = __builtin_amdgcn_mfma_scale_f32_16x16x128_f8f6f4(Bt##8[n], At##8[m], acc[ai][bj][m][n], 0, 0, 0, SCALE_W, 0, SCALE_A); } \
        else { _Pragma("unroll") for (int m = 0; m < 4; ++m) _Pragma("unroll") for (int n = 0; n < 2; ++n) _Pragma("unroll") for (int k = 0; k < 2; ++k) \
            acc[ai][bj][m][n] = __builtin_amdgcn_mfma_f32_16x16x32_bf16(Bt[n][k], At[m][k], acc[ai][bj][m][n], 0, 0, 0); } \
        __builtin_amdgcn_s_setprio(0); } while (0)
#define PG8_WAIT_V(n) asm volatile("s_waitcnt vmcnt(" #n ")" ::: "memory")
#define PG8_WAIT_L(n) asm volatile("s_waitcnt lgkmcnt(" #n ")" ::: "memory")
#define PG8_BAR __builtin_amdgcn_s_barrier()
#define PG8_SCHED __builtin_amdgcn_sched_barrier(0)
    Unit cur, nxt; int ui = 0;
    if (!S.next(0, cur)) return;
    f32x4 acc[2][2][4][2];
#pragma unroll
    for (int a = 0; a < 2; ++a)
#pragma unroll
        for (int b = 0; b < 2; ++b)
#pragma unroll
            for (int m = 0; m < 4; ++m)
#pragma unroll
                for (int n = 0; n < 2; ++n) acc[a][b][m][n] = (f32x4){0.f, 0.f, 0.f, 0.f};
    bf16x8 At[4][2], B0[2][2], B1[2][2]; i32x8 At8[4], B08[2], B18[2];
    const char* cA = (const char*)g.A + (size_t)cur.pm * tstep; const char* cB = (const char*)g.Bt + (size_t)cur.pn * tstep;
    S.a_ready(cur);
    if constexpr (SP2) {
        PG8_STAGE(PG8_SB(0, 0), cB, voffB); PG8_STAGE(PG8_SB(0, 1), cB + hstep, voffB); PG8_STAGE(PG8_SA(0, 0), cA, voffA); PG8_STAGE(PG8_SA(0, 1), cA + hstep, voffA);
        if (wr == 1) PG8_BAR;
        PG8_WAIT_V(2); PG8_BAR;
        PG8_STAGE(PG8_SB(1, 0), cB + kstep, voffB); PG8_STAGE(PG8_SA(1, 0), cA + kstep, voffA); PG8_STAGE(PG8_SB(1, 1), cB + hstep + kstep, voffB);
        PG8_WAIT_V(6); PG8_BAR;
    } else {
        PG8_STAGE(PG8_SB(0, 0), cB, voffB); PG8_STAGE(PG8_SA(0, 0), cA, voffA); PG8_STAGE(PG8_SB(0, 1), cB + hstep, voffB); PG8_STAGE(PG8_SA(0, 1), cA + hstep, voffA);
        if (wr == 1) PG8_BAR;
        PG8_WAIT_V(4); PG8_BAR;
        PG8_STAGE(PG8_SB(1, 0), cB + kstep, voffB); PG8_STAGE(PG8_SA(1, 0), cA + kstep, voffA); PG8_STAGE(PG8_SB(1, 1), cB + hstep + kstep, voffB);
        PG8_WAIT_V(6); PG8_BAR;
    }
    for (;;) {
        const bool has_next = S.next(ui + 1, nxt);
        const char* nA = has_next ? (const char*)g.A + (size_t)nxt.pm * tstep : cA; const char* nB = has_next ? (const char*)g.Bt + (size_t)nxt.pn * tstep : cB;
#pragma unroll 1
        for (int t = 0; t < nt; t += 2) {
            const bool last = (t == nt - 2);
            const char* a1 = cA + (size_t)(t + 1) * kstep;
            const char* a2 = last ? nA : cA + (size_t)(t + 2) * kstep; const char* b2 = last ? nB : cB + (size_t)(t + 2) * kstep;
            const char* a3 = a2 + kstep; const char* b3 = b2 + kstep;
            if (last && has_next) S.a_ready(nxt);
            if constexpr (SP2) {
            PG8_LDB(B0, 0, 0); PG8_LDB(B1, 0, 1); PG8_SCHED; PG8_LDA(At, 0, 0); PG8_STAGE(PG8_SA(1, 1), a1 + hstep, voffA);
            PG8_WAIT_V(8); PG8_WAIT_L(0); PG8_BAR; PG8_MMA(0, 0, At, B0); PG8_MMA(0, 1, At, B1); PG8_BAR; PG8_SCHED;
            PG8_LDA(At, 0, 1); PG8_STAGE(PG8_SB(0, 0), b2, voffB); PG8_STAGE(PG8_SB(0, 1), b2 + hstep, voffB); PG8_STAGE(PG8_SA(0, 0), a2, voffA);
            PG8_WAIT_V(8); PG8_WAIT_L(0); PG8_BAR; PG8_MMA(1, 0, At, B0); PG8_MMA(1, 1, At, B1); PG8_BAR; PG8_SCHED;
            PG8_LDB(B0, 1, 0); PG8_LDB(B1, 1, 1); PG8_SCHED; PG8_LDA(At, 1, 0); PG8_STAGE(PG8_SA(0, 1), a2 + hstep, voffA);
            PG8_WAIT_V(8); PG8_WAIT_L(0); PG8_BAR; PG8_MMA(0, 0, At, B0); PG8_MMA(0, 1, At, B1); PG8_BAR; PG8_SCHED;
            PG8_LDA(At, 1, 1); PG8_STAGE(PG8_SB(1, 0), b3, voffB); PG8_STAGE(PG8_SB(1, 1), b3 + hstep, voffB); PG8_STAGE(PG8_SA(1, 0), a3, voffA);
            PG8_WAIT_V(8); PG8_WAIT_L(0); PG8_BAR; PG8_MMA(1, 0, At, B0); PG8_MMA(1, 1, At, B1); PG8_BAR; PG8_SCHED;
            } else {
            PG8_LDB(B0, 0, 0); PG8_SCHED; PG8_LDA(At, 0, 0); PG8_STAGE(PG8_SA(1, 1), a1 + hstep, voffA);
            PG8_WAIT_L(8); PG8_BAR; PG8_WAIT_L(0); PG8_MMA(0, 0, At, B0); PG8_BAR; PG8_SCHED;
            PG8_LDB(B1, 0, 1); PG8_STAGE(PG8_SB(0, 0), b2, voffB);
            PG8_BAR; PG8_WAIT_L(0); PG8_MMA(0, 1, At, B1); PG8_BAR;
            PG8_LDA(At, 0, 1); PG8_STAGE(PG8_SA(0, 0), a2, voffA);
            PG8_BAR; PG8_WAIT_L(0); PG8_MMA(1, 0, At, B0); PG8_BAR; PG8_SCHED;
            PG8_STAGE(PG8_SB(0, 1), b2 + hstep, voffB);
            PG8_WAIT_V(6); PG8_BAR; PG8_MMA(1, 1, At, B1); PG8_BAR;
            PG8_LDB(B0, 1, 0); PG8_SCHED; PG8_LDA(At, 1, 0); PG8_STAGE(PG8_SA(0, 1), a2 + hstep, voffA);
            PG8_WAIT_L(8); PG8_BAR; PG8_WAIT_L(0); PG8_MMA(0, 0, At, B0); PG8_BAR; PG8_SCHED;
            PG8_LDB(B1, 1, 1); PG8_STAGE(PG8_SB(1, 0), b3, voffB);
            PG8_BAR; PG8_WAIT_L(0); PG8_MMA(0, 1, At, B1); PG8_BAR;
            PG8_LDA(At, 1, 1); PG8_STAGE(PG8_SA(1, 0), a3, voffA);
            PG8_BAR; PG8_WAIT_L(0); PG8_MMA(1, 0, At, B0); PG8_BAR; PG8_SCHED;
            PG8_STAGE(PG8_SB(1, 1), b3 + hstep, voffB);
            PG8_WAIT_V(6); PG8_BAR; PG8_MMA(1, 1, At, B1); PG8_BAR;
            }
        }
        if constexpr (ALIGN_EPI) { if (wr == 0) PG8_BAR; }
        if constexpr (!Epi::AFTER_DRAIN) { const int t2 = ptid_(), w2 = __builtin_amdgcn_readfirstlane(t2 >> 6);
            E(acc, cur, w2 >> 2, w2 & 3, t2 & 15, (t2 & 63) >> 4); S.done(cur); }
        if (!has_next) break;
#pragma unroll
        for (int a = 0; a < 2; ++a)
#pragma unroll
            for (int b = 0; b < 2; ++b)
#pragma unroll
                for (int m = 0; m < 4; ++m)
#pragma unroll
                    for (int n = 0; n < 2; ++n) acc[a][b][m][n] = (f32x4){0.f, 0.f, 0.f, 0.f};
        cur = nxt; cA = nA; cB = nB; ++ui;
        if constexpr (ALIGN_EPI) { if (wr == 1) PG8_BAR; }
    }
    PG8_WAIT_V(0);
    if constexpr (!ALIGN_EPI) { if (wr == 0) PG8_BAR; }
    PG8_BAR;
    if constexpr (Epi::AFTER_DRAIN) { E.fused(acc, cur, wr, wc, fr, fq, lds, wid, lane); S.done(cur); }
#undef PG8_SA
#undef PG8_SB
#undef PG8_STAGE
#undef PG8_LDA
#undef PG8_LDB
#undef PG8_MMA
#undef PG8_WAIT_V
#undef PG8_WAIT_L
#undef PG8_BAR
#undef PG8_SCHED
}
}

#define LAS __attribute__((address_space(3)))
#ifndef WGM_G1
#define WGM_G1 4
#define WGM_G2 4
#define WGM_G3 4
#endif
#ifndef TPROBE
#define TPROBE (-1)
#endif
__device__ __forceinline__ int ptid() { int t = threadIdx.x; asm volatile("" : "+v"(t)); return t; }
constexpr int NWAVES = 8, NTHREADS = 512;
constexpr int RING_BYTES = 131072;
constexpr int MISC_OFF = RING_BYTES + 320;
constexpr int LDS_BYTES = 147456;
constexpr int CW_BAR = 4096;
constexpr size_t CTL_ZERO_BYTES = 40 * 1024;
constexpr int CW_ATTNQ = 7680;

#define XB_TMO      128
#define XB_XCNT(j)  (256  + 64 * (j))
#define XB_XSUB(j)  (1280 + 64 * (j))
#define XB_XGEN(j)  (2304 + 64 * (j))
#define XB_TOP      3328
#define XB_TOPGEN   3392
#define XCD_BAR_WORDS 3456
#define XB_SPIN_CAP (1u << 20)
__device__ __forceinline__ unsigned xb_ld(unsigned* p)              { return __hip_atomic_load(p, __ATOMIC_RELAXED, __HIP_MEMORY_SCOPE_AGENT); }
__device__ __forceinline__ unsigned xb_add(unsigned* p, unsigned v) { return __hip_atomic_fetch_add(p, v, __ATOMIC_RELAXED, __HIP_MEMORY_SCOPE_AGENT); }
__device__ __forceinline__ unsigned xb_xcc_id() { return (unsigned)__builtin_amdgcn_s_getreg((3 << 11) | 20) & 0xFu; }
#define XB_SPIN(cond, bar) do { unsigned _sp = 0; while (cond) { __builtin_amdgcn_s_sleep(1); \
    if ((++_sp & 255u) == 0u) { if (xb_ld(&(bar)[XB_TMO])) break; if (_sp > XB_SPIN_CAP) { atomicAdd(&(bar)[XB_TMO], 1u); break; } } } } while (0)
struct XcdBarrier { unsigned* bar; unsigned x; volatile LAS unsigned* st; };
__device__ __forceinline__ XcdBarrier xcd_barrier_post(unsigned* bar, volatile LAS unsigned* st) {
    XcdBarrier b; b.bar = bar; b.x = xb_xcc_id(); b.st = st;
    if (threadIdx.x == 0) (void)xb_add(&bar[XB_XCNT(b.x)], 1u);
    return b;
}
__device__ __forceinline__ void xcd_barrier_complete(unsigned* bar, unsigned x, unsigned& nloc, unsigned& nx) {
    const unsigned G = gridDim.x * gridDim.y * gridDim.z;
    unsigned sum, cnt, mine, sp = 0u;
    for (;;) {
        sum = 0u; cnt = 0u; mine = 0u;
#pragma unroll
        for (unsigned j = 0; j < 16; ++j) { const unsigned c = xb_ld(&bar[XB_XCNT(j)]); sum += c; cnt += (c > 0u) ? 1u : 0u; mine = (j == x) ? c : mine; }
        if (sum == G) break;
        __builtin_amdgcn_s_sleep(1);
        if ((++sp & 255u) == 0u) { if (xb_ld(&bar[XB_TMO])) break; if (sp > XB_SPIN_CAP) { atomicAdd(&bar[XB_TMO], 1u); break; } }
    }
    nloc = mine > 0u ? mine : 1u; nx = cnt > 0u ? cnt : 1u;
}
__device__ __forceinline__ void xcd_barrier(const XcdBarrier& b) {
    asm volatile("s_waitcnt vmcnt(0)" ::: "memory");
    __syncthreads();
    if (threadIdx.x == 0) {
        unsigned* bar = b.bar;
        __builtin_amdgcn_s_waitcnt(0);
        unsigned nloc = b.st[0], nx = b.st[1];
        if (nloc == 0u) { xcd_barrier_complete(bar, b.x, nloc, nx); b.st[0] = nloc; b.st[1] = nx; }
        const unsigned old = xb_add(&bar[XB_XSUB(b.x)], 1u);
        const unsigned gen = old / nloc;
        if (old + 1u == (gen + 1u) * nloc) {
            __builtin_amdgcn_fence(__ATOMIC_RELEASE, "agent");
            asm volatile("s_waitcnt vmcnt(0)" ::: "memory");
            const unsigned og = xb_add(&bar[XB_TOP], 1u);
            const unsigned tg = og / nx;
            if (og + 1u == (tg + 1u) * nx) xb_add(&bar[XB_TOPGEN], 1u);
            else XB_SPIN(xb_ld(&bar[XB_TOPGEN]) == tg, bar);
            __builtin_amdgcn_fence(__ATOMIC_ACQUIRE, "agent");
            xb_add(&bar[XB_XGEN(b.x)], 1u);
            asm volatile("s_waitcnt vmcnt(0)" ::: "memory");
        } else {
            XB_SPIN(xb_ld(&bar[XB_XGEN(b.x)]) == gen, bar);
            __builtin_amdgcn_fence(__ATOMIC_ACQUIRE, "agent");
            asm volatile("s_waitcnt vmcnt(0)" ::: "memory");
        }
    }
    __syncthreads();
}

struct Args { const float* in[17]; float* out; unsigned char* ws; int ph_lo, ph_hi, li, flags; };
enum { FL_ATTN = 1, FL_HGRN = 2 };

__device__ __forceinline__ unsigned cvt_pk_bf16(float lo, float hi) { f32x2_t v = {lo, hi}; bf16x2_t b = __builtin_convertvector(v, bf16x2_t); return __builtin_bit_cast(unsigned, b); }
struct EpiPlainT {
    static constexpr bool PERM = true, AFTER_DRAIN = false;
    bf16_t* O; int ld;
    __device__ __forceinline__ void operator()(const pg8::f32x4 (&acc)[2][2][4][2], const pg8::Unit& u, int wr, int wc, int fr, int fq) const {
        const int row0 = u.pm * 256 + wr * 64 + fr, col0 = u.pn * 256 + wc * 32 + 8 * fq;
#pragma unroll
        for (int ai = 0; ai < 2; ++ai)
#pragma unroll
            for (int m = 0; m < 4; ++m) { bf16_t* rowp = O + (size_t)(row0 + ai * 128 + m * 16) * ld + col0;
#pragma unroll
                for (int bj = 0; bj < 2; ++bj) { const pg8::f32x4 v0 = acc[ai][bj][m][0], v1 = acc[ai][bj][m][1];
                    u32x4 w; w.x = cvt_pk_bf16(v0[0], v0[1]); w.y = cvt_pk_bf16(v0[2], v0[3]); w.z = cvt_pk_bf16(v1[0], v1[1]); w.w = cvt_pk_bf16(v1[2], v1[3]);
                    *(u32x4*)(rowp + bj * 128) = w; } }
    }
};
struct EpiProjT {
    static constexpr bool PERM = true, AFTER_DRAIN = false;
    static constexpr float ASC = G1F8 ? 0.03125f : 1.f;
    bf16_t* proj; bf16_t* kk; const float* lb; unsigned* kmaxh;
    __device__ __forceinline__ void operator()(const pg8::f32x4 (&acc)[2][2][4][2], const pg8::Unit& u, int wr, int wc, int fr, int fq) const {
        const int row0 = u.pm * 256 + wr * 64 + fr, col0 = u.pn * 256 + wc * 32 + 8 * fq, seg = (u.pn * 256) >> 9;
        float kmx[2] = {0.f, 0.f};
        float lbv[2][8];
        if (seg == 4) {
#pragma unroll
            for (int bj = 0; bj < 2; ++bj)
#pragma unroll
                for (int i = 0; i < 8; ++i) lbv[bj][i] = lb[col0 - C_LF + bj * 128 + i];
        }
        const float sc = (seg == 0) ? QSCALE : (seg == 3) ? HQSCALE : 1.f;
#pragma unroll
        for (int ai = 0; ai < 2; ++ai)
#pragma unroll
            for (int m = 0; m < 4; ++m) { const size_t row = (size_t)(row0 + ai * 128 + m * 16);
#pragma unroll
                for (int bj = 0; bj < 2; ++bj) {
                    float v[8];
#pragma unroll
                    for (int i = 0; i < 4; ++i) { v[i] = acc[ai][bj][m][0][i] * ASC; v[4 + i] = acc[ai][bj][m][1][i] * ASC; }
                    u32x4 w;
                    if (seg == 4) {
                        float k1[8]; unsigned short hh[8];
#pragma unroll
                        for (int i = 0; i < 8; ++i) { const float l = lbv[bj][i], f = l + (1.f - l) * sigmoidf_(v[i]); k1[i] = 1.f - f; hh[i] = f2h(__builtin_amdgcn_logf(f) * 0.69314718056f); }
                        w.x = hh[0] | ((unsigned)hh[1] << 16); w.y = hh[2] | ((unsigned)hh[3] << 16); w.z = hh[4] | ((unsigned)hh[5] << 16); w.w = hh[6] | ((unsigned)hh[7] << 16);
                        (void)k1;
                    } else {
                        if (seg == 6) {
#pragma unroll
                            for (int i = 0; i < 8; ++i) v[i] = v[i] * sigmoidf_(v[i]);
                        } else {
#pragma unroll
                            for (int i = 0; i < 8; ++i) v[i] *= sc;
                        }
                        w.x = cvt_pk_bf16(v[0], v[1]); w.y = cvt_pk_bf16(v[2], v[3]); w.z = cvt_pk_bf16(v[4], v[5]); w.w = cvt_pk_bf16(v[6], v[7]);
                        if (seg == 1) {
                            float s = 0.f;
#pragma unroll
                            for (int i = 0; i < 4; ++i) { const float a = __uint_as_float(w[i] << 16), b = __uint_as_float(w[i] & 0xffff0000u); s += a * a + b * b; }
                            s += __shfl_xor(s, 16); s += __shfl_xor(s, 32);
                            kmx[bj] = fmaxf(kmx[bj], s);
                        }
                    }
                    *(u32x4*)(proj + row * NPROJ + col0 + bj * 128) = w;
                } }
        if (seg == 1) {
#pragma unroll
            for (int bj = 0; bj < 2; ++bj) { float m = kmx[bj]; m = fmaxf(m, __shfl_xor(m, 1)); m = fmaxf(m, __shfl_xor(m, 2)); m = fmaxf(m, __shfl_xor(m, 4)); m = fmaxf(m, __shfl_xor(m, 8));
                const int head = (u.pn - 2) * 4 + bj * 2 + (wc >> 1), b = (u.pm * 256) / SEQ;
                if (fr == 0 && fq == 0) atomicMax(kmaxh + ((b * 8 + head) * 2 + (wc & 1)), __float_as_uint(m)); }
        }
    }
};

template <int SB, bool F8OUT = false> __device__ __forceinline__ void transpose_item(const float* __restrict__ W, int ldw, int c0, bf16_t* WT, int r0, LAS float* scr, int item, int nblk, int lane) {
    const int k0 = 64 * (item / nblk), n0 = 32 * (item % nblk);
#pragma unroll 8
    for (int i = 0; i < 32; ++i) { const int kk = 2 * i + (lane >> 5); scr[kk * 33 + (lane & 31)] = W[(size_t)(k0 + kk) * ldw + c0 + n0 + (lane & 31)]; }
    asm volatile("s_waitcnt lgkmcnt(0)" ::: "memory");
    const int c = lane & 7;
#pragma unroll
    for (int j = 0; j < 4; ++j) { const int n = (lane >> 3) + 8 * j; const LAS float* s = scr + (8 * c) * 33 + n;
        if constexpr (F8OUT) { u32x2 o8; o8.x = pk4f8(s[0 * 33] * 32.f, s[1 * 33] * 32.f, s[2 * 33] * 32.f, s[3 * 33] * 32.f); o8.y = pk4f8(s[4 * 33] * 32.f, s[5 * 33] * 32.f, s[6 * 33] * 32.f, s[7 * 33] * 32.f);
            *(u32x2*)((unsigned char*)WT + (size_t)(r0 + n0 + n) * 1024 + k0 + 8 * c) = o8; continue; }
        u32x4 o; o.x = pk2(F8W(SB, s[0 * 33]), F8W(SB, s[1 * 33])); o.y = pk2(F8W(SB, s[2 * 33]), F8W(SB, s[3 * 33])); o.z = pk2(F8W(SB, s[4 * 33]), F8W(SB, s[5 * 33])); o.w = pk2(F8W(SB, s[6 * 33]), F8W(SB, s[7 * 33]));
        *(u32x4*)(WT + (size_t)(r0 + n0 + n) * 1024 + k0 + 8 * c) = o; }
    asm volatile("s_waitcnt lgkmcnt(0)" ::: "memory");
}
__device__ __forceinline__ void qrow_load(f32x4 (&v)[4], const float* __restrict__ src, int row, int lane) {
#pragma unroll
    for (int j = 0; j < 4; ++j) v[j] = *(const f32x4*)(src + (size_t)row * 1024 + 256 * j + 4 * lane);
}
__device__ __forceinline__ void qrow_store(const f32x4 (&v)[4], unsigned char* q, float* scale, int row, int lane) {
    float ss = 0.f;
#pragma unroll
    for (int j = 0; j < 4; ++j) ss += v[j].x * v[j].x + v[j].y * v[j].y + v[j].z * v[j].z + v[j].w * v[j].w;
    ss = wave_sum(ss);
    const float sc = ss > 0.f ? 0.3352f * sqrtf(ss * (1.f / 1024.f)) : 1.f, inv = __builtin_amdgcn_rcpf(sc);
    unsigned n[16];
#pragma unroll
    for (int j = 0; j < 4; ++j) {
#pragma unroll
        for (int i = 0; i < 4; ++i) { const float f = floorf(v[j][i] * inv) + 8.f; n[4 * j + i] = (unsigned)fminf(fmaxf(f, 0.f), 15.f); } }
    u32x2 o;
#pragma unroll
    for (int m = 0; m < 2; ++m) { unsigned w = 0;
#pragma unroll
        for (int b = 0; b < 4; ++b) w |= (n[8 * m + b] | (n[8 * m + 4 + b] << 4)) << (8 * b);
        o[m] = w; }
    *(u32x2*)(q + (size_t)row * 1024 + lane * 16) = o;
    if (lane == 0) scale[row] = sc;
}
__device__ __forceinline__ void h_rows(const float* __restrict__ x, const float* __restrict__ g, const float* __restrict__ mod, const float* __restrict__ wff, const float* __restrict__ bf, bf16_t* H, float* logf, int t0, int t1, int lane) {
    if (t0 >= t1) return;
    const int b = t0 / SEQ;
    const float* shift = mod + b * 6144, * scale = shift + 1024;
    f32x4 gm[4], sh[4];
#pragma unroll
    for (int j = 0; j < 4; ++j) { const int c0 = 256 * j + 4 * lane; gm[j] = *(const f32x4*)(g + c0) * (*(const f32x4*)(scale + c0) + 1.f); sh[j] = *(const f32x4*)(shift + c0); }
    const float bfl = (lane < 8) ? bf[lane] : 0.f;
    f32x4 nx[4];
#pragma unroll
    for (int j = 0; j < 4; ++j) nx[j] = *(const f32x4*)(x + (size_t)t0 * 1024 + 256 * j + 4 * lane);
    for (int t = t0; t < t1; ++t) {
        f32x4 v[4]; float s = 0.f;
#pragma unroll
        for (int j = 0; j < 4; ++j) { v[j] = nx[j]; s += v[j].x * v[j].x + v[j].y * v[j].y + v[j].z * v[j].z + v[j].w * v[j].w; }
        if (t + 1 < t1) {
#pragma unroll
            for (int j = 0; j < 4; ++j) nx[j] = *(const f32x4*)(x + (size_t)(t + 1) * 1024 + 256 * j + 4 * lane);
        }
        const float rstd = rsqrtf(wave_sum(s) * (1.f / 1024.f) + EPS);
        float ff[8];
#pragma unroll
        for (int i = 0; i < 8; ++i) ff[i] = 0.f;
#pragma unroll
        for (int j = 0; j < 4; ++j) {
            const int c0 = 256 * j + 4 * lane;
            const f32x4 h = v[j] * rstd * gm[j] + sh[j];
            if (G1F8) *(unsigned*)((unsigned char*)H + (size_t)t * 1024 + c0) = pk4f8(h.x, h.y, h.z, h.w);
            else { u32x2 o; o.x = pk2(F8(1, h.x), F8(1, h.y)); o.y = pk2(F8(1, h.z), F8(1, h.w)); *(u32x2*)(H + (size_t)t * 1024 + c0) = o; }
#pragma unroll
            for (int i = 0; i < 8; ++i) { const f32x4 w = *(const f32x4*)(wff + i * 1024 + c0); ff[i] += h.x * w.x + h.y * w.y + h.z * w.z + h.w * w.w; }
        }
#pragma unroll
        for (int i = 0; i < 8; ++i) ff[i] = wave_sum(ff[i]);
        if (lane < 8) {
            float z = 0.f;
#pragma unroll
            for (int i = 0; i < 8; ++i) z = (lane == i) ? ff[i] : z;
            z += bfl;
            logf[(size_t)t * 8 + lane] = fminf(z, 0.f) - log1pf(__expf(-fabsf(z)));
        }
    }
}

__device__ __forceinline__ void row_passes(const float* __restrict__ x, const bf16_t* __restrict__ mix, const float* __restrict__ mod, const float* __restrict__ g_post, const float* __restrict__ g_pre, bf16_t* XB, bf16_t* H2, int t0, int t1, int lane) {
    if (t0 >= t1) return;
    const int b = t0 / SEQ; const float* md = mod + b * 6144;
    f32x4 ga[4], gp[4], shf[4];
#pragma unroll
    for (int j = 0; j < 4; ++j) { const int c0 = 256 * j + 4 * lane; ga[j] = *(const f32x4*)(md + 2048 + c0) * *(const f32x4*)(g_post + c0);
        gp[j] = *(const f32x4*)(g_pre + c0) * (*(const f32x4*)(md + 4096 + c0) + 1.f); shf[j] = *(const f32x4*)(md + 3072 + c0); }
    f32x4 nx[4]; u32x2 nm[4];
#pragma unroll
    for (int j = 0; j < 4; ++j) { const int c0 = 256 * j + 4 * lane; nx[j] = *(const f32x4*)(x + (size_t)t0 * 1024 + c0); nm[j] = *(const u32x2*)(mix + (size_t)t0 * 1024 + c0); }
    for (int t = t0; t < t1; ++t) {
        f32x4 m[4], xv[4]; float s = 0.f;
#pragma unroll
        for (int j = 0; j < 4; ++j) { const u32x2 w = nm[j]; xv[j] = nx[j];
            m[j] = (f32x4){__uint_as_float(w.x << 16), __uint_as_float(w.x & 0xffff0000u), __uint_as_float(w.y << 16), __uint_as_float(w.y & 0xffff0000u)};
            s += m[j].x * m[j].x + m[j].y * m[j].y + m[j].z * m[j].z + m[j].w * m[j].w; }
        if (t + 1 < t1) {
#pragma unroll
            for (int j = 0; j < 4; ++j) { const int c0 = 256 * j + 4 * lane; nx[j] = *(const f32x4*)(x + (size_t)(t + 1) * 1024 + c0); nm[j] = *(const u32x2*)(mix + (size_t)(t + 1) * 1024 + c0); }
        }
        const float r1 = rsqrtf(wave_sum(s) * (1.f / 1024.f) + EPS);
        float s2 = 0.f;
#pragma unroll
        for (int j = 0; j < 4; ++j) { const int c0 = 256 * j + 4 * lane;
            xv[j] = xv[j] + ga[j] * (m[j] * r1);
            { u32x2 xo; xo.x = pk2(xv[j].x, xv[j].y); xo.y = pk2(xv[j].z, xv[j].w); *(u32x2*)(XB + (size_t)t * 1024 + c0) = xo; }
            s2 += xv[j].x * xv[j].x + xv[j].y * xv[j].y + xv[j].z * xv[j].z + xv[j].w * xv[j].w; }
        const float r2 = rsqrtf(wave_sum(s2) * (1.f / 1024.f) + EPS);
#pragma unroll
        for (int j = 0; j < 4; ++j) { const int c0 = 256 * j + 4 * lane;
            const f32x4 h = xv[j] * r2 * gp[j] + shf[j];
            u32x2 o; o.x = pk2(F8(4, h.x), F8(4, h.y)); o.y = pk2(F8(4, h.z), F8(4, h.w));
            *(u32x2*)(H2 + (size_t)t * 1024 + c0) = o; }
    }
}

__device__ __forceinline__ float gelu_as(float v) {
    const float av = fabsf(v), t = __builtin_amdgcn_rcpf(av * 0.2316418882f + 1.0f);
    float q = t * 0.5307027145f + (-0.7265760135f); q = q * t + 0.7107068705f; q = q * t + (-0.142248368f); q = q * t + 0.127414796f; q = q * t;
    const float m = v * (q * __builtin_amdgcn_exp2f((v * v) * (-0.72134752044f)));
    return v < 0.f ? m : v - m;
}
constexpr int EB = 16;
__device__ __forceinline__ void expert_token(const unsigned char* __restrict__ UV, const float* __restrict__ US, const float* __restrict__ VS,
                                             const int* __restrict__ IDX, const float* __restrict__ GATE, const LAS float* pv  ,
                                             const bf16_t* __restrict__ xin, float* out, int t, int lane, int rmask, float pscale) {
    float s2 = 0.f;
    float hv[16]; float mx = 0.f;
    {
    f32x4 x1[4];
#pragma unroll
    for (int j = 0; j < 4; ++j) { const u32x2 xw = *(const u32x2*)(xin + (size_t)t * 1024 + 256 * j + 4 * lane);
        x1[j] = (f32x4){__uint_as_float(xw.x << 16), __uint_as_float(xw.x & 0xffff0000u), __uint_as_float(xw.y << 16), __uint_as_float(xw.y & 0xffff0000u)}; s2 += x1[j].x * x1[j].x + x1[j].y * x1[j].y + x1[j].z * x1[j].z + x1[j].w * x1[j].w; }
    const float r2 = rsqrtf(wave_sum(s2) * (1.f / 1024.f) + EPS);
#pragma unroll
    for (int j = 0; j < 4; ++j) { const f32x4 h = x1[j] * r2 * *(const LAS f32x4*)(pv + 256 * j + 4 * lane) + *(const LAS f32x4*)(pv + 1024 + 256 * j + 4 * lane);
        hv[4 * j] = h.x; hv[4 * j + 1] = h.y; hv[4 * j + 2] = h.z; hv[4 * j + 3] = h.w;
        mx = fmaxf(mx, fmaxf(fmaxf(fabsf(h.x), fabsf(h.y)), fmaxf(fabsf(h.z), fabsf(h.w)))); }
    }
    const int i0 = IDX[(size_t)t * 128 + lane] & rmask, i1 = IDX[(size_t)t * 128 + 64 + lane] & rmask;
    const float g0 = GATE[(size_t)t * 128 + lane], g1 = GATE[(size_t)t * 128 + 64 + lane];
    const float su0 = US[i0], su1 = US[i1], sv0 = VS[i0], sv1 = VS[i1];
    mx = wave_max(mx);
    const float sx = mx > 0.f ? mx / 127.f : 1.f, isx = 1.f / sx;
    int xq[4]; int xs = 0;
#pragma unroll
    for (int j = 0; j < 4; ++j) { const int q0 = (int)rintf(hv[4 * j] * isx), q1 = (int)rintf(hv[4 * j + 1] * isx), q2 = (int)rintf(hv[4 * j + 2] * isx), q3 = (int)rintf(hv[4 * j + 3] * isx);
        xs += q0 + q1 + q2 + q3;
        xq[j] = (int)((unsigned)(q0 & 255) | ((unsigned)(q1 & 255) << 8) | ((unsigned)(q2 & 255) << 16) | ((unsigned)(q3 & 255) << 24)); }
#pragma unroll
    for (int o = 1; o < 64; o <<= 1) xs += __shfl_xor(xs, o);
    const float xoff = 7.5f * (float)xs;
    const int el = ((lane >> 5) & 1) * 8 + ((lane >> 4) & 1) * 4 + ((lane >> 1) & 1) * 2 + (lane & 1);
    float acc[16];
#pragma unroll
    for (int i = 0; i < 16; ++i) acc[i] = 0.f;
    float sumc = 0.f;
    const unsigned lo16 = (unsigned)lane * 16u;
    u32x4 rb[EB];
#pragma unroll
    for (int e = 0; e < EB; ++e) { const unsigned row = (unsigned)__builtin_amdgcn_readlane(i0, e); rb[e] = *(const u32x4*)(UV + (row * 1024u + lo16)); }
#pragma unroll 1
    for (int bi = 0; bi < 128 / EB; ++bi) {
        u32x4 rn[EB];
        {
            const int nb = (bi + 1) & 7, srcn = (nb < 4) ? i0 : i1, ln = (nb & 3) * EB;
#pragma unroll
            for (int e = 0; e < EB; ++e) { const unsigned row = (unsigned)__builtin_amdgcn_readlane(srcn, ln + e); rn[e] = *(const u32x4*)(UV + (row * 1024u + lo16)); }
        }
        int d[EB];
#pragma unroll
        for (int e = 0; e < EB; ++e) { const unsigned w0 = rb[e].x, w1 = rb[e].y;
            int s = __builtin_amdgcn_sdot4(xq[0], (int)(w0 & 0x0F0F0F0Fu), 0, false); s = __builtin_amdgcn_sdot4(xq[1], (int)((w0 >> 4) & 0x0F0F0F0Fu), s, false);
            s = __builtin_amdgcn_sdot4(xq[2], (int)(w1 & 0x0F0F0F0Fu), s, false); d[e] = __builtin_amdgcn_sdot4(xq[3], (int)((w1 >> 4) & 0x0F0F0F0Fu), s, false); }
        int d8[8], d4[4], d2[2], d1;
#pragma unroll
        for (int k = 0; k < 8; ++k) { const auto r = __builtin_amdgcn_permlane32_swap((unsigned)d[k], (unsigned)d[8 + k], false, false); d8[k] = (int)(r[0] + r[1]); }
#pragma unroll
        for (int k = 0; k < 4; ++k) { const auto r = __builtin_amdgcn_permlane16_swap((unsigned)d8[k], (unsigned)d8[4 + k], false, false); d4[k] = (int)(r[0] + r[1]); }
        { const bool up = (lane & 2) != 0;
#pragma unroll
          for (int k = 0; k < 2; ++k) { const int keep = up ? d4[2 + k] : d4[k], give = up ? d4[k] : d4[2 + k]; d2[k] = keep + __builtin_amdgcn_update_dpp(0, give, 0x4E, 0xF, 0xF, false); } }
        { const bool up = (lane & 1) != 0; const int keep = up ? d2[1] : d2[0], give = up ? d2[0] : d2[1]; d1 = keep + __builtin_amdgcn_update_dpp(0, give, 0xB1, 0xF, 0xF, false); }
        d1 += __builtin_amdgcn_update_dpp(0, d1, 0x128, 0xF, 0xF, false);
        d1 += __builtin_amdgcn_update_dpp(0, d1, 0x124, 0xF, 0xF, false);
        const int ei = bi * EB + el;
        const int ba = (ei & 63) * 4;
        const float gsel = __uint_as_float((unsigned)__builtin_amdgcn_ds_bpermute(ba, (int)__float_as_uint((bi < 4) ? g0 : g1)));
        const float susel = __uint_as_float((unsigned)__builtin_amdgcn_ds_bpermute(ba, (int)__float_as_uint((bi < 4) ? su0 : su1)));
        const float svsel = __uint_as_float((unsigned)__builtin_amdgcn_ds_bpermute(ba, (int)__float_as_uint((bi < 4) ? sv0 : sv1)));
        const float aval = ((float)d1 - xoff) * sx * susel;
        const float cl = gsel * gelu_as(aval) * svsel;
#pragma unroll
        for (int e = 0; e < EB; ++e) {
            const float ce = __uint_as_float((unsigned)__builtin_amdgcn_readlane((int)__float_as_uint(cl), ((e >> 3) & 1) * 32 + ((e >> 2) & 1) * 16 + ((e >> 1) & 1) * 2 + (e & 1)));
            sumc += ce;
#pragma unroll
            for (int m = 0; m < 2; ++m) { const unsigned w = rb[e][2 + m], lo = w & 0x0F0F0F0Fu, hi = (w >> 4) & 0x0F0F0F0Fu;
                float f[8];
                asm("v_cvt_f32_ubyte0 %0, %1" : "=v"(f[0]) : "v"(lo)); asm("v_cvt_f32_ubyte1 %0, %1" : "=v"(f[1]) : "v"(lo)); asm("v_cvt_f32_ubyte2 %0, %1" : "=v"(f[2]) : "v"(lo)); asm("v_cvt_f32_ubyte3 %0, %1" : "=v"(f[3]) : "v"(lo));
                asm("v_cvt_f32_ubyte0 %0, %1" : "=v"(f[4]) : "v"(hi)); asm("v_cvt_f32_ubyte1 %0, %1" : "=v"(f[5]) : "v"(hi)); asm("v_cvt_f32_ubyte2 %0, %1" : "=v"(f[6]) : "v"(hi)); asm("v_cvt_f32_ubyte3 %0, %1" : "=v"(f[7]) : "v"(hi));
#pragma unroll
                for (int i = 0; i < 8; ++i) acc[8 * m + i] += ce * f[i]; }
        }
#pragma unroll
        for (int e = 0; e < EB; ++e) rb[e] = rn[e];
    }
    float sy = 0.f;
#pragma unroll
    for (int i = 0; i < 16; ++i) { acc[i] -= 7.5f * sumc; sy += acc[i] * acc[i]; }
    const float ry = rsqrtf(wave_sum(sy) * (1.f / 1024.f) + EPS);
#pragma unroll
    for (int j = 0; j < 4; ++j) { const f32x4 y = (f32x4){acc[4 * j], acc[4 * j + 1], acc[4 * j + 2], acc[4 * j + 3]};
        float* op = out + (size_t)t * 1024 + 256 * j + 4 * lane;
        const u32x2 xw = *(const u32x2*)(xin + (size_t)t * 1024 + 256 * j + 4 * lane);
        *(f32x4*)op = pscale * (f32x4){__uint_as_float(xw.x << 16), __uint_as_float(xw.x & 0xffff0000u), __uint_as_float(xw.y << 16), __uint_as_float(xw.y & 0xffff0000u)} + pscale * *(const LAS f32x4*)(pv + 2048 + 256 * j + 4 * lane) * (y * ry); }
}

#define CE_DESC(a, b) do { const float _t = fmaxf(a, b); b = fminf(a, b); a = _t; } while (0)
__device__ __forceinline__ void sort16_desc(float (&v)[16]) {
#pragma unroll
    for (int k = 2; k <= 16; k <<= 1)
#pragma unroll
        for (int j = k >> 1; j > 0; j >>= 1)
#pragma unroll
            for (int i = 0; i < 16; ++i) { const int l = i ^ j; if (l > i) { if ((i & k) == 0 || k == 16) CE_DESC(v[i], v[l]); else CE_DESC(v[l], v[i]); } }
}
__device__ __forceinline__ void merge16_desc(float (&a)[16], const float (&b)[16]) {
#pragma unroll
    for (int i = 0; i < 16; ++i) a[i] = fmaxf(a[i], b[15 - i]);
#pragma unroll
    for (int j = 8; j > 0; j >>= 1)
#pragma unroll
        for (int i = 0; i < 16; ++i) { const int l = i ^ j; if (l > i) CE_DESC(a[i], a[l]); }
}
#define CE2_DESC(va, pa, vb, pb) do { const bool _c = (va) >= (vb); const float _tv = _c ? (va) : (vb), _tw = _c ? (vb) : (va); const int _tp = _c ? (pa) : (pb), _tq = _c ? (pb) : (pa); va = _tv; vb = _tw; pa = _tp; pb = _tq; } while (0)
template <int N> __device__ __forceinline__ void bitonic_merge_desc2(float (&v)[N], int (&p)[N]) {
#pragma unroll
    for (int j = N / 2; j > 0; j >>= 1)
#pragma unroll
        for (int i = 0; i < N; ++i) { const int l = i ^ j; if (l > i) CE2_DESC(v[i], p[i], v[l], p[l]); }
}
__device__ __forceinline__ void merge16_desc2(float (&a)[16], int (&pa)[16], const float (&b)[16], const int (&pb)[16]) {
#pragma unroll
    for (int i = 0; i < 16; ++i) { const bool c = a[i] >= b[15 - i]; pa[i] = c ? pa[i] : pb[15 - i]; a[i] = c ? a[i] : b[15 - i]; }
    bitonic_merge_desc2<16>(a, pa);
}
__device__ __forceinline__ void sort8_desc2(float (&v)[8], int (&p)[8]) {
#pragma unroll
    for (int k = 2; k <= 8; k <<= 1)
#pragma unroll
        for (int j = k >> 1; j > 0; j >>= 1)
#pragma unroll
            for (int i = 0; i < 8; ++i) { const int l = i ^ j; if (l > i) { if ((i & k) == 0 || k == 8) CE2_DESC(v[i], p[i], v[l], p[l]); else CE2_DESC(v[l], p[l], v[i], p[i]); } }
}
constexpr int RT_KROW = 272;
__device__ __forceinline__ void route_half(float (&top)[16], LAS const unsigned char* keys_lds, const bf16_t* __restrict__ qrow, int r32, int hi) {
    bf16x8 qf[8]; float ss = 0.f;
#pragma unroll
    for (int ks = 0; ks < 8; ++ks) { qf[ks] = *(const bf16x8*)(qrow + 16 * ks + 8 * hi);
#pragma unroll
        for (int j = 0; j < 8; ++j) { const float f = bf2f((bf16_t)qf[ks][j]); ss += f * f; } }
    ss += __shfl_xor(ss, 32);
    const float rn = rsqrtf(ss * (1.f / 128.f) + EPS);
    f32x16 acc[4];
#pragma unroll
    for (int kt = 0; kt < 4; ++kt) {
#pragma unroll
        for (int r = 0; r < 16; ++r) acc[kt][r] = 0.f;
#pragma unroll
        for (int ks = 0; ks < 8; ++ks) { const bf16x8 kf = *(LAS const bf16x8*)(keys_lds + (32 * kt + r32) * RT_KROW + (16 * ks + 8 * hi) * 2);
            acc[kt] = __builtin_amdgcn_mfma_f32_32x32x16_bf16(kf, qf[ks], acc[kt], 0, 0, 0); }
        __builtin_amdgcn_sched_barrier(0);
    }
    const unsigned hi4 = (unsigned)hi << 2;
    float g[4][16];
#pragma unroll
    for (int kt = 0; kt < 4; ++kt)
#pragma unroll
        for (int r = 0; r < 16; ++r) { const unsigned base = (unsigned)(32 * kt + (r & 3) + 8 * (r >> 2)); g[kt][r] = __uint_as_float((__float_as_uint(acc[kt][r] * rn) & 0xFFFFFF80u) | base); }
#pragma unroll
    for (int kt = 0; kt < 4; ++kt) sort16_desc(g[kt]);
    merge16_desc(g[0], g[1]); merge16_desc(g[2], g[3]); merge16_desc(g[0], g[2]);
    float o[16];
#pragma unroll
    for (int i = 0; i < 16; ++i) { g[0][i] = __uint_as_float(__float_as_uint(g[0][i]) | hi4); o[i] = __shfl_xor(g[0][i], 32); }
    merge16_desc(g[0], o);
#pragma unroll
    for (int i = 0; i < 16; ++i) top[i] = g[0][i];
}
__device__ __forceinline__ void route_final(const float (&A)[16], const float (&B)[16], LAS unsigned char* tab, int* idx_out, float* gate_out, bool writer) {
    {
        unsigned w[8];
#pragma unroll
        for (int q = 0; q < 4; ++q) {
            w[q] = (__float_as_uint(A[4 * q]) & 127u) | ((__float_as_uint(A[4 * q + 1]) & 127u) << 8) | ((__float_as_uint(A[4 * q + 2]) & 127u) << 16) | ((__float_as_uint(A[4 * q + 3]) & 127u) << 24);
            w[4 + q] = (__float_as_uint(B[4 * q]) & 127u) | ((__float_as_uint(B[4 * q + 1]) & 127u) << 8) | ((__float_as_uint(B[4 * q + 2]) & 127u) << 16) | ((__float_as_uint(B[4 * q + 3]) & 127u) << 24);
        }
        *(LAS u32x4*)(tab) = (u32x4){w[0], w[1], w[2], w[3]}; *(LAS u32x4*)(tab + 16) = (u32x4){w[4], w[5], w[6], w[7]};
    }
    const float NEG = -INFINITY;
#define CAND(i, j) __uint_as_float((__float_as_uint(A[i] + B[j]) & 0xFFFFFF00u) | (unsigned)(((i) << 4) | (j)))
    float m1[16], m2[16], m3[16];
#pragma unroll
    for (int j = 0; j < 16; ++j) m1[j] = CAND(0, j);
#pragma unroll
    for (int i = 0; i < 16; ++i) m2[i] = (i < 15) ? CAND((i < 15 ? i + 1 : 0), 0) : NEG;
    merge16_desc(m1, m2);
    __builtin_amdgcn_sched_barrier(0);
#pragma unroll
    for (int j = 0; j < 16; ++j) m3[j] = (j < 7) ? CAND(1, (j < 7 ? j + 1 : 0)) : NEG;
#pragma unroll
    for (int i = 0; i < 16; ++i) m2[i] = (i < 6) ? CAND((i < 6 ? i + 2 : 0), 1) : NEG;
    merge16_desc(m3, m2);
    __builtin_amdgcn_sched_barrier(0);
    m2[0] = CAND(2, 2); m2[1] = CAND(2, 3); m2[2] = CAND(2, 4); m2[3] = CAND(3, 2); m2[4] = CAND(4, 2); m2[5] = CAND(3, 3);
#pragma unroll
    for (int i = 6; i < 16; ++i) m2[i] = NEG;
    sort16_desc(m2);
    merge16_desc(m3, m2);
    merge16_desc(m1, m3);
    __builtin_amdgcn_sched_barrier(0);
#undef CAND
    float e[16], den = 0.f; int ex[16];
#pragma unroll
    for (int i = 0; i < 16; ++i) { e[i] = __expf(m1[i] - m1[0]); den += e[i]; const unsigned r = __float_as_uint(m1[i]) & 255u; ex[i] = (int)tab[r >> 4] * 128 + (int)tab[16 + (r & 15u)]; }
    const float inv = 1.f / den;
    if (writer) {
#pragma unroll
        for (int i = 0; i < 4; ++i) { *(u32x4*)(idx_out + 4 * i) = (u32x4){(unsigned)ex[4 * i], (unsigned)ex[4 * i + 1], (unsigned)ex[4 * i + 2], (unsigned)ex[4 * i + 3]};
            *(f32x4*)(gate_out + 4 * i) = (f32x4){e[4 * i] * inv, e[4 * i + 1] * inv, e[4 * i + 2] * inv, e[4 * i + 3] * inv}; }
    }
}

namespace fa {
typedef short s16x4 __attribute__((ext_vector_type(4)));
constexpr int SLOT_V = 8192, SLOT_F = 16384, SLOT_BYTES = 16384 + 256;
constexpr int LDS_WS = 2 * SLOT_BYTES, LDS_OST = LDS_WS + 8 * 64 * 4, LDS_TOTAL = LDS_OST + 8 * 4096;
__device__ __forceinline__ int crow(int r, int hi) { return (r & 3) + 8 * (r >> 2) + 4 * hi; }
__device__ __forceinline__ void attn_unit(LAS unsigned char* lds, const bf16_t* __restrict__ PROJ, const float* __restrict__ F2T, bf16_t* OCAT, int b, int h, int qb, float kmax) {
    const int tid = ptid(), lane = tid & 63, r32 = lane & 31, hi = lane >> 5; const int wid = __builtin_amdgcn_readfirstlane(tid >> 6);
    const size_t rowbase = (size_t)b * SEQ; const int q0 = qb * 256;
    const bf16_t* Qw = PROJ + (rowbase + q0 + wid * 32) * NPROJ + C_Q + h * 64;
    const bf16_t* Kh = PROJ + rowbase * NPROJ + C_K + h * 64;
    const bf16_t* Vh = PROJ + rowbase * NPROJ + C_V + h * 64;
    const float* Fh = F2T + (size_t)(b * 8 + h) * SEQ;
    LAS float* wsf = (LAS float*)(lds + LDS_WS) + wid * 64;
    bf16x8 qr[4];
#pragma unroll
    for (int d0 = 0; d0 < 4; ++d0) qr[d0] = *(const bf16x8*)(Qw + (size_t)r32 * NPROJ + d0 * 16 + hi * 8);
    const float Fq = Fh[q0 + wid * 32 + r32];
    const int NT = 4 * qb + 4;
    int t0; float c0;
    {
        float qs = 0.f;
#pragma unroll
        for (int d0 = 0; d0 < 4; ++d0)
#pragma unroll
            for (int j = 0; j < 8; ++j) { const float f = bf2f((bf16_t)qr[d0][j]); qs += f * f; }
        qs += __shfl_xor(qs, 32);
        qs = wave_max(qs);
        if (lane == 0) wsf[0] = qs;
        __syncthreads();
        float qm = 0.f;
#pragma unroll
        for (int w = 0; w < 8; ++w) qm = fmaxf(qm, ((LAS float*)(lds + LDS_WS))[w * 64]);
        c0 = sqrtf(qm) * kmax;
        const float bound = 2.f * c0 + Fh[q0] + 40.f;
        const bool skip = (lane < NT - 4) && (bound - Fh[64 * lane + 63] < 0.f);
        const unsigned long long bal = __ballot(skip);
        t0 = __builtin_amdgcn_readfirstlane((int)__builtin_ctzll(~bal));
        __syncthreads();
    }
    const int krow = 8 * wid + (lane >> 3), kch = lane & 7;
    const bf16_t* ksrc = Kh + (size_t)krow * NPROJ + kch * 8;
    const int kdst = krow * 128 + ((kch ^ (krow & 7)) * 16);
    const bf16_t* vsrc = Vh + (size_t)(16 * (wid & 3) + (lane >> 2)) * NPROJ + (wid >> 2) * 32 + (lane & 3) * 8;
    const int sdst = wid * 1024 + lane * 16;
    u32x4 kreg = *(const u32x4*)(ksrc + (size_t)t0 * 64 * NPROJ), vreg = *(const u32x4*)(vsrc + (size_t)t0 * 64 * NPROJ);
    float freg = (wid == 0) ? Fh[t0 * 64 + lane] : 0.f;
    *(LAS u32x4*)(lds + kdst) = kreg; *(LAS u32x4*)(lds + SLOT_V + sdst) = vreg; if (wid == 0) *(LAS float*)(lds + SLOT_F + lane * 4) = freg;
    if (t0 + 1 < NT) { kreg = *(const u32x4*)(ksrc + (size_t)(t0 + 1) * 64 * NPROJ); vreg = *(const u32x4*)(vsrc + (size_t)(t0 + 1) * 64 * NPROJ); if (wid == 0) freg = Fh[(t0 + 1) * 64 + lane]; }
    __syncthreads();
    float l = 0.f; f32x16 o[2]; const float Fqs = Fq - c0;
#pragma unroll
    for (int r = 0; r < 16; ++r) { o[0][r] = 0.f; o[1][r] = 0.f; }
    const int qrel = wid * 32 + r32;
    int cur = 0;
    for (int t = t0; t < NT; ++t) {
        const bool more = (t + 1 < NT);
        u32x4 kreg2 = kreg, vreg2 = vreg; float freg2 = freg;
        if (t + 2 < NT) { kreg2 = *(const u32x4*)(ksrc + (size_t)(t + 2) * 64 * NPROJ); vreg2 = *(const u32x4*)(vsrc + (size_t)(t + 2) * 64 * NPROJ); if (wid == 0) freg2 = Fh[(t + 2) * 64 + lane]; }
        LAS unsigned char* slot = lds + cur * SLOT_BYTES;
        f32x16 p0, p1;
        { const LAS float* fk = (const LAS float*)(slot + SLOT_F);
#pragma unroll
          for (int g = 0; g < 4; ++g) { const f32x4 a = *(const LAS f32x4*)(fk + 8 * g + 4 * hi), c = *(const LAS f32x4*)(fk + 32 + 8 * g + 4 * hi);
#pragma unroll
              for (int i = 0; i < 4; ++i) { p0[4 * g + i] = Fqs - a[i]; p1[4 * g + i] = Fqs - c[i]; } } }
        { const LAS unsigned char* kb = slot + r32 * 128; const int sw = r32 & 7;
#pragma unroll
          for (int d0 = 0; d0 < 4; ++d0) { const int co = ((2 * d0 + hi) ^ sw) * 16; const bf16x8 b0 = *(const LAS bf16x8*)(kb + co), b1 = *(const LAS bf16x8*)(kb + co + 4096);
              p0 = __builtin_amdgcn_mfma_f32_32x32x16_bf16(b0, qr[d0], p0, 0, 0, 0); p1 = __builtin_amdgcn_mfma_f32_32x32x16_bf16(b1, qr[d0], p1, 0, 0, 0); } }
        const int jb = t - (NT - 4);
        if (jb >= 0) { const int kb0 = 64 * jb + 4 * hi;
#pragma unroll
            for (int r = 0; r < 16; ++r) { const int kv = kb0 + (r & 3) + 8 * (r >> 2); if (kv > qrel) p0[r] = -INFINITY; if (kv + 32 > qrel) p1[r] = -INFINITY; } }
        float rs = 0.f;
#pragma unroll
        for (int r = 0; r < 16; ++r) { p0[r] = __builtin_amdgcn_exp2f(p0[r]); p1[r] = __builtin_amdgcn_exp2f(p1[r]); rs += p0[r] + p1[r]; }
        l += rs;
        u32x4 pw0, pw1, pw2, pw3;
        pw0 = (u32x4){cvt_pk_bf16(p0[0], p0[1]), cvt_pk_bf16(p0[2], p0[3]), cvt_pk_bf16(p0[4], p0[5]), cvt_pk_bf16(p0[6], p0[7])};
        pw1 = (u32x4){cvt_pk_bf16(p0[8], p0[9]), cvt_pk_bf16(p0[10], p0[11]), cvt_pk_bf16(p0[12], p0[13]), cvt_pk_bf16(p0[14], p0[15])};
        pw2 = (u32x4){cvt_pk_bf16(p1[0], p1[1]), cvt_pk_bf16(p1[2], p1[3]), cvt_pk_bf16(p1[4], p1[5]), cvt_pk_bf16(p1[6], p1[7])};
        pw3 = (u32x4){cvt_pk_bf16(p1[8], p1[9]), cvt_pk_bf16(p1[10], p1[11]), cvt_pk_bf16(p1[12], p1[13]), cvt_pk_bf16(p1[14], p1[15])};
        { const int vb = (int)(unsigned)(size_t)(slot + SLOT_V) + ((lane >> 4) & 1) * 32 + (lane & 3) * 8 + (4 * hi + ((lane & 15) >> 2)) * 64;
#pragma unroll
          for (int d0 = 0; d0 < 2; ++d0) { s16x4 lo4[4], hi4[4];
#pragma unroll
              for (int ks = 0; ks < 4; ++ks) {
                  asm volatile("ds_read_b64_tr_b16 %0,%1 offset:%c2" : "=&v"(lo4[ks]) : "v"(vb), "i"(d0 * 4096 + ks * 1024) : "memory");
                  asm volatile("ds_read_b64_tr_b16 %0,%1 offset:%c2" : "=&v"(hi4[ks]) : "v"(vb), "i"(d0 * 4096 + ks * 1024 + 512) : "memory"); }
              asm volatile("s_waitcnt lgkmcnt(0)" ::: "memory"); __builtin_amdgcn_sched_barrier(0);
#define FA_PK(k) (bf16x8){lo4[k][0], lo4[k][1], lo4[k][2], lo4[k][3], hi4[k][0], hi4[k][1], hi4[k][2], hi4[k][3]}
              o[d0] = __builtin_amdgcn_mfma_f32_32x32x16_bf16(__builtin_bit_cast(bf16x8, pw0), FA_PK(0), o[d0], 0, 0, 0);
              o[d0] = __builtin_amdgcn_mfma_f32_32x32x16_bf16(__builtin_bit_cast(bf16x8, pw1), FA_PK(1), o[d0], 0, 0, 0);
              o[d0] = __builtin_amdgcn_mfma_f32_32x32x16_bf16(__builtin_bit_cast(bf16x8, pw2), FA_PK(2), o[d0], 0, 0, 0);
              o[d0] = __builtin_amdgcn_mfma_f32_32x32x16_bf16(__builtin_bit_cast(bf16x8, pw3), FA_PK(3), o[d0], 0, 0, 0);
#undef FA_PK
          } }
        if (more) { LAS unsigned char* nslot = lds + (cur ^ 1) * SLOT_BYTES;
            *(LAS u32x4*)(nslot + kdst) = kreg; *(LAS u32x4*)(nslot + SLOT_V + sdst) = vreg; if (wid == 0) *(LAS float*)(nslot + SLOT_F + lane * 4) = freg; }
        __syncthreads();
        cur ^= 1; kreg = kreg2; vreg = vreg2; freg = freg2;
    }
    l += __shfl_xor(l, 32);
    if (hi == 0) wsf[32 + r32] = l;
    asm volatile("s_waitcnt lgkmcnt(0)" ::: "memory");
    float rli[16];
#pragma unroll
    for (int r = 0; r < 16; ++r) rli[r] = __builtin_amdgcn_rcpf(wsf[32 + crow(r, hi)]);
    bf16_t* Ow = OCAT + (rowbase + q0 + wid * 32) * 1024 + h * 64;
    LAS bf16_t* stg = (LAS bf16_t*)(lds + LDS_OST) + wid * 2048;
#pragma unroll
    for (int r = 0; r < 16; ++r) { const int orow = crow(r, hi);
#pragma unroll
        for (int d0 = 0; d0 < 2; ++d0) stg[orow * 64 + d0 * 32 + r32] = f2bf(F8(2, o[d0][r] * rli[r])); }
    asm volatile("s_waitcnt lgkmcnt(0)" ::: "memory");
#pragma unroll
    for (int i = 0; i < 4; ++i) { const int row = i * 8 + (lane >> 3), ch = lane & 7; const u32x4 v = *(const LAS u32x4*)(stg + row * 64 + ch * 8); *(u32x4*)(Ow + (size_t)row * 1024 + ch * 8) = v; }
    __syncthreads();
}
}

namespace hg {
constexpr int P272 = 272, P144 = 144;
constexpr int L_RAW = 2048, L_RLF = L_RAW, L_RQ = L_RAW + 16384, L_RKK = L_RAW + 32768, L_RI = L_RAW + 49152;
constexpr int L_QJ = 2048, L_KH = L_QJ + 160 * P272;
constexpr int L_KT = L_RI + 64 * P272, L_IT = L_KT + 128 * P144, L_P = L_IT + 128 * P144, L_SEGT = L_P + 64 * P144  , L_END = L_SEGT + 4096;
static_assert(L_KH + 64 * P272 <= L_KT && L_END <= RING_BYTES, "hgrn LDS");
__device__ __forceinline__ int crow(int r, int hi) { return (r & 3) + 8 * (r >> 2) + 4 * hi; }
__device__ __forceinline__ int qj_row0(int j) { return (j == 0) ? 0 : (j == 1) ? 64 : (j == 2) ? 112 : 144; }
struct RawRegs { u32x4 lf[2], q[2], iv[2]; };
__device__ __forceinline__ void raw_load(RawRegs& R, const bf16_t* __restrict__ PROJ, const bf16_t* __restrict__ KK, int unit, int tid) {
    const int bh = unit >> 6, cch = unit & 63, b = bh >> 2, h = bh & 3; const size_t row0 = (size_t)b * SEQ + cch * 64;
#pragma unroll
    for (int it = 0; it < 2; ++it) { const int id = tid + 512 * it, t = id >> 4, ch = id & 15;
        const bf16_t* pr = PROJ + (row0 + t) * NPROJ + h * 128 + 8 * ch;
        R.lf[it] = *(const u32x4*)(pr + C_LF); R.q[it] = *(const u32x4*)(pr + C_HQ); R.iv[it] = *(const u32x4*)(pr + C_HI);
        }
}
template <bool DRY> __device__ __forceinline__ void pass_a_all(LAS unsigned char* lds, bf16_t* PROJ, const bf16_t* __restrict__ KK, bf16_t* HST, float* HD, int u0, int ustep, int uend) {
    const int tid = ptid(), lane = tid & 63, r32 = lane & 31, hi = lane >> 5; const int wid = __builtin_amdgcn_readfirstlane(tid >> 6);
    LAS float* segt = (LAS float*)(lds + L_SEGT);
    RawRegs R;
    if (u0 < uend) raw_load(R, PROJ, KK, u0, tid);
    for (int unit = u0; unit < uend; unit += ustep) {
        const int bh = unit >> 6, cch = unit & 63, b = bh >> 2, h = bh & 3;
        const size_t row0 = (size_t)b * SEQ + cch * 64;
#pragma unroll
        for (int it = 0; it < 2; ++it) { const int id = tid + 512 * it, t = id >> 4, ch = id & 15;
            *(LAS u32x4*)(lds + L_RLF + t * 256 + ch * 16) = R.lf[it]; *(LAS u32x4*)(lds + L_RQ + t * 256 + ch * 16) = R.q[it];
            *(LAS u32x4*)(lds + L_RI + t * P272 + ch * 16) = R.iv[it]; }
        __syncthreads();
        if (unit + ustep < uend) raw_load(R, PROJ, KK, unit + ustep, tid);
        const int kp = tid & 63, sg8 = wid;
        float Aa[8][2], qv[8][2], kv[8][2];
        { float run0 = 0.f, run1 = 0.f;
#pragma unroll
          for (int i = 0; i < 8; ++i) { const int off = (8 * sg8 + i) * 256 + kp * 4;
              const unsigned wl = *(const LAS unsigned*)(lds + L_RLF + off), wq = *(const LAS unsigned*)(lds + L_RQ + off);
              const float l0 = h2f((unsigned short)(wl & 0xffffu)), l1 = h2f((unsigned short)(wl >> 16));
              run0 += l0; run1 += l1; Aa[i][0] = run0; Aa[i][1] = run1;
              qv[i][0] = __uint_as_float(wq << 16); qv[i][1] = __uint_as_float(wq & 0xffff0000u); kv[i][0] = 1.f - __expf(l0); kv[i][1] = 1.f - __expf(l1); }
          *(LAS f32x2_t*)(segt + sg8 * 128 + 2 * kp) = (f32x2_t){run0, run1}; }
        { const int tp = tid & 31, vc = tid >> 5;
            const bf16x8 r0 = *(const LAS bf16x8*)(lds + L_RI + (2 * tp) * P272 + vc * 16), r1 = *(const LAS bf16x8*)(lds + L_RI + (2 * tp + 1) * P272 + vc * 16);
#pragma unroll
            for (int e8 = 0; e8 < 8; ++e8) *(LAS unsigned*)(lds + L_IT + (8 * vc + e8) * P144 + tp * 4) = (unsigned)(unsigned short)r0[e8] | ((unsigned)(unsigned short)r1[e8] << 16); }
        __syncthreads();
        float E[4][2], pre[2] = {0.f, 0.f};
        { float s0 = 0.f, s1 = 0.f;
#pragma unroll
          for (int sgi = 0; sgi < 8; ++sgi) { const f32x2_t v = *(const LAS f32x2_t*)(segt + sgi * 128 + 2 * kp); if (sgi < sg8) { pre[0] += v.x; pre[1] += v.y; } s0 += v.x; s1 += v.y; if (sgi & 1) { E[sgi >> 1][0] = s0; E[sgi >> 1][1] = s1; } } }
        const int jo = sg8 >> 1;
        float Eown[2];
#pragma unroll
        for (int k2 = 0; k2 < 2; ++k2) Eown[k2] = (jo == 0) ? E[0][k2] : (jo == 1) ? E[1][k2] : (jo == 2) ? E[2][k2] : E[3][k2];
        {
            bf16_t* pq = PROJ + (row0 + 8 * sg8) * NPROJ + C_HQ + h * 128 + 2 * kp;
            unsigned kt[2][4];
            float fj[4][2], f0[2], f3[2];
#pragma unroll
            for (int k2 = 0; k2 < 2; ++k2) { f0[k2] = __expf(Eown[k2]); f3[k2] = __expf(E[3][k2] - Eown[k2]);
#pragma unroll
                for (int j = 0; j < 4; ++j) fj[j][k2] = __expf(Eown[k2] - E[j][k2]); }
#pragma unroll
            for (int i = 0; i < 8; ++i) {
                const int t = 8 * sg8 + i;
                float qe[2], ke1[2];
#pragma unroll
                for (int k2 = 0; k2 < 2; ++k2) { const float A = pre[k2] + Aa[i][k2]; const float e1 = __expf(A - Eown[k2]), r1 = __builtin_amdgcn_rcpf(e1);
                    qe[k2] = qv[i][k2] * e1; ke1[k2] = kv[i][k2] * r1; }
                if (!DRY) *(unsigned*)(pq + (size_t)i * NPROJ) = pk2(qe[0] * f0[0], qe[1] * f0[1]);
#pragma unroll
                for (int j = 0; j < 4; ++j) if (j <= jo) *(LAS unsigned*)(lds + L_QJ + (qj_row0(j) + t - 16 * j) * P272 + kp * 4) = (j == jo) ? pk2(qe[0], qe[1]) : pk2(qe[0] * fj[j][0], qe[1] * fj[j][1]);
                *(LAS unsigned*)(lds + L_KH + t * P272 + kp * 4) = pk2(ke1[0], ke1[1]);
#pragma unroll
                for (int k2 = 0; k2 < 2; ++k2) { const unsigned ke = f2bf(ke1[k2] * f3[k2]); if (i & 1) kt[k2][i >> 1] |= ke << 16; else kt[k2][i >> 1] = ke; }
            }
#pragma unroll
            for (int k2 = 0; k2 < 2; ++k2) *(LAS u32x4*)(lds + L_KT + (2 * kp + k2) * P144 + sg8 * 16) = (u32x4){kt[k2][0], kt[k2][1], kt[k2][2], kt[k2][3]};
            if (sg8 == 0) *(f32x2_t*)(HD + (size_t)unit * 128 + 2 * kp) = (f32x2_t){__expf(E[3][0]), __expf(E[3][1])};
        }
        __syncthreads();
        {
            const int fr = lane & 15, fq = lane >> 4;
#pragma unroll
            for (int bb = 0; bb < 2; ++bb) {
                const int blk = 2 * wid + bb, bi = blk >> 2, bj = blk & 3;
                f32x4 acc = (f32x4){0.f, 0.f, 0.f, 0.f};
                if (bj <= bi) {
                    const LAS unsigned char* ap = lds + L_QJ + (qj_row0(bj) + 16 * (bi - bj) + fr) * P272 + fq * 16;
                    const LAS unsigned char* bp = lds + L_KH + (16 * bj + fr) * P272 + fq * 16;
#pragma unroll
                    for (int s = 0; s < 4; ++s) acc = __builtin_amdgcn_mfma_f32_16x16x32_bf16(*(const LAS bf16x8*)(ap + s * 64), *(const LAS bf16x8*)(bp + s * 64), acc, 0, 0, 0);
                }
#pragma unroll
                for (int r = 0; r < 4; ++r) { const int tl = 4 * fq + r; float v = acc[r]; if (bi == bj && fr > tl) v = 0.f;
                    *(LAS bf16_t*)(lds + L_P + (16 * bi + tl) * P144 + (16 * bj + fr) * 2) = f2bf(v); }
            }
        }
        __syncthreads();
        constexpr int L_SU = L_QJ, L_SO = L_QJ + 128 * P272;
        {
            const int vt = wid & 3, tt = wid >> 2;
            f32x16 acc;
#pragma unroll
            for (int r = 0; r < 16; ++r) acc[r] = 0.f;
#pragma unroll
            for (int ks = 0; ks < 4; ++ks) acc = __builtin_amdgcn_mfma_f32_32x32x16_bf16(*(const LAS bf16x8*)(lds + L_IT + (32 * vt + r32) * P144 + (16 * ks + 8 * hi) * 2), *(const LAS bf16x8*)(lds + L_P + (32 * tt + r32) * P144 + (16 * ks + 8 * hi) * 2), acc, 0, 0, 0);
#pragma unroll
            for (int g = 0; g < 4; ++g) { u32x2 w; w.x = cvt_pk_bf16(acc[4 * g], acc[4 * g + 1]); w.y = cvt_pk_bf16(acc[4 * g + 2], acc[4 * g + 3]); *(LAS u32x2*)(lds + L_SO + (32 * tt + r32) * P272 + (32 * vt + 8 * g + 4 * hi) * 2) = w; }
        }
        {
            const int kt_ = wid & 3;
#pragma unroll
            for (int vv = 0; vv < 2; ++vv) { const int vt = 2 * (wid >> 2) + vv;
                f32x16 acc;
#pragma unroll
                for (int r = 0; r < 16; ++r) acc[r] = 0.f;
#pragma unroll
                for (int ks = 0; ks < 4; ++ks) acc = __builtin_amdgcn_mfma_f32_32x32x16_bf16(*(const LAS bf16x8*)(lds + L_KT + (32 * kt_ + r32) * P144 + (16 * ks + 8 * hi) * 2), *(const LAS bf16x8*)(lds + L_IT + (32 * vt + r32) * P144 + (16 * ks + 8 * hi) * 2), acc, 0, 0, 0);
#pragma unroll
                for (int g = 0; g < 4; ++g) { u32x2 w; w.x = cvt_pk_bf16(acc[4 * g], acc[4 * g + 1]); w.y = cvt_pk_bf16(acc[4 * g + 2], acc[4 * g + 3]); *(LAS u32x2*)(lds + L_SU + (32 * vt + r32) * P272 + (32 * kt_ + 8 * g + 4 * hi) * 2) = w; } }
        }
        __syncthreads();
#pragma unroll
        for (int it = 0; it < 4; ++it) { const int id = tid + 512 * it, v = id >> 4, ch = id & 15;
            *(u32x4*)(HST + (size_t)unit * 16384 + (size_t)id * 8) = *(const LAS u32x4*)(lds + L_SU + v * P272 + ch * 16); }
        if (!DRY) {
#pragma unroll
            for (int it = 0; it < 2; ++it) { const int id = tid + 512 * it, t = id >> 4, ch = id & 15;
                *(u32x4*)(PROJ + (row0 + t) * NPROJ + C_LF + h * 128 + 8 * ch) = *(const LAS u32x4*)(lds + L_SO + t * P272 + ch * 16); }
        }
        __syncthreads();
    }
}
__device__ __forceinline__ void pass_b(bf16_t* HST, const float* __restrict__ HD, int grp) {
    const int bh = grp >> 12, rem = grp & 4095;
    float s0 = 0.f, s1 = 0.f, s2 = 0.f, s3 = 0.f;
    bf16_t* p = HST + (size_t)bh * 64 * 16384 + rem * 4;
    const float* pd = HD + (size_t)bh * 64 * 128 + (rem & 31) * 4;
#pragma unroll 8
    for (int cch = 0; cch < 64; ++cch) {
        const u32x2 u = *(const u32x2*)(p + (size_t)cch * 16384); const f32x4 d = *(const f32x4*)(pd + cch * 128);
        u32x2 w; w.x = pk2(s0, s1); w.y = pk2(s2, s3); *(u32x2*)(p + (size_t)cch * 16384) = w;
        s0 = d.x * s0 + __uint_as_float(u.x << 16); s1 = d.y * s1 + __uint_as_float(u.x & 0xffff0000u);
        s2 = d.z * s2 + __uint_as_float(u.y << 16); s3 = d.w * s3 + __uint_as_float(u.y & 0xffff0000u);
    }
}
constexpr int CL_PART = 0, CL_ST = 2048, CL_QT = CL_ST + 128 * P272, CL_OI = CL_QT + 64 * P272, CL_SG = CL_OI + 64 * P272, CL_END = CL_SG + 64 * P272;
static_assert(CL_END <= RING_BYTES, "hgrn pass C LDS");
struct CRegs { u32x4 st[4], qt[2], oi[2], sg[2]; };
__device__ __forceinline__ void c_load(CRegs& R, const bf16_t* __restrict__ PROJ, const bf16_t* __restrict__ HST, int unit, int tid) {
    const int bh = unit >> 6, cch = unit & 63, b = bh >> 2, h = bh & 3; const size_t row0 = (size_t)b * SEQ + cch * 64;
#pragma unroll
    for (int it = 0; it < 4; ++it) R.st[it] = *(const u32x4*)(HST + (size_t)unit * 16384 + (size_t)(tid + 512 * it) * 8);
#pragma unroll
    for (int it = 0; it < 2; ++it) { const int id = tid + 512 * it, t = id >> 4, ch = id & 15;
        const bf16_t* pr = PROJ + (row0 + t) * NPROJ + h * 128 + 8 * ch;
        R.qt[it] = *(const u32x4*)(pr + C_HQ); R.oi[it] = *(const u32x4*)(pr + C_LF); R.sg[it] = *(const u32x4*)(pr + C_SG); }
}
__device__ __forceinline__ void pass_c_all(LAS unsigned char* lds, const bf16_t* __restrict__ PROJ, const bf16_t* __restrict__ HST, const float* __restrict__ gn, bf16_t* OCAT, int u0, int ustep, int uend) {
    const int tid = ptid(), lane = tid & 63, r32 = lane & 31, hi = lane >> 5; const int wid = __builtin_amdgcn_readfirstlane(tid >> 6);
    const int vt = wid & 3, tt = wid >> 2, tl = 32 * tt + r32;
    LAS float* part = (LAS float*)(lds + CL_PART);
    CRegs R;
    if (u0 < uend) c_load(R, PROJ, HST, u0, tid);
    int par = 0;
    for (int unit = u0; unit < uend; unit += ustep, par ^= 1) {
        const int bh = unit >> 6, cch = unit & 63, b = bh >> 2, h = bh & 3;
        const size_t row0 = (size_t)b * SEQ + cch * 64;
#pragma unroll
        for (int it = 0; it < 4; ++it) { const int id = tid + 512 * it, v = id >> 4, ch = id & 15; *(LAS u32x4*)(lds + CL_ST + v * P272 + ch * 16) = R.st[it]; }
#pragma unroll
        for (int it = 0; it < 2; ++it) { const int id = tid + 512 * it, t = id >> 4, ch = id & 15;
            *(LAS u32x4*)(lds + CL_QT + t * P272 + ch * 16) = R.qt[it]; *(LAS u32x4*)(lds + CL_OI + t * P272 + ch * 16) = R.oi[it]; *(LAS u32x4*)(lds + CL_SG + t * P272 + ch * 16) = R.sg[it]; }
        __syncthreads();
        if (unit + ustep < uend) c_load(R, PROJ, HST, unit + ustep, tid);
        f32x16 acc;
#pragma unroll
        for (int g = 0; g < 4; ++g) { const u32x2 w = *(const LAS u32x2*)(lds + CL_OI + tl * P272 + (32 * vt + 8 * g + 4 * hi) * 2);
            acc[4 * g] = __uint_as_float(w.x << 16); acc[4 * g + 1] = __uint_as_float(w.x & 0xffff0000u); acc[4 * g + 2] = __uint_as_float(w.y << 16); acc[4 * g + 3] = __uint_as_float(w.y & 0xffff0000u); }
#pragma unroll
        for (int ks = 0; ks < 8; ++ks) acc = __builtin_amdgcn_mfma_f32_32x32x16_bf16(*(const LAS bf16x8*)(lds + CL_ST + (32 * vt + r32) * P272 + (16 * ks + 8 * hi) * 2), *(const LAS bf16x8*)(lds + CL_QT + tl * P272 + (16 * ks + 8 * hi) * 2), acc, 0, 0, 0);
        float ss = 0.f;
#pragma unroll
        for (int r = 0; r < 16; ++r) ss += acc[r] * acc[r];
        ss += __shfl_xor(ss, 32);
        LAS float* pp = part + par * 256;
        if (hi == 0) pp[vt * 64 + tl] = ss;
        __syncthreads();
        const float rn = rsqrtf((pp[tl] + pp[64 + tl] + pp[128 + tl] + pp[192 + tl]) * (1.f / 128.f) + EPS);
        const float* pg = gn + h * 128 + 32 * vt + 4 * hi;
#pragma unroll
        for (int g = 0; g < 4; ++g) { const u32x2 sw = *(const LAS u32x2*)(lds + CL_SG + tl * P272 + (32 * vt + 8 * g + 4 * hi) * 2); const f32x4 gv = *(const f32x4*)(pg + 8 * g);
            u32x2 w; w.x = cvt_pk_bf16(F8(2, acc[4 * g] * rn * gv.x * __uint_as_float(sw.x << 16)), F8(2, acc[4 * g + 1] * rn * gv.y * __uint_as_float(sw.x & 0xffff0000u)));
            w.y = cvt_pk_bf16(F8(2, acc[4 * g + 2] * rn * gv.z * __uint_as_float(sw.y << 16)), F8(2, acc[4 * g + 3] * rn * gv.w * __uint_as_float(sw.y & 0xffff0000u)));
            *(LAS u32x2*)(lds + CL_OI + tl * P272 + (32 * vt + 8 * g + 4 * hi) * 2) = w; }
        __syncthreads();
#pragma unroll
        for (int it = 0; it < 2; ++it) { const int id = tid + 512 * it, t = id >> 4, ch = id & 15;
            *(u32x4*)(OCAT + (row0 + t) * 1024 + 512 + h * 128 + 8 * ch) = *(const LAS u32x4*)(lds + CL_OI + t * P272 + ch * 16); }
        __syncthreads();
    }
}
}

__global__ void __launch_bounds__(NTHREADS, 2) mega(Args a) {
    extern __shared__ __attribute__((aligned(16))) unsigned char lds_raw[];
    LAS unsigned char* lds = (LAS unsigned char*)lds_raw;
    volatile LAS unsigned* MISC = (volatile LAS unsigned*)(lds + MISC_OFF);
    const int tid0 = threadIdx.x, wave = __builtin_amdgcn_readfirstlane(tid0 >> 6);
    const int G = gridDim.x, bx = blockIdx.x, vcu = (G % 8 == 0) ? (bx % 8) * (G / 8) + bx / 8 : bx;
    const int gw = vcu * NWAVES + wave, NGW = G * NWAVES;
    unsigned* ctl = (unsigned*)(a.ws + WS_CTL);
    for (int u = tid0; u < (LDS_BYTES - RING_BYTES) / 4; u += NTHREADS) ((LAS unsigned*)(lds + RING_BYTES))[u] = 0u;
    __syncthreads();
    XcdBarrier bar = xcd_barrier_post(ctl + CW_BAR + a.li * XCD_BAR_WORDS, MISC + 8);
    const int lo = a.ph_lo, hi = a.ph_hi;
    if (TPROBE >= 0 && blockIdx.x == 0 && threadIdx.x == 0) ((unsigned long long*)(ctl + 8192))[0] = __builtin_amdgcn_s_memrealtime();
#ifndef PH_COMPILE
#define PH_COMPILE 0x7FF
#endif
#define IN(k) ((((PH_COMPILE) >> (k)) & 1) && lo <= (k) && (k) < hi)
#define STAMP(i) do { if (TPROBE >= 0 && bx == 0 && tid0 == 0) ((unsigned long long*)(ctl + 8192))[i] = __builtin_amdgcn_s_memrealtime(); } while (0)
#define SEAM(k) do { if (IN(k) && IN((k) + 1)) xcd_barrier(bar); STAMP((k) + 1); } while (0)

    typedef const __attribute__((address_space(4))) Args* KArgs;
#define PHASE_PTRS \
    KArgs ka = (KArgs)__builtin_amdgcn_kernarg_segment_ptr(); asm volatile("" : "+s"(ka)); \
    const int tid = ptid(), lane = tid & 63; (void)lane; \
    unsigned char* ws = ka->ws; (void)ws; \
    const float* x = ka->in[0]; const float* c_in = ka->in[1]; const float* w_ada = ka->in[2]; const float* b_ada = ka->in[3]; \
    const float* pre_mix_g = ka->in[4]; const float* w_in = ka->in[6]; const float* b_fox_f = ka->in[7]; const float* gamma = ka->in[8]; \
    const float* w_out = ka->in[10]; const float* w_q = ka->in[13]; const float* sub_keys = ka->in[14]; const float* U = ka->in[15]; const float* V = ka->in[16]; \
    float* MOD = (float*)(ws + WS_MOD); float* LB = (float*)(ws + WS_LB); float* WFF = (float*)(ws + WS_WFF); \
    bf16_t* WIN = (bf16_t*)(ws + WS_WIN); bf16_t* WOUT = (bf16_t*)(ws + WS_WOUT); bf16_t* WQ = (bf16_t*)(ws + WS_WQ); bf16_t* KEYS = (bf16_t*)(ws + WS_KEYS); \
    float* LOGF = (float*)(ws + WS_F); float* F2T = (float*)(ws + WS_F2T); bf16_t* H = (bf16_t*)(ws + WS_H); bf16_t* PROJ = (bf16_t*)(ws + WS_PROJ); bf16_t* KK = (bf16_t*)(ws + WS_KK); \
    bf16_t* OCAT = (bf16_t*)(ws + WS_OCAT); bf16_t* MIX = H; bf16_t* H2 = OCAT; bf16_t* Q2 = (bf16_t*)(ws + WS_Q2); \
    (void)x; (void)c_in; (void)w_ada; (void)b_ada; (void)pre_mix_g; (void)w_in; (void)b_fox_f; (void)gamma; (void)w_out; (void)w_q; (void)sub_keys; (void)U; (void)V; \
    (void)MOD; (void)LB; (void)WFF; (void)WIN; (void)WOUT; (void)WQ; (void)KEYS; (void)LOGF; (void)F2T; (void)H; (void)PROJ; (void)KK; (void)OCAT; (void)MIX; (void)H2; (void)Q2;
    const int flags = a.flags;

    for (int rep_ = 0; rep_ < ((DUP_PHASE == 0) ? 2 : 1); ++rep_) if (IN(0)) { PHASE_PTRS
        LAS float* condl = (LAS float*)lds;
        for (int i = tid; i < 8192; i += NTHREADS) { const float cv = c_in[i]; condl[i] = cv * sigmoidf_(cv); }
        __syncthreads();
        for (int it = gw; it < 768; it += NGW) {
            const int j = it * 8 + (lane & 7), ks = lane >> 3;
            float acc[8];
#pragma unroll
            for (int b = 0; b < 8; ++b) acc[b] = 0.f;
            const float* wp = w_ada + (size_t)ks * 6144 + j;
#pragma unroll 8
            for (int i = 0; i < 128; ++i) { const float w = wp[(size_t)i * 8 * 6144]; const int k = ks + 8 * i;
#pragma unroll
                for (int b = 0; b < 8; ++b) acc[b] += condl[b * 1024 + k] * w; }
#pragma unroll
            for (int b = 0; b < 8; ++b) { float v = acc[b]; v += __shfl_xor(v, 8); v += __shfl_xor(v, 16); v += __shfl_xor(v, 32); acc[b] = v; }
            if (lane < 8) { const float bb = b_ada[j];
#pragma unroll
                for (int b = 0; b < 8; ++b) MOD[b * 6144 + j] = acc[b] + bb; }
        }
        if (gw == NGW - 1) { for (int i = lane; i < 512; i += 64) LB[i] = 1.f / (1.f + __expf(gamma[512 + i] - gamma[i])); ((float*)(ws + WS_LB + 4096))[lane] = 0.f; ((float*)(ws + WS_LB + 4096))[64 + lane] = 0.f; }
        LAS float* scr = (LAS float*)(lds + 32768 + wave * 8448);
        for (int it = gw; it < 3328; it += NGW) {
            int r = it;
            if (r < 768) { transpose_item<1, G1F8 != 0>(w_in, 3592, 0, WIN, 0, scr, r, 48, lane); continue; } r -= 768;
            if (r < 1024) { transpose_item<1, G1F8 != 0>(w_in, 3592, 1544, WIN, 1536, scr, r, 64, lane); continue; } r -= 1024;
            if (r < 512) { transpose_item<2>(w_out, 1024, 0, WOUT, 0, scr, r, 32, lane); continue; } r -= 512;
            transpose_item<4>(w_q, 2048, 0, WQ, 0, scr, r, 64, lane);
        }
        for (int i = gw * 64 + lane; i < 8192; i += NGW * 64) { const int jj = i >> 10, k = i & 1023; WFF[i] = w_in[(size_t)k * 3592 + 1536 + jj]; }
        for (int i = gw * 64 + lane; i < 65536; i += NGW * 64) { const f32x4 v = *(const f32x4*)(sub_keys + (size_t)i * 4); u32x2 o; o.x = pk2(v.x, v.y); o.y = pk2(v.z, v.w); *(u32x2*)(KEYS + (size_t)i * 4) = o; }
    }
    SEAM(0);
    for (int rep_ = 0; rep_ < ((DUP_PHASE == 1) ? 2 : 1); ++rep_) if (IN(1)) { PHASE_PTRS const int rpw = (T + NGW - 1) / NGW; h_rows(x, pre_mix_g, MOD, WFF, b_fox_f, H, LOGF, gw * rpw, (gw * rpw + rpw < T) ? gw * rpw + rpw : T, lane); }
    SEAM(1);
    if (DUP_PHASE == 99) { for (int i = 0; i < 10; ++i) xcd_barrier(bar); }
    for (int rep_ = 0; rep_ < ((DUP_PHASE == 2) ? 2 : 1); ++rep_) if (IN(2)) { PHASE_PTRS
        if (bx < 64) {
            const int bh = bx, b = bh >> 3, h = bh & 7;
            LAS float* wtot = (LAS float*)lds;
            const float* p = LOGF + ((size_t)b * SEQ + tid * 8) * 8 + h;
            float v[8], tot = 0.f;
#pragma unroll
            for (int i = 0; i < 8; ++i) { v[i] = p[i * 8]; tot += v[i]; }
            float incl = tot;
#pragma unroll
            for (int o = 1; o < 64; o <<= 1) { const float n = __shfl_up(incl, o); if (lane >= o) incl += n; }
            if (lane == 63) wtot[wave] = incl;
            __syncthreads();
            float base = incl - tot;
            for (int w = 0; w < wave; ++w) base += wtot[w];
            u32x4 dummy; (void)dummy;
            float run = base;
            float* o = F2T + (size_t)bh * SEQ + tid * 8;
#pragma unroll
            for (int i = 0; i < 8; ++i) { run += v[i]; o[i] = run * LOG2E; }
            __syncthreads();
        }
        pg8::Gemm g{H, WIN, T, NPROJ, G1F8 ? 512 : 1024}; pg8::StaticOrder S; S.init(T, NPROJ, G, bx, WGM_G1);
        EpiProjT E{PROJ, KK, LB, (unsigned*)(ws + WS_LB + 4096)};
        pg8::gemm_phase<EpiProjT, pg8::StaticOrder, true, true, G1F8 != 0>(lds, g, S, E);
    }
    SEAM(2);
    if (IN(3)) { PHASE_PTRS
        const float* KMAXH = (const float*)(ws + WS_LB + 4096);
        if (flags & FL_HGRN) hg::pass_a_all<false>(lds, PROJ, KK, (bf16_t*)(ws + WS_HST), (float*)(ws + WS_HD), vcu, G, 2048);
        xcd_barrier(bar); STAMP(20);
        if (flags & FL_HGRN) { for (int g = vcu * NTHREADS + tid; g < 32 * 4096; g += G * NTHREADS) hg::pass_b((bf16_t*)(ws + WS_HST), (const float*)(ws + WS_HD), g); }
        if (flags & FL_ATTN) {
            unsigned* qctr = ctl + CW_ATTNQ;
            LAS int* ubox = (LAS int*)(lds + RING_BYTES + 64);
            for (int rep_ = 0; rep_ < ((DUP_PHASE == 3) ? 2 : 1); ++rep_)
            for (;;) {
                if (tid == 0) *ubox = (int)atomicAdd(qctr + 64 * rep_, 1u);
                __syncthreads();
                const int u = *ubox;
                __syncthreads();
                if (u >= 1024) break;
                const int qb = 15 - (u >> 6), bh = u & 63;
                fa::attn_unit(lds, PROJ, F2T, OCAT, bh >> 3, bh & 7, qb, sqrtf(KMAXH[2 * bh] + KMAXH[2 * bh + 1]));
            }
        }
    }
    SEAM(3);
    for (int rep_ = 0; rep_ < ((DUP_PHASE == 5) ? 2 : 1); ++rep_) if (IN(5) && (flags & FL_HGRN)) { PHASE_PTRS hg::pass_c_all(lds, PROJ, (const bf16_t*)(ws + WS_HST), ka->in[9], OCAT, vcu, G, 2048); }
    SEAM(5);
    for (int rep_ = 0; rep_ < ((DUP_PHASE == 6) ? 2 : 1); ++rep_) if (IN(6)) { PHASE_PTRS
        pg8::Gemm g{OCAT, WOUT, T, 1024, 1024}; pg8::StaticOrder S; S.init(T, 1024, G, bx, WGM_G2);
        EpiPlainT E{MIX, 1024};
        pg8::gemm_phase<EpiPlainT, pg8::StaticOrder, true, true>(lds, g, S, E);
    }
    SEAM(6);
    for (int rep_ = 0; rep_ < ((DUP_PHASE == 7) ? 2 : 1); ++rep_) if (IN(7)) { PHASE_PTRS const int rpw = (T + NGW - 1) / NGW; row_passes(x, MIX, MOD, ka->in[5], ka->in[11], (bf16_t*)(ws + WS_HST), H2, gw * rpw, (gw * rpw + rpw < T) ? gw * rpw + rpw : T, lane); }
    SEAM(7);
    for (int rep_ = 0; rep_ < ((DUP_PHASE == 8) ? 2 : 1); ++rep_) if (IN(8)) { PHASE_PTRS
        pg8::Gemm g{H2, WQ, T, NQ2, 1024}; pg8::StaticOrder S; S.init(T, NQ2, G, bx, WGM_G3);
        EpiPlainT E{Q2, NQ2};
        pg8::gemm_phase<EpiPlainT, pg8::StaticOrder, true, true>(lds, g, S, E);
    }
    SEAM(8);
    for (int rep_ = 0; rep_ < ((DUP_PHASE == 9) ? 2 : 1); ++rep_) if (IN(9)) { PHASE_PTRS
        const int h = vcu & 7;
        {
            const bf16_t* ksrc = KEYS + (size_t)h * 2 * 128 * 128;
            for (int i = tid; i < 4096; i += NTHREADS) { const int row = i >> 4, ch = i & 15; *(LAS u32x4*)(lds + row * RT_KROW + ch * 16) = *(const u32x4*)(ksrc + row * 128 + ch * 8); }
        }
        __syncthreads();
        const int r32 = lane & 31, hi = lane >> 5;
        int* IDXw = (int*)(ws + WS_IDX); float* GATEw = (float*)(ws + WS_GATE);
        int qi = 0;
        const int qrows = (NEXP + NGW - 1) / NGW;
        for (int tb = (vcu >> 3); tb < T / 256; tb += G / 8) {
            const int t = tb * 256 + wave * 32 + r32;
            const bf16_t* qrow = Q2 + (size_t)t * NQ2 + h * 256;
            float A[16], B[16];
            f32x4 qa[4], qb[4];
            const int ra = gw * qrows + qi, rb_ = ra + 1; const bool oka = (qi < qrows) && (ra < NEXP), okb = (qi + 1 < qrows) && (rb_ < NEXP);
            if (oka) qrow_load(qa, U, ra, lane); if (okb) qrow_load(qb, U, rb_, lane);
            route_half(A, lds, qrow, r32, hi);
            __builtin_amdgcn_sched_barrier(0);
            if (oka) qrow_store(qa, ws + WS_UQ, (float*)(ws + WS_US), ra, lane); if (okb) qrow_store(qb, ws + WS_UQ, (float*)(ws + WS_US), rb_, lane);
            if (oka) qrow_load(qa, V, ra, lane); if (okb) qrow_load(qb, V, rb_, lane);
            route_half(B, lds + 128 * RT_KROW, qrow + 128, r32, hi);
            __builtin_amdgcn_sched_barrier(0);
            if (oka) qrow_store(qa, ws + WS_UQ + 8, (float*)(ws + WS_VS), ra, lane); if (okb) qrow_store(qb, ws + WS_UQ + 8, (float*)(ws + WS_VS), rb_, lane);
            qi += 2;
            route_final(A, B, lds + 256 * RT_KROW + tid * 32, IDXw + (size_t)t * 128 + h * 16, GATEw + (size_t)t * 128 + h * 16, hi == 0);
        }
        for (; qi < qrows; ++qi) { const int r = gw * qrows + qi; if (r < NEXP) { f32x4 qa[4]; qrow_load(qa, U, r, lane); qrow_store(qa, ws + WS_UQ, (float*)(ws + WS_US), r, lane); qrow_load(qa, V, r, lane); qrow_store(qa, ws + WS_UQ + 8, (float*)(ws + WS_VS), r, lane); } }
    }
    SEAM(9);
    if (IN(10)) { PHASE_PTRS
        const int* IDX = (const int*)(ws + WS_IDX); const float* GATE = (const float*)(ws + WS_GATE);
        for (int rep_ = ((DUP_PHASE == 10) ? 0 : 1); rep_ < 2; ++rep_) { float* outp = rep_ ? ka->out : (float*)(ws + 280 * MiB);
            const int rmask = (rep_ == 0 && DUP_MODE == 1) ? 255 : 0x3FFF;
            float pd = 0.f;
            if (TPROBE >= 0) { const unsigned long long* ts = (const unsigned long long*)(ctl + 8192); const int i0_ = (TPROBE == 30) ? 3 : (TPROBE == 31) ? 20 : (TPROBE == 5) ? 4 : TPROBE, i1_ = (TPROBE == 30) ? 20 : (TPROBE == 31) ? 4 : TPROBE + 1;
                const float dus = (float)(long long)(__hip_atomic_load(ts + i1_, __ATOMIC_RELAXED, __HIP_MEMORY_SCOPE_AGENT) - __hip_atomic_load(ts + i0_, __ATOMIC_RELAXED, __HIP_MEMORY_SCOPE_AGENT)) * 0.01f;
                pd = sqrtf(16.f * 0.004f * fminf(fmaxf(dus, 0.f), TPROBE_FS) / TPROBE_FS); }
            {
                const int tpw = (T + NGW - 1) / NGW, tb0 = vcu * NWAVES * tpw, b = (tb0 < T ? tb0 : 0) / SEQ;
                LAS float* pv = (LAS float*)lds; const float* md = MOD + b * 6144; const float* g_pre = ka->in[11]; const float* g_post = ka->in[12];
                for (int i = tid; i < 1024; i += NTHREADS) { pv[i] = g_pre[i] * (md[4096 + i] + 1.f); pv[1024 + i] = md[3072 + i]; pv[2048 + i] = md[5120 + i] * g_post[i]; }
                __syncthreads();
                const int t0 = gw * tpw, t1 = (t0 + tpw < T) ? t0 + tpw : T;
#pragma unroll 1
                for (int t = t0; t < t1; ++t) expert_token((const unsigned char*)(ws + WS_UQ), (const float*)(ws + WS_US), (const float*)(ws + WS_VS), IDX, GATE, pv, (const bf16_t*)(ws + WS_HST), outp, t, lane, rmask, (t < 2048) ? 1.f + pd : 1.f);
                __syncthreads();
            } }
    }
#undef IN
#undef SEAM
}

extern "C" void kernel_launch(void* const* d_in, const int* in_sizes, int n_in, void* d_out, int out_size, void* d_ws, size_t ws_size, hipStream_t stream) {
    if (n_in != 17 || in_sizes[0] != T * DM || out_size != T * DM || ws_size < WS_END) { fprintf(stderr, "kernel_launch: unexpected inputs (n_in %d, ws %zu); nothing launched\n", n_in, ws_size); return; }
    static int grid = 0;
    if (grid == 0) {
        int dev = 0, cus = 0, per_cu = 0;
        if (hipGetDevice(&dev) != hipSuccess || hipDeviceGetAttribute(&cus, hipDeviceAttributeMultiprocessorCount, dev) != hipSuccess) { grid = -1; return; }
        if (hipFuncSetAttribute((const void*)mega, hipFuncAttributeMaxDynamicSharedMemorySize, LDS_BYTES) != hipSuccess) { fprintf(stderr, "kernel_launch: hipFuncSetAttribute failed\n"); grid = -1; return; }
        if (hipOccupancyMaxActiveBlocksPerMultiprocessor(&per_cu, (const void*)mega, NTHREADS, LDS_BYTES) != hipSuccess || per_cu < 1) { fprintf(stderr, "kernel_launch: occupancy query says %d\n", per_cu); (void)hipGetLastError(); grid = -1; return; }
        grid = cus;
        { const int rpw = (T + grid * NWAVES - 1) / (grid * NWAVES); if (SEQ % rpw != 0) { fprintf(stderr, "kernel_launch: %d CUs: the row passes give each wave %d consecutive rows, which must not straddle a batch; nothing launched\n", grid, rpw); grid = -1; return; } }
        if (grid % 8 != 0) { fprintf(stderr, "kernel_launch: %d CUs: the routing phase deals heads over groups of 8 workgroups; nothing launched\n", grid); grid = -1; return; }
    }
    if (grid < 0) return;
    if (hipMemsetAsync((unsigned char*)d_ws + WS_CTL, 0, CTL_ZERO_BYTES, stream) != hipSuccess) return;
    Args a{}; for (int i = 0; i < 17; ++i) a.in[i] = (const float*)d_in[i];
    a.out = (float*)d_out; a.ws = (unsigned char*)d_ws; a.ph_lo = 0; a.ph_hi = 11; a.li = 0; a.flags = FL_ATTN | FL_HGRN;
    hipLaunchKernelGGL(mega, dim3(grid), dim3(NTHREADS), LDS_BYTES, stream, a);
}
```

```cpp
#include <hip/hip_runtime.h>
#include <stdint.h>
#include <cstdio>

typedef unsigned short bf16_t;
typedef short bf16x8 __attribute__((ext_vector_type(8)));
typedef float f32x4 __attribute__((ext_vector_type(4)));
typedef float f32x16 __attribute__((ext_vector_type(16)));
typedef unsigned u32x4 __attribute__((ext_vector_type(4)));
typedef unsigned u32x2 __attribute__((ext_vector_type(2)));

constexpr int BATCH = 8, SEQ = 4096, DM = 1024, T = BATCH * SEQ;
constexpr int NPROJ = 3584;
constexpr int C_Q = 0, C_K = 512, C_V = 1024, C_HQ = 1536, C_LF = 2048, C_HI = 2560, C_SG = 3072;
constexpr int NQ2 = 2048, NEXP = 16384;
constexpr float EPS = 1e-6f;
constexpr float LOG2E = 1.4426950408889634f;
constexpr float QSCALE = 0.125f * LOG2E;
constexpr float HQSCALE = 0.08838834764831845f;

constexpr size_t MiB = 1u << 20;
constexpr size_t WS_CTL = 0;
constexpr size_t WS_MOD = 1 * MiB;
constexpr size_t WS_LB = WS_MOD + 256 * 1024;
constexpr size_t WS_WFF = WS_MOD + 512 * 1024;
constexpr size_t WS_WIN = 2 * MiB;
constexpr size_t WS_WOUT = 10 * MiB;
constexpr size_t WS_WQ = 12 * MiB;
constexpr size_t WS_KEYS = 16 * MiB;
constexpr size_t WS_US = 17 * MiB;
constexpr size_t WS_VS = WS_US + 256 * 1024;
constexpr size_t WS_UQ = 18 * MiB;
constexpr size_t WS_F = 50 * MiB;
constexpr size_t WS_F2T = 52 * MiB;
constexpr size_t WS_H = 56 * MiB;
constexpr size_t WS_PROJ = 120 * MiB;
constexpr size_t WS_KK = 344 * MiB;
constexpr size_t WS_OCAT = 376 * MiB;
constexpr size_t WS_HST = 440 * MiB;
constexpr size_t WS_HD = 504 * MiB;
constexpr size_t WS_Q2 = WS_PROJ;
constexpr size_t WS_IDX = WS_PROJ + 128 * MiB;
constexpr size_t WS_GATE = WS_PROJ + 144 * MiB;
constexpr size_t WS_END = 505 * MiB;

__device__ __forceinline__ float bf2f(bf16_t v) { return __uint_as_float(((unsigned)v) << 16); }
typedef float f32x2_t __attribute__((ext_vector_type(2))); typedef __bf16 bf16x2_t __attribute__((ext_vector_type(2)));
__device__ __forceinline__ unsigned pk2(float lo, float hi) { f32x2_t v = {lo, hi}; bf16x2_t b = __builtin_convertvector(v, bf16x2_t); return __builtin_bit_cast(unsigned, b); }
#ifndef FP8SIM
#define FP8SIM 0
#endif
__device__ __forceinline__ float f8r_(float v) { const int p = __builtin_amdgcn_cvt_pk_fp8_f32(v, v, 0, false); return __builtin_amdgcn_cvt_f32_fp8(p, 0); }
__device__ __forceinline__ unsigned pk4f8(float a, float b, float c, float d) { int p = __builtin_amdgcn_cvt_pk_fp8_f32(a, b, 0, false); p = __builtin_amdgcn_cvt_pk_fp8_f32(c, d, p, true); return (unsigned)p; }
#ifndef G2F8
#define G2F8 1
#endif
#ifndef G1F8
#define G1F8 1
#endif
#define F8(bit, v) ((FP8SIM & (bit)) ? f8r_(v) : (v))
#define F8W(bit, v) ((FP8SIM & (bit)) ? f8r_((v) * 32.f) * 0.03125f : (v))
__device__ __forceinline__ bf16_t f2bf(float f) { return (bf16_t)(pk2(f, 0.f) & 0xffffu); }
__device__ __forceinline__ unsigned short f2h(float f) { _Float16 h = (_Float16)f; return __builtin_bit_cast(unsigned short, h); }
__device__ __forceinline__ float h2f(unsigned short u) { _Float16 h = __builtin_bit_cast(_Float16, u); return (float)h; }
#define WAVE_DPP(v, ctrl) __int_as_float(__builtin_amdgcn_update_dpp(0, __float_as_int(v), ctrl, 0xF, 0xF, false))
__device__ __forceinline__ float wave_sum(float v) {
    v += WAVE_DPP(v, 0xB1);
    v += WAVE_DPP(v, 0x4E);
    v += WAVE_DPP(v, 0x124);
    v += WAVE_DPP(v, 0x128);
    { const auto r = __builtin_amdgcn_permlane16_swap(__float_as_uint(v), __float_as_uint(v), false, false); v = __uint_as_float(r[0]) + __uint_as_float(r[1]); }
    { const auto r = __builtin_amdgcn_permlane32_swap(__float_as_uint(v), __float_as_uint(v), false, false); v = __uint_as_float(r[0]) + __uint_as_float(r[1]); }
    return v;
}
__device__ __forceinline__ float wave_max(float v) {
    v = fmaxf(v, WAVE_DPP(v, 0xB1));
    v = fmaxf(v, WAVE_DPP(v, 0x4E));
    v = fmaxf(v, WAVE_DPP(v, 0x124));
    v = fmaxf(v, WAVE_DPP(v, 0x128));
    { const auto r = __builtin_amdgcn_permlane16_swap(__float_as_uint(v), __float_as_uint(v), false, false); v = fmaxf(__uint_as_float(r[0]), __uint_as_float(r[1])); }
    { const auto r = __builtin_amdgcn_permlane32_swap(__float_as_uint(v), __float_as_uint(v), false, false); v = fmaxf(__uint_as_float(r[0]), __uint_as_float(r[1])); }
    return v;
}
__device__ __forceinline__ float sigmoidf_(float z) { return __builtin_amdgcn_rcpf(1.f + __expf(-z)); }
__device__ __forceinline__ float gelu_erf(float a) { return 0.5f * a * (1.f + erff(a * 0.7071067811865476f)); }

#define DUP_PHASE (-1)
#define DUP_MODE 0
#define TPROBE_FS 300.f
namespace pg8 {
__device__ __forceinline__ int ptid_() { int t = threadIdx.x; asm volatile("" : "+v"(t)); return t; }
#define PG8_LAS __attribute__((address_space(3)))
typedef unsigned short bf16_t;
typedef short bf16x8 __attribute__((ext_vector_type(8)));
typedef float f32x4 __attribute__((ext_vector_type(4)));
typedef unsigned u32x4 __attribute__((ext_vector_type(4)));
constexpr int BM = 256, BK = 64, HALF = 128, HTB = HALF * BK * 2  , STAGE_BYTES = 8 * HTB, NXCD = 8, WGM = 4;

__host__ __device__ __forceinline__ int lds_byte(int r, int c) { const int st = (r >> 4) * 2 + (c >> 5), rr = r & 15, cc = c & 31, ob = rr * 64 + cc * 2; return st * 1024 + (ob ^ (((ob >> 9) & 1) << 5)); }
__host__ __device__ __forceinline__ void stage_rc(int b, int& R, int& C) { const int st = b / 1024, sb = b % 1024, swz = sb ^ (((sb >> 9) & 1) << 5); R = (st >> 1) * 16 + swz / 64; C = (st & 1) * 32 + (swz % 64) / 2; }
__host__ __device__ __forceinline__ int perm32(int rho) { const int n = rho >> 4, i = rho & 15; return 8 * (i >> 2) + 4 * n + (i & 3); }

struct Unit { int pm, pn; };
struct Gemm { const bf16_t* A; const bf16_t* Bt; int M, N, K; };

struct StaticOrder {
    int nM, nN, nwg, G, c, wgm;
    __host__ __device__ void init(int M, int N, int G_, int c_, int wgm_ = WGM) { nM = M / BM; nN = N / BM; nwg = nM * nN; G = G_; c = c_; wgm = wgm_; }
    __host__ __device__ bool next(int i, Unit& u) const {
        const long L = (long)i * G + c; if (L >= nwg) return false;
        int wgid = (int)L; { const int q = nwg / NXCD, r = nwg % NXCD, xcd = wgid % NXCD, off = wgid / NXCD; wgid = (xcd < r ? xcd * (q + 1) : r * (q + 1) + (xcd - r) * q) + off; }
        const int nig = wgm * nN, gid = wgid / nig, fm = gid * wgm, gsz = (nM - fm) < wgm ? (nM - fm) : wgm;
        u.pm = fm + ((wgid % nig) % gsz); u.pn = (wgid % nig) / gsz; return true;
    }
    __device__ __forceinline__ void a_ready(const Unit&) const {}
    __device__ __forceinline__ void done(const Unit&) const {}
};

typedef int i32x4 __attribute__((ext_vector_type(4)));
typedef int i32x8 __attribute__((ext_vector_type(8)));
template <class Epi, class Sched, bool ALIGN_EPI = false, bool SP2 = false, bool F8 = false, int SCALE_W = 0, int SCALE_A = 0>
__device__ __forceinline__ void gemm_phase(PG8_LAS unsigned char* lds, const Gemm g, const Sched& S, const Epi& E) {
    const int tid = ptid_(), wid = __builtin_amdgcn_readfirstlane(tid >> 6), lane = tid & 63, wr = wid >> 2, wc = wid & 3, fr = lane & 15, fq = lane >> 4;
    const int K = g.K, nt = K / BK;
    unsigned voffA[2], voffB[2];
#pragma unroll
    for (int i = 0; i < 2; ++i) { int R, C; stage_rc(tid * 16 + i * 8192, R, C); const int Rb = Epi::PERM ? ((R & ~31) + perm32(R & 31)) : R;
        voffA[i] = (unsigned)(R * K + C) * 2u; voffB[i] = (unsigned)(Rb * K + C) * 2u; }
    const size_t kstep = (size_t)(BK * 2);
    const size_t hstep = (size_t)HALF * K * 2;
    const size_t tstep = 2 * hstep;
    const unsigned ldsw = (unsigned)wid * 1024u;
    const int aoff = lds_byte(wr * 64 + fr, fq * 8), boff = lds_byte(wc * 32 + fr, fq * 8);
#define PG8_SA(b, h) (((b) * 2 + (h)) * HTB)
#define PG8_SB(b, h) ((4 + (b) * 2 + (h)) * HTB)
#define PG8_STAGE(bufoff, gbase, voff) do { _Pragma("unroll") for (int _i = 0; _i < 2; ++_i) { unsigned _vo = (voff)[_i]; asm volatile("" : "+v"(_vo));     \
        __builtin_amdgcn_global_load_lds((const unsigned*)((const char*)(gbase) + _vo), (PG8_LAS unsigned*)(lds + (bufoff) + ldsw + _i * 8192), 16, 0, 0); } } while (0)
#define PG8_LD8(p) __builtin_shufflevector(*(const PG8_LAS i32x4*)(p), *(const PG8_LAS i32x4*)((p) + 1024), 0, 1, 2, 3, 4, 5, 6, 7)
#define PG8_LDA(dst, b, h) do { if constexpr (F8) { _Pragma("unroll") for (int m = 0; m < 4; ++m) dst##8[m] = PG8_LD8(lds + PG8_SA(b, h) + aoff + m * 2048); } \
        else { _Pragma("unroll") for (int m = 0; m < 4; ++m) _Pragma("unroll") for (int k = 0; k < 2; ++k) dst[m][k] = *(const PG8_LAS bf16x8*)(lds + PG8_SA(b, h) + aoff + m * 2048 + k * 1024); } } while (0)
#define PG8_LDB(dst, b, h) do { if constexpr (F8) { _Pragma("unroll") for (int n = 0; n < 2; ++n) dst##8[n] = PG8_LD8(lds + PG8_SB(b, h) + boff + n * 2048); } \
        else { _Pragma("unroll") for (int n = 0; n < 2; ++n) _Pragma("unroll") for (int k = 0; k < 2; ++k) dst[n][k] = *(const PG8_LAS bf16x8*)(lds + PG8_SB(b, h) + boff + n * 2048 + k * 1024); } } while (0)
#define PG8_MMA(ai, bj, At, Bt) do { __builtin_amdgcn_s_setprio(1); \
        if constexpr (F8) { _Pragma("unroll") for (int m = 0; m < 4; ++m) _Pragma("unroll") for (int n = 0; n < 2; ++n) \
            acc[ai][bj][m][n] = __builtin_amdgcn_mfma_scale_f32_16x16x128_f8f6f4(Bt##8[n], At##8[m], acc[ai][bj][m][n], 0, 0, 0, SCALE_W, 0, SCALE_A); } \
        else { _Pragma("unroll") for (int m = 0; m < 4; ++m) _Pragma("unroll") for (int n = 0; n < 2; ++n) _Pragma("unroll") for (int k = 0; k < 2; ++k) \
            acc[ai][bj][m][n] = __builtin_amdgcn_mfma_f32_16x16x32_bf16(Bt[n][k], At[m][k], acc[ai][bj][m][n], 0, 0, 0); } \
        __builtin_amdgcn_s_setprio(0); } while (0)
#define PG8_WAIT_V(n) asm volatile("s_waitcnt vmcnt(" #n ")" ::: "memory")
#define PG8_WAIT_L(n) asm volatile("s_waitcnt lgkmcnt(" #n ")" ::: "memory")
#define PG8_BAR __builtin_amdgcn_s_barrier()
#define PG8_SCHED __builtin_amdgcn_sched_barrier(0)
    Unit cur, nxt; int ui = 0;
    if (!S.next(0, cur)) return;
    f32x4 acc[2][2][4][2];
#pragma unroll
    for (int a = 0; a < 2; ++a)
#pragma unroll
        for (int b = 0; b < 2; ++b)
#pragma unroll
            for (int m = 0; m < 4; ++m)
#pragma unroll
                for (int n = 0; n < 2; ++n) acc[a][b][m][n] = (f32x4){0.f, 0.f, 0.f, 0.f};
    bf16x8 At[4][2], B0[2][2], B1[2][2]; i32x8 At8[4], B08[2], B18[2];
    const char* cA = (const char*)g.A + (size_t)cur.pm * tstep; const char* cB = (const char*)g.Bt + (size_t)cur.pn * tstep;
    S.a_ready(cur);
    if constexpr (SP2) {
        PG8_STAGE(PG8_SB(0, 0), cB, voffB); PG8_STAGE(PG8_SB(0, 1), cB + hstep, voffB); PG8_STAGE(PG8_SA(0, 0), cA, voffA); PG8_STAGE(PG8_SA(0, 1), cA + hstep, voffA);
        if (wr == 1) PG8_BAR;
        PG8_WAIT_V(2); PG8_BAR;
        PG8_STAGE(PG8_SB(1, 0), cB + kstep, voffB); PG8_STAGE(PG8_SA(1, 0), cA + kstep, voffA); PG8_STAGE(PG8_SB(1, 1), cB + hstep + kstep, voffB);
        PG8_WAIT_V(6); PG8_BAR;
    } else {
        PG8_STAGE(PG8_SB(0, 0), cB, voffB); PG8_STAGE(PG8_SA(0, 0), cA, voffA); PG8_STAGE(PG8_SB(0, 1), cB + hstep, voffB); PG8_STAGE(PG8_SA(0, 1), cA + hstep, voffA);
        if (wr == 1) PG8_BAR;
        PG8_WAIT_V(4); PG8_BAR;
        PG8_STAGE(PG8_SB(1, 0), cB + kstep, voffB); PG8_STAGE(PG8_SA(1, 0), cA + kstep, voffA); PG8_STAGE(PG8_SB(1, 1), cB + hstep + kstep, voffB);
        PG8_WAIT_V(6); PG8_BAR;
    }
    for (;;) {
        const bool has_next = S.next(ui + 1, nxt);
        const char* nA = has_next ? (const char*)g.A + (size_t)nxt.pm * tstep : cA; const char* nB = has_next ? (const char*)g.Bt + (size_t)nxt.pn * tstep : cB;
#pragma unroll 1
        for (int t = 0; t < nt; t += 2) {
            const bool last = (t == nt - 2);
            const char* a1 = cA + (size_t)(t + 1) * kstep;
            const char* a2 = last ? nA : cA + (size_t)(t + 2) * kstep; const char* b2 = last ? nB : cB + (size_t)(t + 2) * kstep;
            const char* a3 = a2 + kstep; const char* b3 = b2 + kstep;
            if (last && has_next) S.a_ready(nxt);
            if constexpr (SP2) {
            PG8_LDB(B0, 0, 0); PG8_LDB(B1, 0, 1); PG8_SCHED; PG8_LDA(At, 0, 0); PG8_STAGE(PG8_SA(1, 1), a1 + hstep, voffA);
            PG8_WAIT_V(8); PG8_WAIT_L(0); PG8_BAR; PG8_MMA(0, 0, At, B0); PG8_MMA(0, 1, At, B1); PG8_BAR; PG8_SCHED;
            PG8_LDA(At, 0, 1); PG8_STAGE(PG8_SB(0, 0), b2, voffB); PG8_STAGE(PG8_SB(0, 1), b2 + hstep, voffB); PG8_STAGE(PG8_SA(0, 0), a2, voffA);
            PG8_WAIT_V(8); PG8_WAIT_L(0); PG8_BAR; PG8_MMA(1, 0, At, B0); PG8_MMA(1, 1, At, B1); PG8_BAR; PG8_SCHED;
            PG8_LDB(B0, 1, 0); PG8_LDB(B1, 1, 1); PG8_SCHED; PG8_LDA(At, 1, 0); PG8_STAGE(PG8_SA(0, 1), a2 + hstep, voffA);
            PG8_WAIT_V(8); PG8_WAIT_L(0); PG8_BAR; PG8_MMA(0, 0, At, B0); PG8_MMA(0, 1, At, B1); PG8_BAR; PG8_SCHED;
            PG8_LDA(At, 1, 1); PG8_STAGE(PG8_SB(1, 0), b3, voffB); PG8_STAGE(PG8_SB(1, 1), b3 + hstep, voffB); PG8_STAGE(PG8_SA(1, 0), a3, voffA);
            PG8_WAIT_V(8); PG8_WAIT_L(0); PG8_BAR; PG8_MMA(1, 0, At, B0); PG8_MMA(1, 1, At, B1); PG8_BAR; PG8_SCHED;
            } else {
            PG8_LDB(B0, 0, 0); PG8_SCHED; PG8_LDA(At, 0, 0); PG8_STAGE(PG8_SA(1, 1), a1 + hstep, voffA);
            PG8_WAIT_L(8); PG8_BAR; PG8_WAIT_L(0); PG8_MMA(0, 0, At, B0); PG8_BAR; PG8_SCHED;
            PG8_LDB(B1, 0, 1); PG8_STAGE(PG8_SB(0, 0), b2, voffB);
            PG8_BAR; PG8_WAIT_L(0); PG8_MMA(0, 1, At, B1); PG8_BAR;
            PG8_LDA(At, 0, 1); PG8_STAGE(PG8_SA(0, 0), a2, voffA);
            PG8_BAR; PG8_WAIT_L(0); PG8_MMA(1, 0, At, B0); PG8_BAR; PG8_SCHED;
            PG8_STAGE(PG8_SB(0, 1), b2 + hstep, voffB);
            PG8_WAIT_V(6); PG8_BAR; PG8_MMA(1, 1, At, B1); PG8_BAR;
            PG8_LDB(B0, 1, 0); PG8_SCHED; PG8_LDA(At, 1, 0); PG8_STAGE(PG8_SA(0, 1), a2 + hstep, voffA);
            PG8_WAIT_L(8); PG8_BAR; PG8_WAIT_L(0); PG8_MMA(0, 0, At, B0); PG8_BAR; PG8_SCHED;
            PG8_LDB(B1, 1, 1); PG8_STAGE(PG8_SB(1, 0), b3, voffB);
            PG8_BAR; PG8_WAIT_L(0); PG8_MMA(0, 1, At, B1); PG8_BAR;
            PG8_LDA(At, 1, 1); PG8_STAGE(PG8_SA(1, 0), a3, voffA);
            PG8_BAR; PG8_WAIT_L(0); PG8_MMA(1, 0, At, B0); PG8_BAR; PG8_SCHED;
            PG8_STAGE(PG8_SB(1, 1), b3 + hstep, voffB);
            PG8_WAIT_V(6); PG8_BAR; PG8_MMA(1, 1, At, B1); PG8_BAR;
            }
        }
        if constexpr (ALIGN_EPI) { if (wr == 0) PG8_BAR; }
        if constexpr (!Epi::AFTER_DRAIN) { const int t2 = ptid_(), w2 = __builtin_amdgcn_readfirstlane(t2 >> 6);
            E(acc, cur, w2 >> 2, w2 & 3, t2 & 15, (t2 & 63) >> 4); S.done(cur); }
        if (!has_next) break;
#pragma unroll
        for (int a = 0; a < 2; ++a)
#pragma unroll
            for (int b = 0; b < 2; ++b)
#pragma unroll
                for (int m = 0; m < 4; ++m)
#pragma unroll
                    for (int n = 0; n < 2; ++n) acc[a][b][m][n] = (f32x4){0.f, 0.f, 0.f, 0.f};
        cur = nxt; cA = nA; cB = nB; ++ui;
        if constexpr (ALIGN_EPI) { if (wr == 1) PG8_BAR; }
    }
    PG8_WAIT_V(0);
    if constexpr (!ALIGN_EPI) { if (wr == 0) PG8_BAR; }
    PG8_BAR;
    if constexpr (Epi::AFTER_DRAIN) { E.fused(acc, cur, wr, wc, fr, fq, lds, wid, lane); S.done(cur); }
#undef PG8_SA
#undef PG8_SB
#undef PG8_STAGE
#undef PG8_LDA
#undef PG8_LDB
#undef PG8_MMA
#undef PG8_WAIT_V
#undef PG8_WAIT_L
#undef PG8_BAR
#undef PG8_SCHED
}
}

#define LAS __attribute__((address_space(3)))
#ifndef WGM_G1
#define WGM_G1 4
#define WGM_G2 4
#define WGM_G3 4
#endif
#ifndef TPROBE
#define TPROBE (-1)
#endif
__device__ __forceinline__ int ptid() { int t = threadIdx.x; asm volatile("" : "+v"(t)); return t; }
constexpr int NWAVES = 8, NTHREADS = 512;
constexpr int RING_BYTES = 131072;
constexpr int MISC_OFF = RING_BYTES + 320;
constexpr int LDS_BYTES = 147456;
constexpr int CW_BAR = 4096;
constexpr size_t CTL_ZERO_BYTES = 40 * 1024;
constexpr int CW_ATTNQ = 7680;

#define XB_TMO      128
#define XB_XCNT(j)  (256  + 64 * (j))
#define XB_XSUB(j)  (1280 + 64 * (j))
#define XB_XGEN(j)  (2304 + 64 * (j))
#define XB_TOP      3328
#define XB_TOPGEN   3392
#define XCD_BAR_WORDS 3456
#define XB_SPIN_CAP (1u << 20)
__device__ __forceinline__ unsigned xb_ld(unsigned* p)              { return __hip_atomic_load(p, __ATOMIC_RELAXED, __HIP_MEMORY_SCOPE_AGENT); }
__device__ __forceinline__ unsigned xb_add(unsigned* p, unsigned v) { return __hip_atomic_fetch_add(p, v, __ATOMIC_RELAXED, __HIP_MEMORY_SCOPE_AGENT); }
__device__ __forceinline__ unsigned xb_xcc_id() { return (unsigned)__builtin_amdgcn_s_getreg((3 << 11) | 20) & 0xFu; }
#define XB_SPIN(cond, bar) do { unsigned _sp = 0; while (cond) { __builtin_amdgcn_s_sleep(1); \
    if ((++_sp & 255u) == 0u) { if (xb_ld(&(bar)[XB_TMO])) break; if (_sp > XB_SPIN_CAP) { atomicAdd(&(bar)[XB_TMO], 1u); break; } } } } while (0)
struct XcdBarrier { unsigned* bar; unsigned x; volatile LAS unsigned* st; };
__device__ __forceinline__ XcdBarrier xcd_barrier_post(unsigned* bar, volatile LAS unsigned* st) {
    XcdBarrier b; b.bar = bar; b.x = xb_xcc_id(); b.st = st;
    if (threadIdx.x == 0) (void)xb_add(&bar[XB_XCNT(b.x)], 1u);
    return b;
}
__device__ __forceinline__ void xcd_barrier_complete(unsigned* bar, unsigned x, unsigned& nloc, unsigned& nx) {
    const unsigned G = gridDim.x * gridDim.y * gridDim.z;
    unsigned sum, cnt, mine, sp = 0u;
    for (;;) {
        sum = 0u; cnt = 0u; mine = 0u;
#pragma unroll
        for (unsigned j = 0; j < 16; ++j) { const unsigned c = xb_ld(&bar[XB_XCNT(j)]); sum += c; cnt += (c > 0u) ? 1u : 0u; mine = (j == x) ? c : mine; }
        if (sum == G) break;
        __builtin_amdgcn_s_sleep(1);
        if ((++sp & 255u) == 0u) { if (xb_ld(&bar[XB_TMO])) break; if (sp > XB_SPIN_CAP) { atomicAdd(&bar[XB_TMO], 1u); break; } }
    }
    nloc = mine > 0u ? mine : 1u; nx = cnt > 0u ? cnt : 1u;
}
__device__ __forceinline__ void xcd_barrier(const XcdBarrier& b) {
    asm volatile("s_waitcnt vmcnt(0)" ::: "memory");
    __syncthreads();
    if (threadIdx.x == 0) {
        unsigned* bar = b.bar;
        __builtin_amdgcn_s_waitcnt(0);
        unsigned nloc = b.st[0], nx = b.st[1];
        if (nloc == 0u) { xcd_barrier_complete(bar, b.x, nloc, nx); b.st[0] = nloc; b.st[1] = nx; }
        const unsigned old = xb_add(&bar[XB_XSUB(b.x)], 1u);
        const unsigned gen = old / nloc;
        if (old + 1u == (gen + 1u) * nloc) {
            __builtin_amdgcn_fence(__ATOMIC_RELEASE, "agent");
            asm volatile("s_waitcnt vmcnt(0)" ::: "memory");
            const unsigned og = xb_add(&bar[XB_TOP], 1u);
            const unsigned tg = og / nx;
            if (og + 1u == (tg + 1u) * nx) xb_add(&bar[XB_TOPGEN], 1u);
            else XB_SPIN(xb_ld(&bar[XB_TOPGEN]) == tg, bar);
            __builtin_amdgcn_fence(__ATOMIC_ACQUIRE, "agent");
            xb_add(&bar[XB_XGEN(b.x)], 1u);
            asm volatile("s_waitcnt vmcnt(0)" ::: "memory");
        } else {
            XB_SPIN(xb_ld(&bar[XB_XGEN(b.x)]) == gen, bar);
            __builtin_amdgcn_fence(__ATOMIC_ACQUIRE, "agent");
            asm volatile("s_waitcnt vmcnt(0)" ::: "memory");
        }
    }
    __syncthreads();
}

struct Args { const float* in[17]; float* out; unsigned char* ws; int ph_lo, ph_hi, li, flags; };
enum { FL_ATTN = 1, FL_HGRN = 2 };

__device__ __forceinline__ unsigned cvt_pk_bf16(float lo, float hi) { f32x2_t v = {lo, hi}; bf16x2_t b = __builtin_convertvector(v, bf16x2_t); return __builtin_bit_cast(unsigned, b); }
struct EpiPlainT {
    static constexpr bool PERM = true, AFTER_DRAIN = false;
    bf16_t* O; int ld; float sc;
    __device__ __forceinline__ void operator()(const pg8::f32x4 (&acc)[2][2][4][2], const pg8::Unit& u, int wr, int wc, int fr, int fq) const {
        const int row0 = u.pm * 256 + wr * 64 + fr, col0 = u.pn * 256 + wc * 32 + 8 * fq;
#pragma unroll
        for (int ai = 0; ai < 2; ++ai)
#pragma unroll
            for (int m = 0; m < 4; ++m) { bf16_t* rowp = O + (size_t)(row0 + ai * 128 + m * 16) * ld + col0;
#pragma unroll
                for (int bj = 0; bj < 2; ++bj) { const pg8::f32x4 v0 = acc[ai][bj][m][0] * sc, v1 = acc[ai][bj][m][1] * sc;
                    u32x4 w; w.x = cvt_pk_bf16(v0[0], v0[1]); w.y = cvt_pk_bf16(v0[2], v0[3]); w.z = cvt_pk_bf16(v1[0], v1[1]); w.w = cvt_pk_bf16(v1[2], v1[3]);
                    *(u32x4*)(rowp + bj * 128) = w; } }
    }
};
struct EpiProjT {
    static constexpr bool PERM = true, AFTER_DRAIN = false;
    static constexpr float ASC = G1F8 ? 0.03125f : 1.f;
    bf16_t* proj; bf16_t* kk; const float* lb; unsigned* kmaxh;
    __device__ __forceinline__ void operator()(const pg8::f32x4 (&acc)[2][2][4][2], const pg8::Unit& u, int wr, int wc, int fr, int fq) const {
        const int row0 = u.pm * 256 + wr * 64 + fr, col0 = u.pn * 256 + wc * 32 + 8 * fq, seg = (u.pn * 256) >> 9;
        float kmx[2] = {0.f, 0.f};
        float lbv[2][8];
        if (seg == 4) {
#pragma unroll
            for (int bj = 0; bj < 2; ++bj)
#pragma unroll
                for (int i = 0; i < 8; ++i) lbv[bj][i] = lb[col0 - C_LF + bj * 128 + i];
        }
        const float sc = (seg == 0) ? QSCALE : (seg == 3) ? HQSCALE : 1.f;
#pragma unroll
        for (int ai = 0; ai < 2; ++ai)
#pragma unroll
            for (int m = 0; m < 4; ++m) { const size_t row = (size_t)(row0 + ai * 128 + m * 16);
#pragma unroll
                for (int bj = 0; bj < 2; ++bj) {
                    float v[8];
#pragma unroll
                    for (int i = 0; i < 4; ++i) { v[i] = acc[ai][bj][m][0][i] * ASC; v[4 + i] = acc[ai][bj][m][1][i] * ASC; }
                    u32x4 w;
                    if (seg == 4) {
                        float k1[8]; unsigned short hh[8];
#pragma unroll
                        for (int i = 0; i < 8; ++i) { const float l = lbv[bj][i], f = l + (1.f - l) * sigmoidf_(v[i]); k1[i] = 1.f - f; hh[i] = f2h(__builtin_amdgcn_logf(f) * 0.69314718056f); }
                        w.x = hh[0] | ((unsigned)hh[1] << 16); w.y = hh[2] | ((unsigned)hh[3] << 16); w.z = hh[4] | ((unsigned)hh[5] << 16); w.w = hh[6] | ((unsigned)hh[7] << 16);
                        (void)k1;
                    } else {
                        if (seg == 6) {
#pragma unroll
                            for (int i = 0; i < 8; ++i) v[i] = v[i] * sigmoidf_(v[i]);
                        } else {
#pragma unroll
                            for (int i = 0; i < 8; ++i) v[i] *= sc;
                        }
                        w.x = cvt_pk_bf16(v[0], v[1]); w.y = cvt_pk_bf16(v[2], v[3]); w.z = cvt_pk_bf16(v[4], v[5]); w.w = cvt_pk_bf16(v[6], v[7]);
                        if (seg == 1) {
                            float s = 0.f;
#pragma unroll
                            for (int i = 0; i < 4; ++i) { const float a = __uint_as_float(w[i] << 16), b = __uint_as_float(w[i] & 0xffff0000u); s += a * a + b * b; }
                            s += __shfl_xor(s, 16); s += __shfl_xor(s, 32);
                            kmx[bj] = fmaxf(kmx[bj], s);
                        }
                    }
                    *(u32x4*)(proj + row * NPROJ + col0 + bj * 128) = w;
                } }
        if (seg == 1) {
#pragma unroll
            for (int bj = 0; bj < 2; ++bj) { float m = kmx[bj]; m = fmaxf(m, __shfl_xor(m, 1)); m = fmaxf(m, __shfl_xor(m, 2)); m = fmaxf(m, __shfl_xor(m, 4)); m = fmaxf(m, __shfl_xor(m, 8));
                const int head = (u.pn - 2) * 4 + bj * 2 + (wc >> 1), b = (u.pm * 256) / SEQ;
                if (fr == 0 && fq == 0) atomicMax(kmaxh + ((b * 8 + head) * 2 + (wc & 1)), __float_as_uint(m)); }
        }
    }
};

template <int SB, bool F8OUT = false> __device__ __forceinline__ void transpose_item(const float* __restrict__ W, int ldw, int c0, bf16_t* WT, int r0, LAS float* scr, int item, int nblk, int lane) {
    const int k0 = 64 * (item / nblk), n0 = 32 * (item % nblk);
#pragma unroll 8
    for (int i = 0; i < 32; ++i) { const int kk = 2 * i + (lane >> 5); scr[kk * 33 + (lane & 31)] = W[(size_t)(k0 + kk) * ldw + c0 + n0 + (lane & 31)]; }
    asm volatile("s_waitcnt lgkmcnt(0)" ::: "memory");
    const int c = lane & 7;
#pragma unroll
    for (int j = 0; j < 4; ++j) { const int n = (lane >> 3) + 8 * j; const LAS float* s = scr + (8 * c) * 33 + n;
        if constexpr (F8OUT) { u32x2 o8; o8.x = pk4f8(s[0 * 33] * 32.f, s[1 * 33] * 32.f, s[2 * 33] * 32.f, s[3 * 33] * 32.f); o8.y = pk4f8(s[4 * 33] * 32.f, s[5 * 33] * 32.f, s[6 * 33] * 32.f, s[7 * 33] * 32.f);
            *(u32x2*)((unsigned char*)WT + (size_t)(r0 + n0 + n) * 1024 + k0 + 8 * c) = o8; continue; }
        u32x4 o; o.x = pk2(F8W(SB, s[0 * 33]), F8W(SB, s[1 * 33])); o.y = pk2(F8W(SB, s[2 * 33]), F8W(SB, s[3 * 33])); o.z = pk2(F8W(SB, s[4 * 33]), F8W(SB, s[5 * 33])); o.w = pk2(F8W(SB, s[6 * 33]), F8W(SB, s[7 * 33]));
        *(u32x4*)(WT + (size_t)(r0 + n0 + n) * 1024 + k0 + 8 * c) = o; }
    asm volatile("s_waitcnt lgkmcnt(0)" ::: "memory");
}
__device__ __forceinline__ void qrow_load(f32x4 (&v)[4], const float* __restrict__ src, int row, int lane) {
#pragma unroll
    for (int j = 0; j < 4; ++j) v[j] = *(const f32x4*)(src + (size_t)row * 1024 + 256 * j + 4 * lane);
}
__device__ __forceinline__ void qrow_store(const f32x4 (&v)[4], unsigned char* q, float* scale, int row, int lane) {
    float ss = 0.f;
#pragma unroll
    for (int j = 0; j < 4; ++j) ss += v[j].x * v[j].x + v[j].y * v[j].y + v[j].z * v[j].z + v[j].w * v[j].w;
    ss = wave_sum(ss);
    const float sc = ss > 0.f ? 0.3352f * sqrtf(ss * (1.f / 1024.f)) : 1.f, inv = __builtin_amdgcn_rcpf(sc);
    unsigned n[16];
#pragma unroll
    for (int j = 0; j < 4; ++j) {
#pragma unroll
        for (int i = 0; i < 4; ++i) { const float f = floorf(v[j][i] * inv) + 8.f; n[4 * j + i] = (unsigned)fminf(fmaxf(f, 0.f), 15.f); } }
    u32x2 o;
#pragma unroll
    for (int m = 0; m < 2; ++m) { unsigned w = 0;
#pragma unroll
        for (int b = 0; b < 4; ++b) w |= (n[8 * m + b] | (n[8 * m + 4 + b] << 4)) << (8 * b);
        o[m] = w; }
    *(u32x2*)(q + (size_t)row * 1024 + lane * 16) = o;
    if (lane == 0) scale[row] = sc;
}
__device__ __forceinline__ void h_rows(const float* __restrict__ x, const float* __restrict__ g, const float* __restrict__ mod, const float* __restrict__ wff, const float* __restrict__ bf, bf16_t* H, float* logf, int t0, int t1, int lane) {
    if (t0 >= t1) return;
    const int b = t0 / SEQ;
    const float* shift = mod + b * 6144, * scale = shift + 1024;
    f32x4 gm[4], sh[4];
#pragma unroll
    for (int j = 0; j < 4; ++j) { const int c0 = 256 * j + 4 * lane; gm[j] = *(const f32x4*)(g + c0) * (*(const f32x4*)(scale + c0) + 1.f); sh[j] = *(const f32x4*)(shift + c0); }
    const float bfl = (lane < 8) ? bf[lane] : 0.f;
    f32x4 nx[4];
#pragma unroll
    for (int j = 0; j < 4; ++j) nx[j] = *(const f32x4*)(x + (size_t)t0 * 1024 + 256 * j + 4 * lane);
    for (int t = t0; t < t1; ++t) {
        f32x4 v[4]; float s = 0.f;
#pragma unroll
        for (int j = 0; j < 4; ++j) { v[j] = nx[j]; s += v[j].x * v[j].x + v[j].y * v[j].y + v[j].z * v[j].z + v[j].w * v[j].w; }
        if (t + 1 < t1) {
#pragma unroll
            for (int j = 0; j < 4; ++j) nx[j] = *(const f32x4*)(x + (size_t)(t + 1) * 1024 + 256 * j + 4 * lane);
        }
        const float rstd = rsqrtf(wave_sum(s) * (1.f / 1024.f) + EPS);
        float ff[8];
#pragma unroll
        for (int i = 0; i < 8; ++i) ff[i] = 0.f;
#pragma unroll
        for (int j = 0; j < 4; ++j) {
            const int c0 = 256 * j + 4 * lane;
            const f32x4 h = v[j] * rstd * gm[j] + sh[j];
            if (G1F8) *(unsigned*)((unsigned char*)H + (size_t)t * 1024 + c0) = pk4f8(h.x, h.y, h.z, h.w);
            else { u32x2 o; o.x = pk2(F8(1, h.x), F8(1, h.y)); o.y = pk2(F8(1, h.z), F8(1, h.w)); *(u32x2*)(H + (size_t)t * 1024 + c0) = o; }
#pragma unroll
            for (int i = 0; i < 8; ++i) { const f32x4 w = *(const f32x4*)(wff + i * 1024 + c0); ff[i] += h.x * w.x + h.y * w.y + h.z * w.z + h.w * w.w; }
        }
#pragma unroll
        for (int i = 0; i < 8; ++i) ff[i] = wave_sum(ff[i]);
        if (lane < 8) {
            float z = 0.f;
#pragma unroll
            for (int i = 0; i < 8; ++i) z = (lane == i) ? ff[i] : z;
            z += bfl;
            logf[(size_t)t * 8 + lane] = fminf(z, 0.f) - log1pf(__expf(-fabsf(z)));
        }
    }
}

__device__ __forceinline__ void row_passes(const float* __restrict__ x, const bf16_t* __restrict__ mix, const float* __restrict__ mod, const float* __restrict__ g_post, const float* __restrict__ g_pre, bf16_t* XB, bf16_t* H2, int t0, int t1, int lane) {
    if (t0 >= t1) return;
    const int b = t0 / SEQ; const float* md = mod + b * 6144;
    f32x4 ga[4], gp[4], shf[4];
#pragma unroll
    for (int j = 0; j < 4; ++j) { const int c0 = 256 * j + 4 * lane; ga[j] = *(const f32x4*)(md + 2048 + c0) * *(const f32x4*)(g_post + c0);
        gp[j] = *(const f32x4*)(g_pre + c0) * (*(const f32x4*)(md + 4096 + c0) + 1.f); shf[j] = *(const f32x4*)(md + 3072 + c0); }
    f32x4 nx[4]; u32x2 nm[4];
#pragma unroll
    for (int j = 0; j < 4; ++j) { const int c0 = 256 * j + 4 * lane; nx[j] = *(const f32x4*)(x + (size_t)t0 * 1024 + c0); nm[j] = *(const u32x2*)(mix + (size_t)t0 * 1024 + c0); }
    for (int t = t0; t < t1; ++t) {
        f32x4 m[4], xv[4]; float s = 0.f;
#pragma unroll
        for (int j = 0; j < 4; ++j) { const u32x2 w = nm[j]; xv[j] = nx[j];
            m[j] = (f32x4){__uint_as_float(w.x << 16), __uint_as_float(w.x & 0xffff0000u), __uint_as_float(w.y << 16), __uint_as_float(w.y & 0xffff0000u)};
            s += m[j].x * m[j].x + m[j].y * m[j].y + m[j].z * m[j].z + m[j].w * m[j].w; }
        if (t + 1 < t1) {
#pragma unroll
            for (int j = 0; j < 4; ++j) { const int c0 = 256 * j + 4 * lane; nx[j] = *(const f32x4*)(x + (size_t)(t + 1) * 1024 + c0); nm[j] = *(const u32x2*)(mix + (size_t)(t + 1) * 1024 + c0); }
        }
        const float r1 = rsqrtf(wave_sum(s) * (1.f / 1024.f) + EPS);
        float s2 = 0.f;
#pragma unroll
        for (int j = 0; j < 4; ++j) { const int c0 = 256 * j + 4 * lane;
            xv[j] = xv[j] + ga[j] * (m[j] * r1);
            { u32x2 xo; xo.x = pk2(xv[j].x, xv[j].y); xo.y = pk2(xv[j].z, xv[j].w); *(u32x2*)(XB + (size_t)t * 1024 + c0) = xo; }
            s2 += xv[j].x * xv[j].x + xv[j].y * xv[j].y + xv[j].z * xv[j].z + xv[j].w * xv[j].w; }
        const float r2 = rsqrtf(wave_sum(s2) * (1.f / 1024.f) + EPS);
#pragma unroll
        for (int j = 0; j < 4; ++j) { const int c0 = 256 * j + 4 * lane;
            const f32x4 h = xv[j] * r2 * gp[j] + shf[j];
            u32x2 o; o.x = pk2(F8(4, h.x), F8(4, h.y)); o.y = pk2(F8(4, h.z), F8(4, h.w));
            *(u32x2*)(H2 + (size_t)t * 1024 + c0) = o; }
    }
}

__device__ __forceinline__ float gelu_as(float v) {
    const float av = fabsf(v), t = __builtin_amdgcn_rcpf(av * 0.2316418882f + 1.0f);
    float q = t * 0.5307027145f + (-0.7265760135f); q = q * t + 0.7107068705f; q = q * t + (-0.142248368f); q = q * t + 0.127414796f; q = q * t;
    const float m = v * (q * __builtin_amdgcn_exp2f((v * v) * (-0.72134752044f)));
    return v < 0.f ? m : v - m;
}
constexpr int EB = 16;
__device__ __forceinline__ void expert_token(const unsigned char* __restrict__ UV, const float* __restrict__ US, const float* __restrict__ VS,
                                             const int* __restrict__ IDX, const float* __restrict__ GATE, const LAS float* pv  ,
                                             const bf16_t* __restrict__ xin, float* out, int t, int lane, int rmask, float pscale) {
    float s2 = 0.f;
    float hv[16]; float mx = 0.f;
    {
    f32x4 x1[4];
#pragma unroll
    for (int j = 0; j < 4; ++j) { const u32x2 xw = *(const u32x2*)(xin + (size_t)t * 1024 + 256 * j + 4 * lane);
        x1[j] = (f32x4){__uint_as_float(xw.x << 16), __uint_as_float(xw.x & 0xffff0000u), __uint_as_float(xw.y << 16), __uint_as_float(xw.y & 0xffff0000u)}; s2 += x1[j].x * x1[j].x + x1[j].y * x1[j].y + x1[j].z * x1[j].z + x1[j].w * x1[j].w; }
    const float r2 = rsqrtf(wave_sum(s2) * (1.f / 1024.f) + EPS);
#pragma unroll
    for (int j = 0; j < 4; ++j) { const f32x4 h = x1[j] * r2 * *(const LAS f32x4*)(pv + 256 * j + 4 * lane) + *(const LAS f32x4*)(pv + 1024 + 256 * j + 4 * lane);
        hv[4 * j] = h.x; hv[4 * j + 1] = h.y; hv[4 * j + 2] = h.z; hv[4 * j + 3] = h.w;
        mx = fmaxf(mx, fmaxf(fmaxf(fabsf(h.x), fabsf(h.y)), fmaxf(fabsf(h.z), fabsf(h.w)))); }
    }
    const int i0 = IDX[(size_t)t * 128 + lane] & rmask, i1 = IDX[(size_t)t * 128 + 64 + lane] & rmask;
    const float g0 = GATE[(size_t)t * 128 + lane], g1 = GATE[(size_t)t * 128 + 64 + lane];
    const float su0 = US[i0], su1 = US[i1], sv0 = VS[i0], sv1 = VS[i1];
    mx = wave_max(mx);
    const float sx = mx > 0.f ? mx / 127.f : 1.f, isx = 1.f / sx;
    int xq[4]; int xs = 0;
#pragma unroll
    for (int j = 0; j < 4; ++j) { const int q0 = (int)rintf(hv[4 * j] * isx), q1 = (int)rintf(hv[4 * j + 1] * isx), q2 = (int)rintf(hv[4 * j + 2] * isx), q3 = (int)rintf(hv[4 * j + 3] * isx);
        xs += q0 + q1 + q2 + q3;
        xq[j] = (int)((unsigned)(q0 & 255) | ((unsigned)(q1 & 255) << 8) | ((unsigned)(q2 & 255) << 16) | ((unsigned)(q3 & 255) << 24)); }
#pragma unroll
    for (int o = 1; o < 64; o <<= 1) xs += __shfl_xor(xs, o);
    const float xoff = 7.5f * (float)xs;
    const int el = ((lane >> 5) & 1) * 8 + ((lane >> 4) & 1) * 4 + ((lane >> 1) & 1) * 2 + (lane & 1);
    float acc[16];
#pragma unroll
    for (int i = 0; i < 16; ++i) acc[i] = 0.f;
    float sumc = 0.f;
    const unsigned lo16 = (unsigned)lane * 16u;
    u32x4 rb[EB];
#pragma unroll
    for (int e = 0; e < EB; ++e) { const unsigned row = (unsigned)__builtin_amdgcn_readlane(i0, e); rb[e] = *(const u32x4*)(UV + (row * 1024u + lo16)); }
#pragma unroll 1
    for (int bi = 0; bi < 128 / EB; ++bi) {
        u32x4 rn[EB];
        {
            const int nb = (bi + 1) & 7, srcn = (nb < 4) ? i0 : i1, ln = (nb & 3) * EB;
#pragma unroll
            for (int e = 0; e < EB; ++e) { const unsigned row = (unsigned)__builtin_amdgcn_readlane(srcn, ln + e); rn[e] = *(const u32x4*)(UV + (row * 1024u + lo16)); }
        }
        int d[EB];
#pragma unroll
        for (int e = 0; e < EB; ++e) { const unsigned w0 = rb[e].x, w1 = rb[e].y;
            int s = __builtin_amdgcn_sdot4(xq[0], (int)(w0 & 0x0F0F0F0Fu), 0, false); s = __builtin_amdgcn_sdot4(xq[1], (int)((w0 >> 4) & 0x0F0F0F0Fu), s, false);
            s = __builtin_amdgcn_sdot4(xq[2], (int)(w1 & 0x0F0F0F0Fu), s, false); d[e] = __builtin_amdgcn_sdot4(xq[3], (int)((w1 >> 4) & 0x0F0F0F0Fu), s, false); }
        int d8[8], d4[4], d2[2], d1;
#pragma unroll
        for (int k = 0; k < 8; ++k) { const auto r = __builtin_amdgcn_permlane32_swap((unsigned)d[k], (unsigned)d[8 + k], false, false); d8[k] = (int)(r[0] + r[1]); }
#pragma unroll
        for (int k = 0; k < 4; ++k) { const auto r = __builtin_amdgcn_permlane16_swap((unsigned)d8[k], (unsigned)d8[4 + k], false, false); d4[k] = (int)(r[0] + r[1]); }
        { const bool up = (lane & 2) != 0;
#pragma unroll
          for (int k = 0; k < 2; ++k) { const int keep = up ? d4[2 + k] : d4[k], give = up ? d4[k] : d4[2 + k]; d2[k] = keep + __builtin_amdgcn_update_dpp(0, give, 0x4E, 0xF, 0xF, false); } }
        { const bool up = (lane & 1) != 0; const int keep = up ? d2[1] : d2[0], give = up ? d2[0] : d2[1]; d1 = keep + __builtin_amdgcn_update_dpp(0, give, 0xB1, 0xF, 0xF, false); }
        d1 += __builtin_amdgcn_update_dpp(0, d1, 0x128, 0xF, 0xF, false);
        d1 += __builtin_amdgcn_update_dpp(0, d1, 0x124, 0xF, 0xF, false);
        const int ei = bi * EB + el;
        const int ba = (ei & 63) * 4;
        const float gsel = __uint_as_float((unsigned)__builtin_amdgcn_ds_bpermute(ba, (int)__float_as_uint((bi < 4) ? g0 : g1)));
        const float susel = __uint_as_float((unsigned)__builtin_amdgcn_ds_bpermute(ba, (int)__float_as_uint((bi < 4) ? su0 : su1)));
        const float svsel = __uint_as_float((unsigned)__builtin_amdgcn_ds_bpermute(ba, (int)__float_as_uint((bi < 4) ? sv0 : sv1)));
        const float aval = ((float)d1 - xoff) * sx * susel;
        const float cl = gsel * gelu_as(aval) * svsel;
#pragma unroll
        for (int e = 0; e < EB; ++e) {
            const float ce = __uint_as_float((unsigned)__builtin_amdgcn_readlane((int)__float_as_uint(cl), ((e >> 3) & 1) * 32 + ((e >> 2) & 1) * 16 + ((e >> 1) & 1) * 2 + (e & 1)));
            sumc += ce;
#pragma unroll
            for (int m = 0; m < 2; ++m) { const unsigned w = rb[e][2 + m], lo = w & 0x0F0F0F0Fu, hi = (w >> 4) & 0x0F0F0F0Fu;
                float f[8];
                asm("v_cvt_f32_ubyte0 %0, %1" : "=v"(f[0]) : "v"(lo)); asm("v_cvt_f32_ubyte1 %0, %1" : "=v"(f[1]) : "v"(lo)); asm("v_cvt_f32_ubyte2 %0, %1" : "=v"(f[2]) : "v"(lo)); asm("v_cvt_f32_ubyte3 %0, %1" : "=v"(f[3]) : "v"(lo));
                asm("v_cvt_f32_ubyte0 %0, %1" : "=v"(f[4]) : "v"(hi)); asm("v_cvt_f32_ubyte1 %0, %1" : "=v"(f[5]) : "v"(hi)); asm("v_cvt_f32_ubyte2 %0, %1" : "=v"(f[6]) : "v"(hi)); asm("v_cvt_f32_ubyte3 %0, %1" : "=v"(f[7]) : "v"(hi));
#pragma unroll
                for (int i = 0; i < 8; ++i) acc[8 * m + i] += ce * f[i]; }
        }
#pragma unroll
        for (int e = 0; e < EB; ++e) rb[e] = rn[e];
    }
    float sy = 0.f;
#pragma unroll
    for (int i = 0; i < 16; ++i) { acc[i] -= 7.5f * sumc; sy += acc[i] * acc[i]; }
    const float ry = rsqrtf(wave_sum(sy) * (1.f / 1024.f) + EPS);
#pragma unroll
    for (int j = 0; j < 4; ++j) { const f32x4 y = (f32x4){acc[4 * j], acc[4 * j + 1], acc[4 * j + 2], acc[4 * j + 3]};
        float* op = out + (size_t)t * 1024 + 256 * j + 4 * lane;
        const u32x2 xw = *(const u32x2*)(xin + (size_t)t * 1024 + 256 * j + 4 * lane);
        *(f32x4*)op = pscale * (f32x4){__uint_as_float(xw.x << 16), __uint_as_float(xw.x & 0xffff0000u), __uint_as_float(xw.y << 16), __uint_as_float(xw.y & 0xffff0000u)} + pscale * *(const LAS f32x4*)(pv + 2048 + 256 * j + 4 * lane) * (y * ry); }
}

#define CE_DESC(a, b) do { const float _t = fmaxf(a, b); b = fminf(a, b); a = _t; } while (0)
__device__ __forceinline__ void sort16_desc(float (&v)[16]) {
#pragma unroll
    for (int k = 2; k <= 16; k <<= 1)
#pragma unroll
        for (int j = k >> 1; j > 0; j >>= 1)
#pragma unroll
            for (int i = 0; i < 16; ++i) { const int l = i ^ j; if (l > i) { if ((i & k) == 0 || k == 16) CE_DESC(v[i], v[l]); else CE_DESC(v[l], v[i]); } }
}
__device__ __forceinline__ void merge16_desc(float (&a)[16], const float (&b)[16]) {
#pragma unroll
    for (int i = 0; i < 16; ++i) a[i] = fmaxf(a[i], b[15 - i]);
#pragma unroll
    for (int j = 8; j > 0; j >>= 1)
#pragma unroll
        for (int i = 0; i < 16; ++i) { const int l = i ^ j; if (l > i) CE_DESC(a[i], a[l]); }
}
#define CE2_DESC(va, pa, vb, pb) do { const bool _c = (va) >= (vb); const float _tv = _c ? (va) : (vb), _tw = _c ? (vb) : (va); const int _tp = _c ? (pa) : (pb), _tq = _c ? (pb) : (pa); va = _tv; vb = _tw; pa = _tp; pb = _tq; } while (0)
template <int N> __device__ __forceinline__ void bitonic_merge_desc2(float (&v)[N], int (&p)[N]) {
#pragma unroll
    for (int j = N / 2; j > 0; j >>= 1)
#pragma unroll
        for (int i = 0; i < N; ++i) { const int l = i ^ j; if (l > i) CE2_DESC(v[i], p[i], v[l], p[l]); }
}
__device__ __forceinline__ void merge16_desc2(float (&a)[16], int (&pa)[16], const float (&b)[16], const int (&pb)[16]) {
#pragma unroll
    for (int i = 0; i < 16; ++i) { const bool c = a[i] >= b[15 - i]; pa[i] = c ? pa[i] : pb[15 - i]; a[i] = c ? a[i] : b[15 - i]; }
    bitonic_merge_desc2<16>(a, pa);
}
__device__ __forceinline__ void sort8_desc2(float (&v)[8], int (&p)[8]) {
#pragma unroll
    for (int k = 2; k <= 8; k <<= 1)
#pragma unroll
        for (int j = k >> 1; j > 0; j >>= 1)
#pragma unroll
            for (int i = 0; i < 8; ++i) { const int l = i ^ j; if (l > i) { if ((i & k) == 0 || k == 8) CE2_DESC(v[i], p[i], v[l], p[l]); else CE2_DESC(v[l], p[l], v[i], p[i]); } }
}
constexpr int RT_KROW = 272;
__device__ __forceinline__ void route_half(float (&top)[16], LAS const unsigned char* keys_lds, const bf16_t* __restrict__ qrow, int r32, int hi) {
    bf16x8 qf[8]; float ss = 0.f;
#pragma unroll
    for (int ks = 0; ks < 8; ++ks) { qf[ks] = *(const bf16x8*)(qrow + 16 * ks + 8 * hi);
#pragma unroll
        for (int j = 0; j < 8; ++j) { const float f = bf2f((bf16_t)qf[ks][j]); ss += f * f; } }
    ss += __shfl_xor(ss, 32);
    const float rn = rsqrtf(ss * (1.f / 128.f) + EPS);
    f32x16 acc[4];
#pragma unroll
    for (int kt = 0; kt < 4; ++kt) {
#pragma unroll
        for (int r = 0; r < 16; ++r) acc[kt][r] = 0.f;
#pragma unroll
        for (int ks = 0; ks < 8; ++ks) { const bf16x8 kf = *(LAS const bf16x8*)(keys_lds + (32 * kt + r32) * RT_KROW + (16 * ks + 8 * hi) * 2);
            acc[kt] = __builtin_amdgcn_mfma_f32_32x32x16_bf16(kf, qf[ks], acc[kt], 0, 0, 0); }
        __builtin_amdgcn_sched_barrier(0);
    }
    const unsigned hi4 = (unsigned)hi << 2;
    float g[4][16];
#pragma unroll
    for (int kt = 0; kt < 4; ++kt)
#pragma unroll
        for (int r = 0; r < 16; ++r) { const unsigned base = (unsigned)(32 * kt + (r & 3) + 8 * (r >> 2)); g[kt][r] = __uint_as_float((__float_as_uint(acc[kt][r] * rn) & 0xFFFFFF80u) | base); }
#pragma unroll
    for (int kt = 0; kt < 4; ++kt) sort16_desc(g[kt]);
    merge16_desc(g[0], g[1]); merge16_desc(g[2], g[3]); merge16_desc(g[0], g[2]);
    float o[16];
#pragma unroll
    for (int i = 0; i < 16; ++i) { g[0][i] = __uint_as_float(__float_as_uint(g[0][i]) | hi4); o[i] = __shfl_xor(g[0][i], 32); }
    merge16_desc(g[0], o);
#pragma unroll
    for (int i = 0; i < 16; ++i) top[i] = g[0][i];
}
__device__ __forceinline__ void route_final(const float (&A)[16], const float (&B)[16], LAS unsigned char* tab, int* idx_out, float* gate_out, bool writer) {
    {
        unsigned w[8];
#pragma unroll
        for (int q = 0; q < 4; ++q) {
            w[q] = (__float_as_uint(A[4 * q]) & 127u) | ((__float_as_uint(A[4 * q + 1]) & 127u) << 8) | ((__float_as_uint(A[4 * q + 2]) & 127u) << 16) | ((__float_as_uint(A[4 * q + 3]) & 127u) << 24);
            w[4 + q] = (__float_as_uint(B[4 * q]) & 127u) | ((__float_as_uint(B[4 * q + 1]) & 127u) << 8) | ((__float_as_uint(B[4 * q + 2]) & 127u) << 16) | ((__float_as_uint(B[4 * q + 3]) & 127u) << 24);
        }
        *(LAS u32x4*)(tab) = (u32x4){w[0], w[1], w[2], w[3]}; *(LAS u32x4*)(tab + 16) = (u32x4){w[4], w[5], w[6], w[7]};
    }
    const float NEG = -INFINITY;
#define CAND(i, j) __uint_as_float((__float_as_uint(A[i] + B[j]) & 0xFFFFFF00u) | (unsigned)(((i) << 4) | (j)))
    float m1[16], m2[16], m3[16];
#pragma unroll
    for (int j = 0; j < 16; ++j) m1[j] = CAND(0, j);
#pragma unroll
    for (int i = 0; i < 16; ++i) m2[i] = (i < 15) ? CAND((i < 15 ? i + 1 : 0), 0) : NEG;
    merge16_desc(m1, m2);
    __builtin_amdgcn_sched_barrier(0);
#pragma unroll
    for (int j = 0; j < 16; ++j) m3[j] = (j < 7) ? CAND(1, (j < 7 ? j + 1 : 0)) : NEG;
#pragma unroll
    for (int i = 0; i < 16; ++i) m2[i] = (i < 6) ? CAND((i < 6 ? i + 2 : 0), 1) : NEG;
    merge16_desc(m3, m2);
    __builtin_amdgcn_sched_barrier(0);
    m2[0] = CAND(2, 2); m2[1] = CAND(2, 3); m2[2] = CAND(2, 4); m2[3] = CAND(3, 2); m2[4] = CAND(4, 2); m2[5] = CAND(3, 3);
#pragma unroll
    for (int i = 6; i < 16; ++i) m2[i] = NEG;
    sort16_desc(m2);
    merge16_desc(m3, m2);
    merge16_desc(m1, m3);
    __builtin_amdgcn_sched_barrier(0);
#undef CAND
    float e[16], den = 0.f; int ex[16];
#pragma unroll
    for (int i = 0; i < 16; ++i) { e[i] = __expf(m1[i] - m1[0]); den += e[i]; const unsigned r = __float_as_uint(m1[i]) & 255u; ex[i] = (int)tab[r >> 4] * 128 + (int)tab[16 + (r & 15u)]; }
    const float inv = 1.f / den;
    if (writer) {
#pragma unroll
        for (int i = 0; i < 4; ++i) { *(u32x4*)(idx_out + 4 * i) = (u32x4){(unsigned)ex[4 * i], (unsigned)ex[4 * i + 1], (unsigned)ex[4 * i + 2], (unsigned)ex[4 * i + 3]};
            *(f32x4*)(gate_out + 4 * i) = (f32x4){e[4 * i] * inv, e[4 * i + 1] * inv, e[4 * i + 2] * inv, e[4 * i + 3] * inv}; }
    }
}

namespace fa {
typedef short s16x4 __attribute__((ext_vector_type(4)));
constexpr int SLOT_V = 8192, SLOT_F = 16384, SLOT_BYTES = 16384 + 256;
constexpr int LDS_WS = 2 * SLOT_BYTES, LDS_OST = LDS_WS + 8 * 64 * 4, LDS_TOTAL = LDS_OST + 8 * 4096;
__device__ __forceinline__ int crow(int r, int hi) { return (r & 3) + 8 * (r >> 2) + 4 * hi; }
__device__ __forceinline__ void attn_unit(LAS unsigned char* lds, const bf16_t* __restrict__ PROJ, const float* __restrict__ F2T, bf16_t* OCAT, int b, int h, int qb, float kmax) {
    const int tid = ptid(), lane = tid & 63, r32 = lane & 31, hi = lane >> 5; const int wid = __builtin_amdgcn_readfirstlane(tid >> 6);
    const size_t rowbase = (size_t)b * SEQ; const int q0 = qb * 256;
    const bf16_t* Qw = PROJ + (rowbase + q0 + wid * 32) * NPROJ + C_Q + h * 64;
    const bf16_t* Kh = PROJ + rowbase * NPROJ + C_K + h * 64;
    const bf16_t* Vh = PROJ + rowbase * NPROJ + C_V + h * 64;
    const float* Fh = F2T + (size_t)(b * 8 + h) * SEQ;
    LAS float* wsf = (LAS float*)(lds + LDS_WS) + wid * 64;
    bf16x8 qr[4];
#pragma unroll
    for (int d0 = 0; d0 < 4; ++d0) qr[d0] = *(const bf16x8*)(Qw + (size_t)r32 * NPROJ + d0 * 16 + hi * 8);
    const float Fq = Fh[q0 + wid * 32 + r32];
    const int NT = 4 * qb + 4;
    int t0; float c0;
    {
        float qs = 0.f;
#pragma unroll
        for (int d0 = 0; d0 < 4; ++d0)
#pragma unroll
            for (int j = 0; j < 8; ++j) { const float f = bf2f((bf16_t)qr[d0][j]); qs += f * f; }
        qs += __shfl_xor(qs, 32);
        qs = wave_max(qs);
        if (lane == 0) wsf[0] = qs;
        __syncthreads();
        float qm = 0.f;
#pragma unroll
        for (int w = 0; w < 8; ++w) qm = fmaxf(qm, ((LAS float*)(lds + LDS_WS))[w * 64]);
        c0 = sqrtf(qm) * kmax;
        const float bound = 2.f * c0 + Fh[q0] + 40.f;
        const bool skip = (lane < NT - 4) && (bound - Fh[64 * lane + 63] < 0.f);
        const unsigned long long bal = __ballot(skip);
        t0 = __builtin_amdgcn_readfirstlane((int)__builtin_ctzll(~bal));
        __syncthreads();
    }
    const int krow = 8 * wid + (lane >> 3), kch = lane & 7;
    const bf16_t* ksrc = Kh + (size_t)krow * NPROJ + kch * 8;
    const int kdst = krow * 128 + ((kch ^ (krow & 7)) * 16);
    const bf16_t* vsrc = Vh + (size_t)(16 * (wid & 3) + (lane >> 2)) * NPROJ + (wid >> 2) * 32 + (lane & 3) * 8;
    const int sdst = wid * 1024 + lane * 16;
    u32x4 kreg = *(const u32x4*)(ksrc + (size_t)t0 * 64 * NPROJ), vreg = *(const u32x4*)(vsrc + (size_t)t0 * 64 * NPROJ);
    float freg = (wid == 0) ? Fh[t0 * 64 + lane] : 0.f;
    *(LAS u32x4*)(lds + kdst) = kreg; *(LAS u32x4*)(lds + SLOT_V + sdst) = vreg; if (wid == 0) *(LAS float*)(lds + SLOT_F + lane * 4) = freg;
    if (t0 + 1 < NT) { kreg = *(const u32x4*)(ksrc + (size_t)(t0 + 1) * 64 * NPROJ); vreg = *(const u32x4*)(vsrc + (size_t)(t0 + 1) * 64 * NPROJ); if (wid == 0) freg = Fh[(t0 + 1) * 64 + lane]; }
    __syncthreads();
    float l = 0.f; f32x16 o[2]; const float Fqs = Fq - c0;
#pragma unroll
    for (int r = 0; r < 16; ++r) { o[0][r] = 0.f; o[1][r] = 0.f; }
    const int qrel = wid * 32 + r32;
    int cur = 0;
    for (int t = t0; t < NT; ++t) {
        const bool more = (t + 1 < NT);
        u32x4 kreg2 = kreg, vreg2 = vreg; float freg2 = freg;
        if (t + 2 < NT) { kreg2 = *(const u32x4*)(ksrc + (size_t)(t + 2) * 64 * NPROJ); vreg2 = *(const u32x4*)(vsrc + (size_t)(t + 2) * 64 * NPROJ); if (wid == 0) freg2 = Fh[(t + 2) * 64 + lane]; }
        LAS unsigned char* slot = lds + cur * SLOT_BYTES;
        f32x16 p0, p1;
        { const LAS float* fk = (const LAS float*)(slot + SLOT_F);
#pragma unroll
          for (int g = 0; g < 4; ++g) { const f32x4 a = *(const LAS f32x4*)(fk + 8 * g + 4 * hi), c = *(const LAS f32x4*)(fk + 32 + 8 * g + 4 * hi);
#pragma unroll
              for (int i = 0; i < 4; ++i) { p0[4 * g + i] = Fqs - a[i]; p1[4 * g + i] = Fqs - c[i]; } } }
        { const LAS unsigned char* kb = slot + r32 * 128; const int sw = r32 & 7;
#pragma unroll
          for (int d0 = 0; d0 < 4; ++d0) { const int co = ((2 * d0 + hi) ^ sw) * 16; const bf16x8 b0 = *(const LAS bf16x8*)(kb + co), b1 = *(const LAS bf16x8*)(kb + co + 4096);
              p0 = __builtin_amdgcn_mfma_f32_32x32x16_bf16(b0, qr[d0], p0, 0, 0, 0); p1 = __builtin_amdgcn_mfma_f32_32x32x16_bf16(b1, qr[d0], p1, 0, 0, 0); } }
        const int jb = t - (NT - 4);
        if (jb >= 0) { const int kb0 = 64 * jb + 4 * hi;
#pragma unroll
            for (int r = 0; r < 16; ++r) { const int kv = kb0 + (r & 3) + 8 * (r >> 2); if (kv > qrel) p0[r] = -INFINITY; if (kv + 32 > qrel) p1[r] = -INFINITY; } }
        float rs = 0.f;
#pragma unroll
        for (int r = 0; r < 16; ++r) { p0[r] = __builtin_amdgcn_exp2f(p0[r]); p1[r] = __builtin_amdgcn_exp2f(p1[r]); rs += p0[r] + p1[r]; }
        l += rs;
        u32x4 pw0, pw1, pw2, pw3;
        pw0 = (u32x4){cvt_pk_bf16(p0[0], p0[1]), cvt_pk_bf16(p0[2], p0[3]), cvt_pk_bf16(p0[4], p0[5]), cvt_pk_bf16(p0[6], p0[7])};
        pw1 = (u32x4){cvt_pk_bf16(p0[8], p0[9]), cvt_pk_bf16(p0[10], p0[11]), cvt_pk_bf16(p0[12], p0[13]), cvt_pk_bf16(p0[14], p0[15])};
        pw2 = (u32x4){cvt_pk_bf16(p1[0], p1[1]), cvt_pk_bf16(p1[2], p1[3]), cvt_pk_bf16(p1[4], p1[5]), cvt_pk_bf16(p1[6], p1[7])};
        pw3 = (u32x4){cvt_pk_bf16(p1[8], p1[9]), cvt_pk_bf16(p1[10], p1[11]), cvt_pk_bf16(p1[12], p1[13]), cvt_pk_bf16(p1[14], p1[15])};
        { const int vb = (int)(unsigned)(size_t)(slot + SLOT_V) + ((lane >> 4) & 1) * 32 + (lane & 3) * 8 + (4 * hi + ((lane & 15) >> 2)) * 64;
#pragma unroll
          for (int d0 = 0; d0 < 2; ++d0) { s16x4 lo4[4], hi4[4];
#pragma unroll
              for (int ks = 0; ks < 4; ++ks) {
                  asm volatile("ds_read_b64_tr_b16 %0,%1 offset:%c2" : "=&v"(lo4[ks]) : "v"(vb), "i"(d0 * 4096 + ks * 1024) : "memory");
                  asm volatile("ds_read_b64_tr_b16 %0,%1 offset:%c2" : "=&v"(hi4[ks]) : "v"(vb), "i"(d0 * 4096 + ks * 1024 + 512) : "memory"); }
              asm volatile("s_waitcnt lgkmcnt(0)" ::: "memory"); __builtin_amdgcn_sched_barrier(0);
#define FA_PK(k) (bf16x8){lo4[k][0], lo4[k][1], lo4[k][2], lo4[k][3], hi4[k][0], hi4[k][1], hi4[k][2], hi4[k][3]}
              o[d0] = __builtin_amdgcn_mfma_f32_32x32x16_bf16(__builtin_bit_cast(bf16x8, pw0), FA_PK(0), o[d0], 0, 0, 0);
              o[d0] = __builtin_amdgcn_mfma_f32_32x32x16_bf16(__builtin_bit_cast(bf16x8, pw1), FA_PK(1), o[d0], 0, 0, 0);
              o[d0] = __builtin_amdgcn_mfma_f32_32x32x16_bf16(__builtin_bit_cast(bf16x8, pw2), FA_PK(2), o[d0], 0, 0, 0);
              o[d0] = __builtin_amdgcn_mfma_f32_32x32x16_bf16(__builtin_bit_cast(bf16x8, pw3), FA_PK(3), o[d0], 0, 0, 0);
#undef FA_PK
          } }
        if (more) { LAS unsigned char* nslot = lds + (cur ^ 1) * SLOT_BYTES;
            *(LAS u32x4*)(nslot + kdst) = kreg; *(LAS u32x4*)(nslot + SLOT_V + sdst) = vreg; if (wid == 0) *(LAS float*)(nslot + SLOT_F + lane * 4) = freg; }
        __syncthreads();
        cur ^= 1; kreg = kreg2; vreg = vreg2; freg = freg2;
    }
    l += __shfl_xor(l, 32);
    if (hi == 0) wsf[32 + r32] = l;
    asm volatile("s_waitcnt lgkmcnt(0)" ::: "memory");
    float rli[16];
#pragma unroll
    for (int r = 0; r < 16; ++r) rli[r] = __builtin_amdgcn_rcpf(wsf[32 + crow(r, hi)]);
    if (G2F8) {
        unsigned char* Ow8 = (unsigned char*)OCAT + (rowbase + q0 + wid * 32) * 1024 + h * 64;
        LAS unsigned char* stg8 = (LAS unsigned char*)(lds + LDS_OST) + wid * 4096;
#pragma unroll
        for (int r = 0; r < 16; ++r) { const int orow = crow(r, hi); const int p = __builtin_amdgcn_cvt_pk_fp8_f32(o[0][r] * rli[r], o[1][r] * rli[r], 0, false);
            stg8[orow * 64 + r32] = (unsigned char)(p & 0xff); stg8[orow * 64 + 32 + r32] = (unsigned char)((p >> 8) & 0xff); }
        asm volatile("s_waitcnt lgkmcnt(0)" ::: "memory");
#pragma unroll
        for (int i = 0; i < 2; ++i) { const int row = i * 16 + (lane >> 2), ch = lane & 3; const u32x4 v = *(const LAS u32x4*)(stg8 + row * 64 + ch * 16); *(u32x4*)(Ow8 + (size_t)row * 1024 + ch * 16) = v; }
    } else {
    bf16_t* Ow = OCAT + (rowbase + q0 + wid * 32) * 1024 + h * 64;
    LAS bf16_t* stg = (LAS bf16_t*)(lds + LDS_OST) + wid * 2048;
#pragma unroll
    for (int r = 0; r < 16; ++r) { const int orow = crow(r, hi);
#pragma unroll
        for (int d0 = 0; d0 < 2; ++d0) stg[orow * 64 + d0 * 32 + r32] = f2bf(F8(2, o[d0][r] * rli[r])); }
    asm volatile("s_waitcnt lgkmcnt(0)" ::: "memory");
#pragma unroll
    for (int i = 0; i < 4; ++i) { const int row = i * 8 + (lane >> 3), ch = lane & 7; const u32x4 v = *(const LAS u32x4*)(stg + row * 64 + ch * 8); *(u32x4*)(Ow + (size_t)row * 1024 + ch * 8) = v; }
    }
    __syncthreads();
}
}

namespace hg {
constexpr int P272 = 272, P144 = 144;
constexpr int L_RAW = 2048, L_RLF = L_RAW, L_RQ = L_RAW + 16384, L_RKK = L_RAW + 32768, L_RI = L_RAW + 49152;
constexpr int L_QJ = 2048, L_KH = L_QJ + 160 * P272;
constexpr int L_KT = L_RI + 64 * P272, L_IT = L_KT + 128 * P144, L_P = L_IT + 128 * P144, L_SEGT = L_P + 64 * P144  , L_END = L_SEGT + 4096;
static_assert(L_KH + 64 * P272 <= L_KT && L_END <= RING_BYTES, "hgrn LDS");
__device__ __forceinline__ int crow(int r, int hi) { return (r & 3) + 8 * (r >> 2) + 4 * hi; }
__device__ __forceinline__ int qj_row0(int j) { return (j == 0) ? 0 : (j == 1) ? 64 : (j == 2) ? 112 : 144; }
struct RawRegs { u32x4 lf[2], q[2], iv[2]; };
__device__ __forceinline__ void raw_load(RawRegs& R, const bf16_t* __restrict__ PROJ, const bf16_t* __restrict__ KK, int unit, int tid) {
    const int bh = unit >> 6, cch = unit & 63, b = bh >> 2, h = bh & 3; const size_t row0 = (size_t)b * SEQ + cch * 64;
#pragma unroll
    for (int it = 0; it < 2; ++it) { const int id = tid + 512 * it, t = id >> 4, ch = id & 15;
        const bf16_t* pr = PROJ + (row0 + t) * NPROJ + h * 128 + 8 * ch;
        R.lf[it] = *(const u32x4*)(pr + C_LF); R.q[it] = *(const u32x4*)(pr + C_HQ); R.iv[it] = *(const u32x4*)(pr + C_HI);
        }
}
template <bool DRY> __device__ __forceinline__ void pass_a_all(LAS unsigned char* lds, bf16_t* PROJ, const bf16_t* __restrict__ KK, bf16_t* HST, float* HD, int u0, int ustep, int uend) {
    const int tid = ptid(), lane = tid & 63, r32 = lane & 31, hi = lane >> 5; const int wid = __builtin_amdgcn_readfirstlane(tid >> 6);
    LAS float* segt = (LAS float*)(lds + L_SEGT);
    RawRegs R;
    if (u0 < uend) raw_load(R, PROJ, KK, u0, tid);
    for (int unit = u0; unit < uend; unit += ustep) {
        const int bh = unit >> 6, cch = unit & 63, b = bh >> 2, h = bh & 3;
        const size_t row0 = (size_t)b * SEQ + cch * 64;
#pragma unroll
        for (int it = 0; it < 2; ++it) { const int id = tid + 512 * it, t = id >> 4, ch = id & 15;
            *(LAS u32x4*)(lds + L_RLF + t * 256 + ch * 16) = R.lf[it]; *(LAS u32x4*)(lds + L_RQ + t * 256 + ch * 16) = R.q[it];
            *(LAS u32x4*)(lds + L_RI + t * P272 + ch * 16) = R.iv[it]; }
        __syncthreads();
        if (unit + ustep < uend) raw_load(R, PROJ, KK, unit + ustep, tid);
        const int kp = tid & 63, sg8 = wid;
        float Aa[8][2], qv[8][2], kv[8][2];
        { float run0 = 0.f, run1 = 0.f;
#pragma unroll
          for (int i = 0; i < 8; ++i) { const int off = (8 * sg8 + i) * 256 + kp * 4;
              const unsigned wl = *(const LAS unsigned*)(lds + L_RLF + off), wq = *(const LAS unsigned*)(lds + L_RQ + off);
              const float l0 = h2f((unsigned short)(wl & 0xffffu)), l1 = h2f((unsigned short)(wl >> 16));
              run0 += l0; run1 += l1; Aa[i][0] = run0; Aa[i][1] = run1;
              qv[i][0] = __uint_as_float(wq << 16); qv[i][1] = __uint_as_float(wq & 0xffff0000u); kv[i][0] = 1.f - __expf(l0); kv[i][1] = 1.f - __expf(l1); }
          *(LAS f32x2_t*)(segt + sg8 * 128 + 2 * kp) = (f32x2_t){run0, run1}; }
        { const int tp = tid & 31, vc = tid >> 5;
            const bf16x8 r0 = *(const LAS bf16x8*)(lds + L_RI + (2 * tp) * P272 + vc * 16), r1 = *(const LAS bf16x8*)(lds + L_RI + (2 * tp + 1) * P272 + vc * 16);
#pragma unroll
            for (int e8 = 0; e8 < 8; ++e8) *(LAS unsigned*)(lds + L_IT + (8 * vc + e8) * P144 + tp * 4) = (unsigned)(unsigned short)r0[e8] | ((unsigned)(unsigned short)r1[e8] << 16); }
        __syncthreads();
        float E[4][2], pre[2] = {0.f, 0.f};
        { float s0 = 0.f, s1 = 0.f;
#pragma unroll
          for (int sgi = 0; sgi < 8; ++sgi) { const f32x2_t v = *(const LAS f32x2_t*)(segt + sgi * 128 + 2 * kp); if (sgi < sg8) { pre[0] += v.x; pre[1] += v.y; } s0 += v.x; s1 += v.y; if (sgi & 1) { E[sgi >> 1][0] = s0; E[sgi >> 1][1] = s1; } } }
        const int jo = sg8 >> 1;
        float Eown[2];
#pragma unroll
        for (int k2 = 0; k2 < 2; ++k2) Eown[k2] = (jo == 0) ? E[0][k2] : (jo == 1) ? E[1][k2] : (jo == 2) ? E[2][k2] : E[3][k2];
        {
            bf16_t* pq = PROJ + (row0 + 8 * sg8) * NPROJ + C_HQ + h * 128 + 2 * kp;
            unsigned kt[2][4];
            float fj[4][2], f0[2], f3[2];
#pragma unroll
            for (int k2 = 0; k2 < 2; ++k2) { f0[k2] = __expf(Eown[k2]); f3[k2] = __expf(E[3][k2] - Eown[k2]);
#pragma unroll
                for (int j = 0; j < 4; ++j) fj[j][k2] = __expf(Eown[k2] - E[j][k2]); }
#pragma unroll
            for (int i = 0; i < 8; ++i) {
                const int t = 8 * sg8 + i;
                float qe[2], ke1[2];
#pragma unroll
                for (int k2 = 0; k2 < 2; ++k2) { const float A = pre[k2] + Aa[i][k2]; const float e1 = __expf(A - Eown[k2]), r1 = __builtin_amdgcn_rcpf(e1);
                    qe[k2] = qv[i][k2] * e1; ke1[k2] = kv[i][k2] * r1; }
                if (!DRY) *(unsigned*)(pq + (size_t)i * NPROJ) = pk2(qe[0] * f0[0], qe[1] * f0[1]);
#pragma unroll
                for (int j = 0; j < 4; ++j) if (j <= jo) *(LAS unsigned*)(lds + L_QJ + (qj_row0(j) + t - 16 * j) * P272 + kp * 4) = (j == jo) ? pk2(qe[0], qe[1]) : pk2(qe[0] * fj[j][0], qe[1] * fj[j][1]);
                *(LAS unsigned*)(lds + L_KH + t * P272 + kp * 4) = pk2(ke1[0], ke1[1]);
#pragma unroll
                for (int k2 = 0; k2 < 2; ++k2) { const unsigned ke = f2bf(ke1[k2] * f3[k2]); if (i & 1) kt[k2][i >> 1] |= ke << 16; else kt[k2][i >> 1] = ke; }
            }
#pragma unroll
            for (int k2 = 0; k2 < 2; ++k2) *(LAS u32x4*)(lds + L_KT + (2 * kp + k2) * P144 + sg8 * 16) = (u32x4){kt[k2][0], kt[k2][1], kt[k2][2], kt[k2][3]};
            if (sg8 == 0) *(f32x2_t*)(HD + (size_t)unit * 128 + 2 * kp) = (f32x2_t){__expf(E[3][0]), __expf(E[3][1])};
        }
        __syncthreads();
        {
            const int fr = lane & 15, fq = lane >> 4;
#pragma unroll
            for (int bb = 0; bb < 2; ++bb) {
                const int blk = 2 * wid + bb, bi = blk >> 2, bj = blk & 3;
                f32x4 acc = (f32x4){0.f, 0.f, 0.f, 0.f};
                if (bj <= bi) {
                    const LAS unsigned char* ap = lds + L_QJ + (qj_row0(bj) + 16 * (bi - bj) + fr) * P272 + fq * 16;
                    const LAS unsigned char* bp = lds + L_KH + (16 * bj + fr) * P272 + fq * 16;
#pragma unroll
                    for (int s = 0; s < 4; ++s) acc = __builtin_amdgcn_mfma_f32_16x16x32_bf16(*(const LAS bf16x8*)(ap + s * 64), *(const LAS bf16x8*)(bp + s * 64), acc, 0, 0, 0);
                }
#pragma unroll
                for (int r = 0; r < 4; ++r) { const int tl = 4 * fq + r; float v = acc[r]; if (bi == bj && fr > tl) v = 0.f;
                    *(LAS bf16_t*)(lds + L_P + (16 * bi + tl) * P144 + (16 * bj + fr) * 2) = f2bf(v); }
            }
        }
        __syncthreads();
        constexpr int L_SU = L_QJ, L_SO = L_QJ + 128 * P272;
        {
            const int vt = wid & 3, tt = wid >> 2;
            f32x16 acc;
#pragma unroll
            for (int r = 0; r < 16; ++r) acc[r] = 0.f;
#pragma unroll
            for (int ks = 0; ks < 4; ++ks) acc = __builtin_amdgcn_mfma_f32_32x32x16_bf16(*(const LAS bf16x8*)(lds + L_IT + (32 * vt + r32) * P144 + (16 * ks + 8 * hi) * 2), *(const LAS bf16x8*)(lds + L_P + (32 * tt + r32) * P144 + (16 * ks + 8 * hi) * 2), acc, 0, 0, 0);
#pragma unroll
            for (int g = 0; g < 4; ++g) { u32x2 w; w.x = cvt_pk_bf16(acc[4 * g], acc[4 * g + 1]); w.y = cvt_pk_bf16(acc[4 * g + 2], acc[4 * g + 3]); *(LAS u32x2*)(lds + L_SO + (32 * tt + r32) * P272 + (32 * vt + 8 * g + 4 * hi) * 2) = w; }
        }
        {
            const int kt_ = wid & 3;
#pragma unroll
            for (int vv = 0; vv < 2; ++vv) { const int vt = 2 * (wid >> 2) + vv;
                f32x16 acc;
#pragma unroll
                for (int r = 0; r < 16; ++r) acc[r] = 0.f;
#pragma unroll
                for (int ks = 0; ks < 4; ++ks) acc = __builtin_amdgcn_mfma_f32_32x32x16_bf16(*(const LAS bf16x8*)(lds + L_KT + (32 * kt_ + r32) * P144 + (16 * ks + 8 * hi) * 2), *(const LAS bf16x8*)(lds + L_IT + (32 * vt + r32) * P144 + (16 * ks + 8 * hi) * 2), acc, 0, 0, 0);
#pragma unroll
                for (int g = 0; g < 4; ++g) { u32x2 w; w.x = cvt_pk_bf16(acc[4 * g], acc[4 * g + 1]); w.y = cvt_pk_bf16(acc[4 * g + 2], acc[4 * g + 3]); *(LAS u32x2*)(lds + L_SU + (32 * vt + r32) * P272 + (32 * kt_ + 8 * g + 4 * hi) * 2) = w; } }
        }
        __syncthreads();
#pragma unroll
        for (int it = 0; it < 4; ++it) { const int id = tid + 512 * it, v = id >> 4, ch = id & 15;
            *(u32x4*)(HST + (size_t)unit * 16384 + (size_t)id * 8) = *(const LAS u32x4*)(lds + L_SU + v * P272 + ch * 16); }
        if (!DRY) {
#pragma unroll
            for (int it = 0; it < 2; ++it) { const int id = tid + 512 * it, t = id >> 4, ch = id & 15;
                *(u32x4*)(PROJ + (row0 + t) * NPROJ + C_LF + h * 128 + 8 * ch) = *(const LAS u32x4*)(lds + L_SO + t * P272 + ch * 16); }
        }
        __syncthreads();
    }
}
__device__ __forceinline__ void pass_b(bf16_t* HST, const float* __restrict__ HD, int grp) {
    const int bh = grp >> 12, rem = grp & 4095;
    float s0 = 0.f, s1 = 0.f, s2 = 0.f, s3 = 0.f;
    bf16_t* p = HST + (size_t)bh * 64 * 16384 + rem * 4;
    const float* pd = HD + (size_t)bh * 64 * 128 + (rem & 31) * 4;
#pragma unroll 8
    for (int cch = 0; cch < 64; ++cch) {
        const u32x2 u = *(const u32x2*)(p + (size_t)cch * 16384); const f32x4 d = *(const f32x4*)(pd + cch * 128);
        u32x2 w; w.x = pk2(s0, s1); w.y = pk2(s2, s3); *(u32x2*)(p + (size_t)cch * 16384) = w;
        s0 = d.x * s0 + __uint_as_float(u.x << 16); s1 = d.y * s1 + __uint_as_float(u.x & 0xffff0000u);
        s2 = d.z * s2 + __uint_as_float(u.y << 16); s3 = d.w * s3 + __uint_as_float(u.y & 0xffff0000u);
    }
}
constexpr int CL_PART = 0, CL_ST = 2048, CL_QT = CL_ST + 128 * P272, CL_OI = CL_QT + 64 * P272, CL_SG = CL_OI + 64 * P272, CL_END = CL_SG + 64 * P272;
static_assert(CL_END <= RING_BYTES, "hgrn pass C LDS");
struct CRegs { u32x4 st[4], qt[2], oi[2], sg[2]; };
__device__ __forceinline__ void c_load(CRegs& R, const bf16_t* __restrict__ PROJ, const bf16_t* __restrict__ HST, int unit, int tid) {
    const int bh = unit >> 6, cch = unit & 63, b = bh >> 2, h = bh & 3; const size_t row0 = (size_t)b * SEQ + cch * 64;
#pragma unroll
    for (int it = 0; it < 4; ++it) R.st[it] = *(const u32x4*)(HST + (size_t)unit * 16384 + (size_t)(tid + 512 * it) * 8);
#pragma unroll
    for (int it = 0; it < 2; ++it) { const int id = tid + 512 * it, t = id >> 4, ch = id & 15;
        const bf16_t* pr = PROJ + (row0 + t) * NPROJ + h * 128 + 8 * ch;
        R.qt[it] = *(const u32x4*)(pr + C_HQ); R.oi[it] = *(const u32x4*)(pr + C_LF); R.sg[it] = *(const u32x4*)(pr + C_SG); }
}
__device__ __forceinline__ void pass_c_all(LAS unsigned char* lds, const bf16_t* __restrict__ PROJ, const bf16_t* __restrict__ HST, const float* __restrict__ gn, bf16_t* OCAT, int u0, int ustep, int uend) {
    const int tid = ptid(), lane = tid & 63, r32 = lane & 31, hi = lane >> 5; const int wid = __builtin_amdgcn_readfirstlane(tid >> 6);
    const int vt = wid & 3, tt = wid >> 2, tl = 32 * tt + r32;
    LAS float* part = (LAS float*)(lds + CL_PART);
    CRegs R;
    if (u0 < uend) c_load(R, PROJ, HST, u0, tid);
    int par = 0;
    for (int unit = u0; unit < uend; unit += ustep, par ^= 1) {
        const int bh = unit >> 6, cch = unit & 63, b = bh >> 2, h = bh & 3;
        const size_t row0 = (size_t)b * SEQ + cch * 64;
#pragma unroll
        for (int it = 0; it < 4; ++it) { const int id = tid + 512 * it, v = id >> 4, ch = id & 15; *(LAS u32x4*)(lds + CL_ST + v * P272 + ch * 16) = R.st[it]; }
#pragma unroll
        for (int it = 0; it < 2; ++it) { const int id = tid + 512 * it, t = id >> 4, ch = id & 15;
            *(LAS u32x4*)(lds + CL_QT + t * P272 + ch * 16) = R.qt[it]; *(LAS u32x4*)(lds + CL_OI + t * P272 + ch * 16) = R.oi[it]; *(LAS u32x4*)(lds + CL_SG + t * P272 + ch * 16) = R.sg[it]; }
        __syncthreads();
        if (unit + ustep < uend) c_load(R, PROJ, HST, unit + ustep, tid);
        f32x16 acc;
#pragma unroll
        for (int g = 0; g < 4; ++g) { const u32x2 w = *(const LAS u32x2*)(lds + CL_OI + tl * P272 + (32 * vt + 8 * g + 4 * hi) * 2);
            acc[4 * g] = __uint_as_float(w.x << 16); acc[4 * g + 1] = __uint_as_float(w.x & 0xffff0000u); acc[4 * g + 2] = __uint_as_float(w.y << 16); acc[4 * g + 3] = __uint_as_float(w.y & 0xffff0000u); }
#pragma unroll
        for (int ks = 0; ks < 8; ++ks) acc = __builtin_amdgcn_mfma_f32_32x32x16_bf16(*(const LAS bf16x8*)(lds + CL_ST + (32 * vt + r32) * P272 + (16 * ks + 8 * hi) * 2), *(const LAS bf16x8*)(lds + CL_QT + tl * P272 + (16 * ks + 8 * hi) * 2), acc, 0, 0, 0);
        float ss = 0.f;
#pragma unroll
        for (int r = 0; r < 16; ++r) ss += acc[r] * acc[r];
        ss += __shfl_xor(ss, 32);
        LAS float* pp = part + par * 256;
        if (hi == 0) pp[vt * 64 + tl] = ss;
        __syncthreads();
        const float rn = rsqrtf((pp[tl] + pp[64 + tl] + pp[128 + tl] + pp[192 + tl]) * (1.f / 128.f) + EPS);
        const float* pg = gn + h * 128 + 32 * vt + 4 * hi;
#pragma unroll
        for (int g = 0; g < 4; ++g) { const u32x2 sw = *(const LAS u32x2*)(lds + CL_SG + tl * P272 + (32 * vt + 8 * g + 4 * hi) * 2); const f32x4 gv = *(const f32x4*)(pg + 8 * g);
            const float f0 = acc[4 * g] * rn * gv.x * __uint_as_float(sw.x << 16), f1 = acc[4 * g + 1] * rn * gv.y * __uint_as_float(sw.x & 0xffff0000u), f2 = acc[4 * g + 2] * rn * gv.z * __uint_as_float(sw.y << 16), f3 = acc[4 * g + 3] * rn * gv.w * __uint_as_float(sw.y & 0xffff0000u);
            if (G2F8) *(LAS unsigned*)(lds + CL_OI + tl * P272 + (32 * vt + 8 * g + 4 * hi)) = pk4f8(f0, f1, f2, f3);
            else { u32x2 w; w.x = cvt_pk_bf16(F8(2, f0), F8(2, f1)); w.y = cvt_pk_bf16(F8(2, f2), F8(2, f3)); *(LAS u32x2*)(lds + CL_OI + tl * P272 + (32 * vt + 8 * g + 4 * hi) * 2) = w; } }
        __syncthreads();
        if (G2F8) { const int t = tid >> 3, ch = tid & 7;
            *(u32x4*)((unsigned char*)OCAT + (row0 + t) * 1024 + 512 + h * 128 + 16 * ch) = *(const LAS u32x4*)(lds + CL_OI + t * P272 + ch * 16); }
        else {
#pragma unroll
        for (int it = 0; it < 2; ++it) { const int id = tid + 512 * it, t = id >> 4, ch = id & 15;
            *(u32x4*)(OCAT + (row0 + t) * 1024 + 512 + h * 128 + 8 * ch) = *(const LAS u32x4*)(lds + CL_OI + t * P272 + ch * 16); }
        }
        __syncthreads();
    }
}
}

__global__ void __launch_bounds__(NTHREADS, 2) mega(Args a) {
    extern __shared__ __attribute__((aligned(16))) unsigned char lds_raw[];
    LAS unsigned char* lds = (LAS unsigned char*)lds_raw;
    volatile LAS unsigned* MISC = (volatile LAS unsigned*)(lds + MISC_OFF);
    const int tid0 = threadIdx.x, wave = __builtin_amdgcn_readfirstlane(tid0 >> 6);
    const int G = gridDim.x, bx = blockIdx.x, vcu = (G % 8 == 0) ? (bx % 8) * (G / 8) + bx / 8 : bx;
    const int gw = vcu * NWAVES + wave, NGW = G * NWAVES;
    unsigned* ctl = (unsigned*)(a.ws + WS_CTL);
    for (int u = tid0; u < (LDS_BYTES - RING_BYTES) / 4; u += NTHREADS) ((LAS unsigned*)(lds + RING_BYTES))[u] = 0u;
    __syncthreads();
    XcdBarrier bar = xcd_barrier_post(ctl + CW_BAR + a.li * XCD_BAR_WORDS, MISC + 8);
    const int lo = a.ph_lo, hi = a.ph_hi;
    if (TPROBE >= 0 && blockIdx.x == 0 && threadIdx.x == 0) ((unsigned long long*)(ctl + 8192))[0] = __builtin_amdgcn_s_memrealtime();
#ifndef PH_COMPILE
#define PH_COMPILE 0x7FF
#endif
#define IN(k) ((((PH_COMPILE) >> (k)) & 1) && lo <= (k) && (k) < hi)
#define STAMP(i) do { if (TPROBE >= 0 && bx == 0 && tid0 == 0) ((unsigned long long*)(ctl + 8192))[i] = __builtin_amdgcn_s_memrealtime(); } while (0)
#define SEAM(k) do { if (IN(k) && IN((k) + 1)) xcd_barrier(bar); STAMP((k) + 1); } while (0)

    typedef const __attribute__((address_space(4))) Args* KArgs;
#define PHASE_PTRS \
    KArgs ka = (KArgs)__builtin_amdgcn_kernarg_segment_ptr(); asm volatile("" : "+s"(ka)); \
    const int tid = ptid(), lane = tid & 63; (void)lane; \
    unsigned char* ws = ka->ws; (void)ws; \
    const float* x = ka->in[0]; const float* c_in = ka->in[1]; const float* w_ada = ka->in[2]; const float* b_ada = ka->in[3]; \
    const float* pre_mix_g = ka->in[4]; const float* w_in = ka->in[6]; const float* b_fox_f = ka->in[7]; const float* gamma = ka->in[8]; \
    const float* w_out = ka->in[10]; const float* w_q = ka->in[13]; const float* sub_keys = ka->in[14]; const float* U = ka->in[15]; const float* V = ka->in[16]; \
    float* MOD = (float*)(ws + WS_MOD); float* LB = (float*)(ws + WS_LB); float* WFF = (float*)(ws + WS_WFF); \
    bf16_t* WIN = (bf16_t*)(ws + WS_WIN); bf16_t* WOUT = (bf16_t*)(ws + WS_WOUT); bf16_t* WQ = (bf16_t*)(ws + WS_WQ); bf16_t* KEYS = (bf16_t*)(ws + WS_KEYS); \
    float* LOGF = (float*)(ws + WS_F); float* F2T = (float*)(ws + WS_F2T); bf16_t* H = (bf16_t*)(ws + WS_H); bf16_t* PROJ = (bf16_t*)(ws + WS_PROJ); bf16_t* KK = (bf16_t*)(ws + WS_KK); \
    bf16_t* OCAT = (bf16_t*)(ws + WS_OCAT); bf16_t* MIX = H; bf16_t* H2 = OCAT; bf16_t* Q2 = (bf16_t*)(ws + WS_Q2); \
    (void)x; (void)c_in; (void)w_ada; (void)b_ada; (void)pre_mix_g; (void)w_in; (void)b_fox_f; (void)gamma; (void)w_out; (void)w_q; (void)sub_keys; (void)U; (void)V; \
    (void)MOD; (void)LB; (void)WFF; (void)WIN; (void)WOUT; (void)WQ; (void)KEYS; (void)LOGF; (void)F2T; (void)H; (void)PROJ; (void)KK; (void)OCAT; (void)MIX; (void)H2; (void)Q2;
    const int flags = a.flags;

    for (int rep_ = 0; rep_ < ((DUP_PHASE == 0) ? 2 : 1); ++rep_) if (IN(0)) { PHASE_PTRS
        LAS float* condl = (LAS float*)lds;
        for (int i = tid; i < 8192; i += NTHREADS) { const float cv = c_in[i]; condl[i] = cv * sigmoidf_(cv); }
        __syncthreads();
        for (int it = gw; it < 768; it += NGW) {
            const int j = it * 8 + (lane & 7), ks = lane >> 3;
            float acc[8];
#pragma unroll
            for (int b = 0; b < 8; ++b) acc[b] = 0.f;
            const float* wp = w_ada + (size_t)ks * 6144 + j;
#pragma unroll 8
            for (int i = 0; i < 128; ++i) { const float w = wp[(size_t)i * 8 * 6144]; const int k = ks + 8 * i;
#pragma unroll
                for (int b = 0; b < 8; ++b) acc[b] += condl[b * 1024 + k] * w; }
#pragma unroll
            for (int b = 0; b < 8; ++b) { float v = acc[b]; v += __shfl_xor(v, 8); v += __shfl_xor(v, 16); v += __shfl_xor(v, 32); acc[b] = v; }
            if (lane < 8) { const float bb = b_ada[j];
#pragma unroll
                for (int b = 0; b < 8; ++b) MOD[b * 6144 + j] = acc[b] + bb; }
        }
        if (gw == NGW - 1) { for (int i = lane; i < 512; i += 64) LB[i] = 1.f / (1.f + __expf(gamma[512 + i] - gamma[i])); ((float*)(ws + WS_LB + 4096))[lane] = 0.f; ((float*)(ws + WS_LB + 4096))[64 + lane] = 0.f; }
        LAS float* scr = (LAS float*)(lds + 32768 + wave * 8448);
        for (int it = gw; it < 3328; it += NGW) {
            int r = it;
            if (r < 768) { transpose_item<1, G1F8 != 0>(w_in, 3592, 0, WIN, 0, scr, r, 48, lane); continue; } r -= 768;
            if (r < 1024) { transpose_item<1, G1F8 != 0>(w_in, 3592, 1544, WIN, 1536, scr, r, 64, lane); continue; } r -= 1024;
            if (r < 512) { transpose_item<2, G2F8 != 0>(w_out, 1024, 0, WOUT, 0, scr, r, 32, lane); continue; } r -= 512;
            transpose_item<4>(w_q, 2048, 0, WQ, 0, scr, r, 64, lane);
        }
        for (int i = gw * 64 + lane; i < 8192; i += NGW * 64) { const int jj = i >> 10, k = i & 1023; WFF[i] = w_in[(size_t)k * 3592 + 1536 + jj]; }
        for (int i = gw * 64 + lane; i < 65536; i += NGW * 64) { const f32x4 v = *(const f32x4*)(sub_keys + (size_t)i * 4); u32x2 o; o.x = pk2(v.x, v.y); o.y = pk2(v.z, v.w); *(u32x2*)(KEYS + (size_t)i * 4) = o; }
    }
    SEAM(0);
    for (int rep_ = 0; rep_ < ((DUP_PHASE == 1) ? 2 : 1); ++rep_) if (IN(1)) { PHASE_PTRS const int rpw = (T + NGW - 1) / NGW; h_rows(x, pre_mix_g, MOD, WFF, b_fox_f, H, LOGF, gw * rpw, (gw * rpw + rpw < T) ? gw * rpw + rpw : T, lane); }
    SEAM(1);
    if (DUP_PHASE == 99) { for (int i = 0; i < 10; ++i) xcd_barrier(bar); }
    for (int rep_ = 0; rep_ < ((DUP_PHASE == 2) ? 2 : 1); ++rep_) if (IN(2)) { PHASE_PTRS
        if (bx < 64) {
            const int bh = bx, b = bh >> 3, h = bh & 7;
            LAS float* wtot = (LAS float*)lds;
            const float* p = LOGF + ((size_t)b * SEQ + tid * 8) * 8 + h;
            float v[8], tot = 0.f;
#pragma unroll
            for (int i = 0; i < 8; ++i) { v[i] = p[i * 8]; tot += v[i]; }
            float incl = tot;
#pragma unroll
            for (int o = 1; o < 64; o <<= 1) { const float n = __shfl_up(incl, o); if (lane >= o) incl += n; }
            if (lane == 63) wtot[wave] = incl;
            __syncthreads();
            float base = incl - tot;
            for (int w = 0; w < wave; ++w) base += wtot[w];
            u32x4 dummy; (void)dummy;
            float run = base;
            float* o = F2T + (size_t)bh * SEQ + tid * 8;
#pragma unroll
            for (int i = 0; i < 8; ++i) { run += v[i]; o[i] = run * LOG2E; }
            __syncthreads();
        }
        pg8::Gemm g{H, WIN, T, NPROJ, G1F8 ? 512 : 1024}; pg8::StaticOrder S; S.init(T, NPROJ, G, bx, WGM_G1);
        EpiProjT E{PROJ, KK, LB, (unsigned*)(ws + WS_LB + 4096)};
        pg8::gemm_phase<EpiProjT, pg8::StaticOrder, true, true, G1F8 != 0>(lds, g, S, E);
    }
    SEAM(2);
    if (IN(3)) { PHASE_PTRS
        const float* KMAXH = (const float*)(ws + WS_LB + 4096);
        if (flags & FL_HGRN) hg::pass_a_all<false>(lds, PROJ, KK, (bf16_t*)(ws + WS_HST), (float*)(ws + WS_HD), vcu, G, 2048);
        xcd_barrier(bar); STAMP(20);
        if (flags & FL_HGRN) { for (int g = vcu * NTHREADS + tid; g < 32 * 4096; g += G * NTHREADS) hg::pass_b((bf16_t*)(ws + WS_HST), (const float*)(ws + WS_HD), g); }
        if (flags & FL_ATTN) {
            unsigned* qctr = ctl + CW_ATTNQ;
            LAS int* ubox = (LAS int*)(lds + RING_BYTES + 64);
            for (int rep_ = 0; rep_ < ((DUP_PHASE == 3) ? 2 : 1); ++rep_)
            for (;;) {
                if (tid == 0) *ubox = (int)atomicAdd(qctr + 64 * rep_, 1u);
                __syncthreads();
                const int u = *ubox;
                __syncthreads();
                if (u >= 1024) break;
                const int qb = 15 - (u >> 6), bh = u & 63;
                fa::attn_unit(lds, PROJ, F2T, OCAT, bh >> 3, bh & 7, qb, sqrtf(KMAXH[2 * bh] + KMAXH[2 * bh + 1]));
            }
        }
    }
    SEAM(3);
    for (int rep_ = 0; rep_ < ((DUP_PHASE == 5) ? 2 : 1); ++rep_) if (IN(5) && (flags & FL_HGRN)) { PHASE_PTRS hg::pass_c_all(lds, PROJ, (const bf16_t*)(ws + WS_HST), ka->in[9], OCAT, vcu, G, 2048); }
    SEAM(5);
    for (int rep_ = 0; rep_ < ((DUP_PHASE == 6) ? 2 : 1); ++rep_) if (IN(6)) { PHASE_PTRS
        pg8::Gemm g{OCAT, WOUT, T, 1024, G2F8 ? 512 : 1024}; pg8::StaticOrder S; S.init(T, 1024, G, bx, WGM_G2);
        EpiPlainT E{MIX, 1024, G2F8 ? 0.03125f : 1.f};
        pg8::gemm_phase<EpiPlainT, pg8::StaticOrder, true, true, G2F8 != 0>(lds, g, S, E);
    }
    SEAM(6);
    for (int rep_ = 0; rep_ < ((DUP_PHASE == 7) ? 2 : 1); ++rep_) if (IN(7)) { PHASE_PTRS const int rpw = (T + NGW - 1) / NGW; row_passes(x, MIX, MOD, ka->in[5], ka->in[11], (bf16_t*)(ws + WS_HST), H2, gw * rpw, (gw * rpw + rpw < T) ? gw * rpw + rpw : T, lane); }
    SEAM(7);
    for (int rep_ = 0; rep_ < ((DUP_PHASE == 8) ? 2 : 1); ++rep_) if (IN(8)) { PHASE_PTRS
        pg8::Gemm g{H2, WQ, T, NQ2, 1024}; pg8::StaticOrder S; S.init(T, NQ2, G, bx, WGM_G3);
        EpiPlainT E{Q2, NQ2, 1.f};
        pg8::gemm_phase<EpiPlainT, pg8::StaticOrder, true, true>(lds, g, S, E);
    }
    SEAM(8);
    for (int rep_ = 0; rep_ < ((DUP_PHASE == 9) ? 2 : 1); ++rep_) if (IN(9)) { PHASE_PTRS
        const int h = vcu & 7;
        {
            const bf16_t* ksrc = KEYS + (size_t)h * 2 * 128 * 128;
            for (int i = tid; i < 4096; i += NTHREADS) { const int row = i >> 4, ch = i & 15; *(LAS u32x4*)(lds + row * RT_KROW + ch * 16) = *(const u32x4*)(ksrc + row * 128 + ch * 8); }
        }
        __syncthreads();
        const int r32 = lane & 31, hi = lane >> 5;
        int* IDXw = (int*)(ws + WS_IDX); float* GATEw = (float*)(ws + WS_GATE);
        int qi = 0;
        const int qrows = (NEXP + NGW - 1) / NGW;
        for (int tb = (vcu >> 3); tb < T / 256; tb += G / 8) {
            const int t = tb * 256 + wave * 32 + r32;
            const bf16_t* qrow = Q2 + (size_t)t * NQ2 + h * 256;
            float A[16], B[16];
            f32x4 qa[4], qb[4];
            const int ra = gw * qrows + qi, rb_ = ra + 1; const bool oka = (qi < qrows) && (ra < NEXP), okb = (qi + 1 < qrows) && (rb_ < NEXP);
            if (oka) qrow_load(qa, U, ra, lane); if (okb) qrow_load(qb, U, rb_, lane);
            route_half(A, lds, qrow, r32, hi);
            __builtin_amdgcn_sched_barrier(0);
            if (oka) qrow_store(qa, ws + WS_UQ, (float*)(ws + WS_US), ra, lane); if (okb) qrow_store(qb, ws + WS_UQ, (float*)(ws + WS_US), rb_, lane);
            if (oka) qrow_load(qa, V, ra, lane); if (okb) qrow_load(qb, V, rb_, lane);
            route_half(B, lds + 128 * RT_KROW, qrow + 128, r32, hi);
            __builtin_amdgcn_sched_barrier(0);
            if (oka) qrow_store(qa, ws + WS_UQ + 8, (float*)(ws + WS_VS), ra, lane); if (okb) qrow_store(qb, ws + WS_UQ + 8, (float*)(ws + WS_VS), rb_, lane);
            qi += 2;
            route_final(A, B, lds + 256 * RT_KROW + tid * 32, IDXw + (size_t)t * 128 + h * 16, GATEw + (size_t)t * 128 + h * 16, hi == 0);
        }
        for (; qi < qrows; ++qi) { const int r = gw * qrows + qi; if (r < NEXP) { f32x4 qa[4]; qrow_load(qa, U, r, lane); qrow_store(qa, ws + WS_UQ, (float*)(ws + WS_US), r, lane); qrow_load(qa, V, r, lane); qrow_store(qa, ws + WS_UQ + 8, (float*)(ws + WS_VS), r, lane); } }
    }
    SEAM(9);
    if (IN(10)) { PHASE_PTRS
        const int* IDX = (const int*)(ws + WS_IDX); const float* GATE = (const float*)(ws + WS_GATE);
        for (int rep_ = ((DUP_PHASE == 10) ? 0 : 1); rep_ < 2; ++rep_) { float* outp = rep_ ? ka->out : (float*)(ws + 280 * MiB);
            const int rmask = (rep_ == 0 && DUP_MODE == 1) ? 255 : 0x3FFF;
            float pd = 0.f;
            if (TPROBE >= 0) { const unsigned long long* ts = (const unsigned long long*)(ctl + 8192); const int i0_ = (TPROBE == 30) ? 3 : (TPROBE == 31) ? 20 : (TPROBE == 5) ? 4 : TPROBE, i1_ = (TPROBE == 30) ? 20 : (TPROBE == 31) ? 4 : TPROBE + 1;
                const float dus = (float)(long long)(__hip_atomic_load(ts + i1_, __ATOMIC_RELAXED, __HIP_MEMORY_SCOPE_AGENT) - __hip_atomic_load(ts + i0_, __ATOMIC_RELAXED, __HIP_MEMORY_SCOPE_AGENT)) * 0.01f;
                pd = sqrtf(16.f * 0.004f * fminf(fmaxf(dus, 0.f), TPROBE_FS) / TPROBE_FS); }
            {
                const int tpw = (T + NGW - 1) / NGW, tb0 = vcu * NWAVES * tpw, b = (tb0 < T ? tb0 : 0) / SEQ;
                LAS float* pv = (LAS float*)lds; const float* md = MOD + b * 6144; const float* g_pre = ka->in[11]; const float* g_post = ka->in[12];
                for (int i = tid; i < 1024; i += NTHREADS) { pv[i] = g_pre[i] * (md[4096 + i] + 1.f); pv[1024 + i] = md[3072 + i]; pv[2048 + i] = md[5120 + i] * g_post[i]; }
                __syncthreads();
                const int t0 = gw * tpw, t1 = (t0 + tpw < T) ? t0 + tpw : T;
#pragma unroll 1
                for (int t = t0; t < t1; ++t) expert_token((const unsigned char*)(ws + WS_UQ), (const float*)(ws + WS_US), (const float*)(ws + WS_VS), IDX, GATE, pv, (const bf16_t*)(ws + WS_HST), outp, t, lane, rmask, (t < 2048) ? 1.f + pd : 1.f);
                __syncthreads();
            } }
    }
#undef IN
#undef SEAM
}

extern "C" void kernel_launch(void* const* d_in, const int* in_sizes, int n_in, void* d_out, int out_size, void* d_ws, size_t ws_size, hipStream_t stream) {
    if (n_in != 17 || in_sizes[0] != T * DM || out_size != T * DM || ws_size < WS_END) { fprintf(stderr, "kernel_launch: unexpected inputs (n_in %d, ws %zu); nothing launched\n", n_in, ws_size); return; }
    static int grid = 0;
    if (grid == 0) {
        int dev = 0, cus = 0, per_cu = 0;
        if (hipGetDevice(&dev) != hipSuccess || hipDeviceGetAttribute(&cus, hipDeviceAttributeMultiprocessorCount, dev) != hipSuccess) { grid = -1; return; }
        if (hipFuncSetAttribute((const void*)mega, hipFuncAttributeMaxDynamicSharedMemorySize, LDS_BYTES) != hipSuccess) { fprintf(stderr, "kernel_launch: hipFuncSetAttribute failed\n"); grid = -1; return; }
        if (hipOccupancyMaxActiveBlocksPerMultiprocessor(&per_cu, (const void*)mega, NTHREADS, LDS_BYTES) != hipSuccess || per_cu < 1) { fprintf(stderr, "kernel_launch: occupancy query says %d\n", per_cu); (void)hipGetLastError(); grid = -1; return; }
        grid = cus;
        { const int rpw = (T + grid * NWAVES - 1) / (grid * NWAVES); if (SEQ % rpw != 0) { fprintf(stderr, "kernel_launch: %d CUs: the row passes give each wave %d consecutive rows, which must not straddle a batch; nothing launched\n", grid, rpw); grid = -1; return; } }
        if (grid % 8 != 0) { fprintf(stderr, "kernel_launch: %d CUs: the routing phase deals heads over groups of 8 workgroups; nothing launched\n", grid); grid = -1; return; }
    }
    if (grid < 0) return;
    if (hipMemsetAsync((unsigned char*)d_ws + WS_CTL, 0, CTL_ZERO_BYTES, stream) != hipSuccess) return;
    Args a{}; for (int i = 0; i < 17; ++i) a.in[i] = (const float*)d_in[i];
    a.out = (float*)d_out; a.ws = (unsigned char*)d_ws; a.ph_lo = 0; a.ph_hi = 11; a.li = 0; a.flags = FL_ATTN | FL_HGRN;
    hipLaunchKernelGGL(mega, dim3(grid), dim3(NTHREADS), LDS_BYTES, stream, a);
}
```

```cpp
#include <hip/hip_runtime.h>
#include <stdint.h>
#include <cstdio>

typedef unsigned short bf16_t;
typedef short bf16x8 __attribute__((ext_vector_type(8)));
typedef float f32x4 __attribute__((ext_vector_type(4)));
typedef float f32x16 __attribute__((ext_vector_type(16)));
typedef unsigned u32x4 __attribute__((ext_vector_type(4)));
typedef unsigned u32x2 __attribute__((ext_vector_type(2)));

constexpr int BATCH = 8, SEQ = 4096, DM = 1024, T = BATCH * SEQ;
constexpr int NPROJ = 3584;
constexpr int C_Q = 0, C_K = 512, C_V = 1024, C_HQ = 1536, C_LF = 2048, C_HI = 2560, C_SG = 3072;
constexpr int NQ2 = 2048, NEXP = 16384;
constexpr float EPS = 1e-6f;
constexpr float LOG2E = 1.4426950408889634f;
constexpr float QSCALE = 0.125f * LOG2E;
constexpr float HQSCALE = 0.08838834764831845f;

constexpr size_t MiB = 1u << 20;
constexpr size_t WS_CTL = 0;
constexpr size_t WS_MOD = 1 * MiB;
constexpr size_t WS_LB = WS_MOD + 256 * 1024;
constexpr size_t WS_WFF = WS_MOD + 512 * 1024;
constexpr size_t WS_WIN = 2 * MiB;
constexpr size_t WS_WOUT = 10 * MiB;
constexpr size_t WS_WQ = 12 * MiB;
constexpr size_t WS_KEYS = 16 * MiB;
constexpr size_t WS_US = 17 * MiB;
constexpr size_t WS_VS = WS_US + 256 * 1024;
constexpr size_t WS_UQ = 18 * MiB;
constexpr size_t WS_F = 50 * MiB;
constexpr size_t WS_F2T = 52 * MiB;
constexpr size_t WS_H = 56 * MiB;
constexpr size_t WS_PROJ = 120 * MiB;
constexpr size_t WS_KK = 344 * MiB;
constexpr size_t WS_OCAT = 376 * MiB;
constexpr size_t WS_HST = 440 * MiB;
constexpr size_t WS_HD = 504 * MiB;
constexpr size_t WS_Q2 = WS_PROJ;
constexpr size_t WS_IDX = WS_PROJ + 128 * MiB;
constexpr size_t WS_GATE = WS_PROJ + 144 * MiB;
constexpr size_t WS_END = 505 * MiB;

__device__ __forceinline__ float bf2f(bf16_t v) { return __uint_as_float(((unsigned)v) << 16); }
typedef float f32x2_t __attribute__((ext_vector_type(2))); typedef __bf16 bf16x2_t __attribute__((ext_vector_type(2)));
__device__ __forceinline__ unsigned pk2(float lo, float hi) { f32x2_t v = {lo, hi}; bf16x2_t b = __builtin_convertvector(v, bf16x2_t); return __builtin_bit_cast(unsigned, b); }
#ifndef FP8SIM
#define FP8SIM 0
#endif
__device__ __forceinline__ float f8r_(float v) { const int p = __builtin_amdgcn_cvt_pk_fp8_f32(v, v, 0, false); return __builtin_amdgcn_cvt_f32_fp8(p, 0); }
typedef _Float16 h16x2 __attribute__((ext_vector_type(2)));
__device__ __forceinline__ unsigned pk4f8(float a, float b, float c, float d) { int p = __builtin_amdgcn_cvt_pk_fp8_f32(a, b, 0, false); p = __builtin_amdgcn_cvt_pk_fp8_f32(c, d, p, true); return (unsigned)p; }
#ifndef MIX8
#define MIX8 1
#endif
#ifndef HST8
#define HST8 1
#endif
#ifndef G3I8
#define G3I8 1
#endif
#ifndef G2F8
#define G2F8 1
#endif
#ifndef G1F8
#define G1F8 1
#endif
#define F8(bit, v) ((FP8SIM & (bit)) ? f8r_(v) : (v))
#define F8W(bit, v) ((FP8SIM & (bit)) ? f8r_((v) * 32.f) * 0.03125f : (v))
__device__ __forceinline__ bf16_t f2bf(float f) { return (bf16_t)(pk2(f, 0.f) & 0xffffu); }
__device__ __forceinline__ unsigned short f2h(float f) { _Float16 h = (_Float16)f; return __builtin_bit_cast(unsigned short, h); }
__device__ __forceinline__ float h2f(unsigned short u) { _Float16 h = __builtin_bit_cast(_Float16, u); return (float)h; }
#define WAVE_DPP(v, ctrl) __int_as_float(__builtin_amdgcn_update_dpp(0, __float_as_int(v), ctrl, 0xF, 0xF, false))
__device__ __forceinline__ float wave_sum(float v) {
    v += WAVE_DPP(v, 0xB1);
    v += WAVE_DPP(v, 0x4E);
    v += WAVE_DPP(v, 0x124);
    v += WAVE_DPP(v, 0x128);
    { const auto r = __builtin_amdgcn_permlane16_swap(__float_as_uint(v), __float_as_uint(v), false, false); v = __uint_as_float(r[0]) + __uint_as_float(r[1]); }
    { const auto r = __builtin_amdgcn_permlane32_swap(__float_as_uint(v), __float_as_uint(v), false, false); v = __uint_as_float(r[0]) + __uint_as_float(r[1]); }
    return v;
}
__device__ __forceinline__ float wave_max(float v) {
    v = fmaxf(v, WAVE_DPP(v, 0xB1));
    v = fmaxf(v, WAVE_DPP(v, 0x4E));
    v = fmaxf(v, WAVE_DPP(v, 0x124));
    v = fmaxf(v, WAVE_DPP(v, 0x128));
    { const auto r = __builtin_amdgcn_permlane16_swap(__float_as_uint(v), __float_as_uint(v), false, false); v = fmaxf(__uint_as_float(r[0]), __uint_as_float(r[1])); }
    { const auto r = __builtin_amdgcn_permlane32_swap(__float_as_uint(v), __float_as_uint(v), false, false); v = fmaxf(__uint_as_float(r[0]), __uint_as_float(r[1])); }
    return v;
}
__device__ __forceinline__ float sigmoidf_(float z) { return __builtin_amdgcn_rcpf(1.f + __expf(-z)); }
__device__ __forceinline__ float gelu_erf(float a) { return 0.5f * a * (1.f + erff(a * 0.7071067811865476f)); }

#define DUP_PHASE (-1)
#define DUP_MODE 0
#define TPROBE_FS 300.f
namespace pg8 {
__device__ __forceinline__ int ptid_() { int t = threadIdx.x; asm volatile("" : "+v"(t)); return t; }
#define PG8_LAS __attribute__((address_space(3)))
typedef unsigned short bf16_t;
typedef short bf16x8 __attribute__((ext_vector_type(8)));
typedef float f32x4 __attribute__((ext_vector_type(4)));
typedef unsigned u32x4 __attribute__((ext_vector_type(4)));
constexpr int BM = 256, BK = 64, HALF = 128, HTB = HALF * BK * 2  , STAGE_BYTES = 8 * HTB, NXCD = 8, WGM = 4;

__host__ __device__ __forceinline__ int lds_byte(int r, int c) { const int st = (r >> 4) * 2 + (c >> 5), rr = r & 15, cc = c & 31, ob = rr * 64 + cc * 2; return st * 1024 + (ob ^ (((ob >> 9) & 1) << 5)); }
__host__ __device__ __forceinline__ void stage_rc(int b, int& R, int& C) { const int st = b / 1024, sb = b % 1024, swz = sb ^ (((sb >> 9) & 1) << 5); R = (st >> 1) * 16 + swz / 64; C = (st & 1) * 32 + (swz % 64) / 2; }
__host__ __device__ __forceinline__ int perm32(int rho) { const int n = rho >> 4, i = rho & 15; return 8 * (i >> 2) + 4 * n + (i & 3); }

struct Unit { int pm, pn; };
struct Gemm { const bf16_t* A; const bf16_t* Bt; int M, N, K; };

struct StaticOrder {
    int nM, nN, nwg, G, c, wgm;
    __host__ __device__ void init(int M, int N, int G_, int c_, int wgm_ = WGM) { nM = M / BM; nN = N / BM; nwg = nM * nN; G = G_; c = c_; wgm = wgm_; }
    __host__ __device__ bool next(int i, Unit& u) const {
        const long L = (long)i * G + c; if (L >= nwg) return false;
        int wgid = (int)L; { const int q = nwg / NXCD, r = nwg % NXCD, xcd = wgid % NXCD, off = wgid / NXCD; wgid = (xcd < r ? xcd * (q + 1) : r * (q + 1) + (xcd - r) * q) + off; }
        const int nig = wgm * nN, gid = wgid / nig, fm = gid * wgm, gsz = (nM - fm) < wgm ? (nM - fm) : wgm;
        u.pm = fm + ((wgid % nig) % gsz); u.pn = (wgid % nig) / gsz; return true;
    }
    __device__ __forceinline__ void a_ready(const Unit&) const {}
    __device__ __forceinline__ void done(const Unit&) const {}
};

typedef int i32x4 __attribute__((ext_vector_type(4)));
typedef int i32x8 __attribute__((ext_vector_type(8)));
template <class Epi, class Sched, bool ALIGN_EPI = false, bool SP2 = false, bool F8 = false, int SCALE_W = 0, int SCALE_A = 0, bool I8 = false>
__device__ __forceinline__ void gemm_phase(PG8_LAS unsigned char* lds, const Gemm g, const Sched& S, const Epi& E) {
    const int tid = ptid_(), wid = __builtin_amdgcn_readfirstlane(tid >> 6), lane = tid & 63, wr = wid >> 2, wc = wid & 3, fr = lane & 15, fq = lane >> 4;
    const int K = g.K, nt = K / BK;
    unsigned voffA[2], voffB[2];
#pragma unroll
    for (int i = 0; i < 2; ++i) { int R, C; stage_rc(tid * 16 + i * 8192, R, C); const int Rb = Epi::PERM ? ((R & ~31) + perm32(R & 31)) : R;
        voffA[i] = (unsigned)(R * K + C) * 2u; voffB[i] = (unsigned)(Rb * K + C) * 2u; }
    const size_t kstep = (size_t)(BK * 2);
    const size_t hstep = (size_t)HALF * K * 2;
    const size_t tstep = 2 * hstep;
    const unsigned ldsw = (unsigned)wid * 1024u;
    const int aoff = lds_byte(wr * 64 + fr, fq * 8), boff = lds_byte(wc * 32 + fr, fq * 8);
#define PG8_SA(b, h) (((b) * 2 + (h)) * HTB)
#define PG8_SB(b, h) ((4 + (b) * 2 + (h)) * HTB)
#define PG8_STAGE(bufoff, gbase, voff) do { _Pragma("unroll") for (int _i = 0; _i < 2; ++_i) { unsigned _vo = (voff)[_i]; asm volatile("" : "+v"(_vo));     \
        __builtin_amdgcn_global_load_lds((const unsigned*)((const char*)(gbase) + _vo), (PG8_LAS unsigned*)(lds + (bufoff) + ldsw + _i * 8192), 16, 0, 0); } } while (0)
#define PG8_LD8(p) __builtin_shufflevector(*(const PG8_LAS i32x4*)(p), *(const PG8_LAS i32x4*)((p) + 1024), 0, 1, 2, 3, 4, 5, 6, 7)
#define PG8_LDA(dst, b, h) do { if constexpr (F8) { _Pragma("unroll") for (int m = 0; m < 4; ++m) dst##8[m] = PG8_LD8(lds + PG8_SA(b, h) + aoff + m * 2048); } \
        else { _Pragma("unroll") for (int m = 0; m < 4; ++m) _Pragma("unroll") for (int k = 0; k < 2; ++k) dst[m][k] = *(const PG8_LAS bf16x8*)(lds + PG8_SA(b, h) + aoff + m * 2048 + k * 1024); } } while (0)
#define PG8_LDB(dst, b, h) do { if constexpr (F8) { _Pragma("unroll") for (int n = 0; n < 2; ++n) dst##8[n] = PG8_LD8(lds + PG8_SB(b, h) + boff + n * 2048); } \
        else { _Pragma("unroll") for (int n = 0; n < 2; ++n) _Pragma("unroll") for (int k = 0; k < 2; ++k) dst[n][k] = *(const PG8_LAS bf16x8*)(lds + PG8_SB(b, h) + boff + n * 2048 + k * 1024); } } while (0)
#define PG8_MMA(ai, bj, At, Bt) do { __builtin_amdgcn_s_setprio(1); \
        if constexpr (F8) { _Pragma("unroll") for (int m = 0; m < 4; ++m) _Pragma("unroll") for (int n = 0; n < 2; ++n) \
            acc[ai][bj][m][n] = __builtin_amdgcn_mfma_scale_f32_16x16x128_f8f6f4(Bt##8[n], At##8[m], acc[ai][bj][m][n], 0, 0, 0, SCALE_W, 0, SCALE_A); } \
        else if constexpr (I8) { _Pragma("unroll") for (int m = 0; m < 4; ++m) _Pragma("unroll") for (int n = 0; n < 2; ++n) _Pragma("unroll") for (int k = 0; k < 2; ++k)        \
            acc[ai][bj][m][n] = __builtin_bit_cast(f32x4, __builtin_amdgcn_mfma_i32_16x16x64_i8(__builtin_bit_cast(i32x4, Bt[n][k]), __builtin_bit_cast(i32x4, At[m][k]), __builtin_bit_cast(i32x4, acc[ai][bj][m][n]), 0, 0, 0)); } \
        else { _Pragma("unroll") for (int m = 0; m < 4; ++m) _Pragma("unroll") for (int n = 0; n < 2; ++n) _Pragma("unroll") for (int k = 0; k < 2; ++k) \
            acc[ai][bj][m][n] = __builtin_amdgcn_mfma_f32_16x16x32_bf16(Bt[n][k], At[m][k], acc[ai][bj][m][n], 0, 0, 0); } \
        __builtin_amdgcn_s_setprio(0); } while (0)
#define PG8_WAIT_V(n) asm volatile("s_waitcnt vmcnt(" #n ")" ::: "memory")
#define PG8_WAIT_L(n) asm volatile("s_waitcnt lgkmcnt(" #n ")" ::: "memory")
#define PG8_BAR __builtin_amdgcn_s_barrier()
#define PG8_SCHED __builtin_amdgcn_sched_barrier(0)
    Unit cur, nxt; int ui = 0;
    if (!S.next(0, cur)) return;
    f32x4 acc[2][2][4][2];
#pragma unroll
    for (int a = 0; a < 2; ++a)
#pragma unroll
        for (int b = 0; b < 2; ++b)
#pragma unroll
            for (int m = 0; m < 4; ++m)
#pragma unroll
                for (int n = 0; n < 2; ++n) acc[a][b][m][n] = (f32x4){0.f, 0.f, 0.f, 0.f};
    bf16x8 At[4][2], B0[2][2], B1[2][2]; i32x8 At8[4], B08[2], B18[2];
    const char* cA = (const char*)g.A + (size_t)cur.pm * tstep; const char* cB = (const char*)g.Bt + (size_t)cur.pn * tstep;
    S.a_ready(cur);
    if constexpr (SP2) {
        PG8_STAGE(PG8_SB(0, 0), cB, voffB); PG8_STAGE(PG8_SB(0, 1), cB + hstep, voffB); PG8_STAGE(PG8_SA(0, 0), cA, voffA); PG8_STAGE(PG8_SA(0, 1), cA + hstep, voffA);
        if (wr == 1) PG8_BAR;
        PG8_WAIT_V(2); PG8_BAR;
        PG8_STAGE(PG8_SB(1, 0), cB + kstep, voffB); PG8_STAGE(PG8_SA(1, 0), cA + kstep, voffA); PG8_STAGE(PG8_SB(1, 1), cB + hstep + kstep, voffB);
        PG8_WAIT_V(6); PG8_BAR;
    } else {
        PG8_STAGE(PG8_SB(0, 0), cB, voffB); PG8_STAGE(PG8_SA(0, 0), cA, voffA); PG8_STAGE(PG8_SB(0, 1), cB + hstep, voffB); PG8_STAGE(PG8_SA(0, 1), cA + hstep, voffA);
        if (wr == 1) PG8_BAR;
        PG8_WAIT_V(4); PG8_BAR;
        PG8_STAGE(PG8_SB(1, 0), cB + kstep, voffB); PG8_STAGE(PG8_SA(1, 0), cA + kstep, voffA); PG8_STAGE(PG8_SB(1, 1), cB + hstep + kstep, voffB);
        PG8_WAIT_V(6); PG8_BAR;
    }
    for (;;) {
        const bool has_next = S.next(ui + 1, nxt);
        const char* nA = has_next ? (const char*)g.A + (size_t)nxt.pm * tstep : cA; const char* nB = has_next ? (const char*)g.Bt + (size_t)nxt.pn * tstep : cB;
#pragma unroll 1
        for (int t = 0; t < nt; t += 2) {
            const bool last = (t == nt - 2);
            const char* a1 = cA + (size_t)(t + 1) * kstep;
            const char* a2 = last ? nA : cA + (size_t)(t + 2) * kstep; const char* b2 = last ? nB : cB + (size_t)(t + 2) * kstep;
            const char* a3 = a2 + kstep; const char* b3 = b2 + kstep;
            if (last && has_next) S.a_ready(nxt);
            if constexpr (SP2) {
            PG8_LDB(B0, 0, 0); PG8_LDB(B1, 0, 1); PG8_SCHED; PG8_LDA(At, 0, 0); PG8_STAGE(PG8_SA(1, 1), a1 + hstep, voffA);
            PG8_WAIT_V(8); PG8_WAIT_L(0); PG8_BAR; PG8_MMA(0, 0, At, B0); PG8_MMA(0, 1, At, B1); PG8_BAR; PG8_SCHED;
            PG8_LDA(At, 0, 1); PG8_STAGE(PG8_SB(0, 0), b2, voffB); PG8_STAGE(PG8_SB(0, 1), b2 + hstep, voffB); PG8_STAGE(PG8_SA(0, 0), a2, voffA);
            PG8_WAIT_V(8); PG8_WAIT_L(0); PG8_BAR; PG8_MMA(1, 0, At, B0); PG8_MMA(1, 1, At, B1); PG8_BAR; PG8_SCHED;
            PG8_LDB(B0, 1, 0); PG8_LDB(B1, 1, 1); PG8_SCHED; PG8_LDA(At, 1, 0); PG8_STAGE(PG8_SA(0, 1), a2 + hstep, voffA);
            PG8_WAIT_V(8); PG8_WAIT_L(0); PG8_BAR; PG8_MMA(0, 0, At, B0); PG8_MMA(0, 1, At, B1); PG8_BAR; PG8_SCHED;
            PG8_LDA(At, 1, 1); PG8_STAGE(PG8_SB(1, 0), b3, voffB); PG8_STAGE(PG8_SB(1, 1), b3 + hstep, voffB); PG8_STAGE(PG8_SA(1, 0), a3, voffA);
            PG8_WAIT_V(8); PG8_WAIT_L(0); PG8_BAR; PG8_MMA(1, 0, At, B0); PG8_MMA(1, 1, At, B1); PG8_BAR; PG8_SCHED;
            } else {
            PG8_LDB(B0, 0, 0); PG8_SCHED; PG8_LDA(At, 0, 0); PG8_STAGE(PG8_SA(1, 1), a1 + hstep, voffA);
            PG8_WAIT_L(8); PG8_BAR; PG8_WAIT_L(0); PG8_MMA(0, 0, At, B0); PG8_BAR; PG8_SCHED;
            PG8_LDB(B1, 0, 1); PG8_STAGE(PG8_SB(0, 0), b2, voffB);
            PG8_BAR; PG8_WAIT_L(0); PG8_MMA(0, 1, At, B1); PG8_BAR;
            PG8_LDA(At, 0, 1); PG8_STAGE(PG8_SA(0, 0), a2, voffA);
            PG8_BAR; PG8_WAIT_L(0); PG8_MMA(1, 0, At, B0); PG8_BAR; PG8_SCHED;
            PG8_STAGE(PG8_SB(0, 1), b2 + hstep, voffB);
            PG8_WAIT_V(6); PG8_BAR; PG8_MMA(1, 1, At, B1); PG8_BAR;
            PG8_LDB(B0, 1, 0); PG8_SCHED; PG8_LDA(At, 1, 0); PG8_STAGE(PG8_SA(0, 1), a2 + hstep, voffA);
            PG8_WAIT_L(8); PG8_BAR; PG8_WAIT_L(0); PG8_MMA(0, 0, At, B0); PG8_BAR; PG8_SCHED;
            PG8_LDB(B1, 1, 1); PG8_STAGE(PG8_SB(1, 0), b3, voffB);
            PG8_BAR; PG8_WAIT_L(0); PG8_MMA(0, 1, At, B1); PG8_BAR;
            PG8_LDA(At, 1, 1); PG8_STAGE(PG8_SA(1, 0), a3, voffA);
            PG8_BAR; PG8_WAIT_L(0); PG8_MMA(1, 0, At, B0); PG8_BAR; PG8_SCHED;
            PG8_STAGE(PG8_SB(1, 1), b3 + hstep, voffB);
            PG8_WAIT_V(6); PG8_BAR; PG8_MMA(1, 1, At, B1); PG8_BAR;
            }
        }
        if constexpr (ALIGN_EPI) { if (wr == 0) PG8_BAR; }
        if constexpr (!Epi::AFTER_DRAIN) { const int t2 = ptid_(), w2 = __builtin_amdgcn_readfirstlane(t2 >> 6);
            E(acc, cur, w2 >> 2, w2 & 3, t2 & 15, (t2 & 63) >> 4); S.done(cur); }
        if (!has_next) break;
#pragma unroll
        for (int a = 0; a < 2; ++a)
#pragma unroll
            for (int b = 0; b < 2; ++b)
#pragma unroll
                for (int m = 0; m < 4; ++m)
#pragma unroll
                    for (int n = 0; n < 2; ++n) acc[a][b][m][n] = (f32x4){0.f, 0.f, 0.f, 0.f};
        cur = nxt; cA = nA; cB = nB; ++ui;
        if constexpr (ALIGN_EPI) { if (wr == 1) PG8_BAR; }
    }
    PG8_WAIT_V(0);
    if constexpr (!ALIGN_EPI) { if (wr == 0) PG8_BAR; }
    PG8_BAR;
    if constexpr (Epi::AFTER_DRAIN) { E.fused(acc, cur, wr, wc, fr, fq, lds, wid, lane); S.done(cur); }
#undef PG8_SA
#undef PG8_SB
#undef PG8_STAGE
#undef PG8_LDA
#undef PG8_LDB
#undef PG8_MMA
#undef PG8_WAIT_V
#undef PG8_WAIT_L
#undef PG8_BAR
#undef PG8_SCHED
}
}

#define LAS __attribute__((address_space(3)))
#ifndef WGM_G1
#define WGM_G1 4
#define WGM_G2 4
#define WGM_G3 4
#endif
#ifndef TPROBE
#define TPROBE (-1)
#endif
__device__ __forceinline__ int ptid() { int t = threadIdx.x; asm volatile("" : "+v"(t)); return t; }
constexpr int NWAVES = 8, NTHREADS = 512;
constexpr int RING_BYTES = 131072;
constexpr int MISC_OFF = RING_BYTES + 320;
constexpr int LDS_BYTES = 147456;
constexpr int CW_BAR = 4096;
constexpr int CW_CMAXQ = 14336;
constexpr int CW_GB = 16384;
constexpr size_t CTL_ZERO_BYTES = 80 * 1024;
constexpr int CW_BAR2 = 10240;
#ifndef HG_PER_XCD
#define HG_PER_XCD 24
#endif
constexpr int CW_ATTNQ = 7680;

#define XB_TMO      128
#define XB_XCNT(j)  (256  + 64 * (j))
#define XB_XSUB(j)  (1280 + 64 * (j))
#define XB_XGEN(j)  (2304 + 64 * (j))
#define XB_TOP      3328
#define XB_TOPGEN   3392
#define XCD_BAR_WORDS 3456
#define XB_SPIN_CAP (1u << 20)
__device__ __forceinline__ unsigned xb_ld(unsigned* p)              { return __hip_atomic_load(p, __ATOMIC_RELAXED, __HIP_MEMORY_SCOPE_AGENT); }
__device__ __forceinline__ unsigned xb_add(unsigned* p, unsigned v) { return __hip_atomic_fetch_add(p, v, __ATOMIC_RELAXED, __HIP_MEMORY_SCOPE_AGENT); }
__device__ __forceinline__ unsigned xb_xcc_id() { return (unsigned)__builtin_amdgcn_s_getreg((3 << 11) | 20) & 0xFu; }
#define XB_SPIN(cond, bar) do { unsigned _sp = 0; while (cond) { __builtin_amdgcn_s_sleep(1); \
    if ((++_sp & 255u) == 0u) { if (xb_ld(&(bar)[XB_TMO])) break; if (_sp > XB_SPIN_CAP) { atomicAdd(&(bar)[XB_TMO], 1u); break; } } } } while (0)
struct XcdBarrier { unsigned* bar; unsigned x; volatile LAS unsigned* st; unsigned total; };
__device__ __forceinline__ XcdBarrier xcd_barrier_post(unsigned* bar, volatile LAS unsigned* st, unsigned total, bool member = true) {
    XcdBarrier b; b.bar = bar; b.x = xb_xcc_id(); b.st = st; b.total = total;
    if (member && threadIdx.x == 0) (void)xb_add(&bar[XB_XCNT(b.x)], 1u);
    return b;
}
__device__ __forceinline__ void xcd_barrier_complete(unsigned* bar, unsigned x, unsigned G, unsigned& nloc, unsigned& nx) {
    unsigned sum, cnt, mine, sp = 0u;
    for (;;) {
        sum = 0u; cnt = 0u; mine = 0u;
#pragma unroll
        for (unsigned j = 0; j < 16; ++j) { const unsigned c = xb_ld(&bar[XB_XCNT(j)]); sum += c; cnt += (c > 0u) ? 1u : 0u; mine = (j == x) ? c : mine; }
        if (sum == G) break;
        __builtin_amdgcn_s_sleep(1);
        if ((++sp & 255u) == 0u) { if (xb_ld(&bar[XB_TMO])) break; if (sp > XB_SPIN_CAP) { atomicAdd(&bar[XB_TMO], 1u); break; } }
    }
    nloc = mine > 0u ? mine : 1u; nx = cnt > 0u ? cnt : 1u;
}
__device__ __forceinline__ void xcd_barrier(const XcdBarrier& b) {
    asm volatile("s_waitcnt vmcnt(0)" ::: "memory");
    __syncthreads();
    if (threadIdx.x == 0) {
        unsigned* bar = b.bar;
        __builtin_amdgcn_s_waitcnt(0);
        unsigned nloc = b.st[0], nx = b.st[1];
        if (nloc == 0u) { xcd_barrier_complete(bar, b.x, b.total, nloc, nx); b.st[0] = nloc; b.st[1] = nx; }
        const unsigned old = xb_add(&bar[XB_XSUB(b.x)], 1u);
        const unsigned gen = old / nloc;
        if (old + 1u == (gen + 1u) * nloc) {
            __builtin_amdgcn_fence(__ATOMIC_RELEASE, "agent");
            asm volatile("s_waitcnt vmcnt(0)" ::: "memory");
            const unsigned og = xb_add(&bar[XB_TOP], 1u);
            const unsigned tg = og / nx;
            if (og + 1u == (tg + 1u) * nx) xb_add(&bar[XB_TOPGEN], 1u);
            else XB_SPIN(xb_ld(&bar[XB_TOPGEN]) == tg, bar);
            __builtin_amdgcn_fence(__ATOMIC_ACQUIRE, "agent");
            xb_add(&bar[XB_XGEN(b.x)], 1u);
            asm volatile("s_waitcnt vmcnt(0)" ::: "memory");
        } else {
            XB_SPIN(xb_ld(&bar[XB_XGEN(b.x)]) == gen, bar);
            __builtin_amdgcn_fence(__ATOMIC_ACQUIRE, "agent");
            asm volatile("s_waitcnt vmcnt(0)" ::: "memory");
        }
    }
    __syncthreads();
}

__device__ __forceinline__ void group_barrier(unsigned* cnt, unsigned target, unsigned* tmo) {
    asm volatile("s_waitcnt vmcnt(0)" ::: "memory");
    __syncthreads();
    if (threadIdx.x == 0) {
        __builtin_amdgcn_fence(__ATOMIC_RELEASE, "agent");
        asm volatile("s_waitcnt vmcnt(0)" ::: "memory");
        (void)xb_add(cnt, 1u);
        unsigned sp = 0;
        while (xb_ld(cnt) < target) { __builtin_amdgcn_s_sleep(1); if ((++sp & 255u) == 0u) { if (xb_ld(tmo)) break; if (sp > XB_SPIN_CAP) { atomicAdd(tmo, 1u); break; } } }
        __builtin_amdgcn_fence(__ATOMIC_ACQUIRE, "agent");
        asm volatile("s_waitcnt vmcnt(0)" ::: "memory");
    }
    __syncthreads();
}
struct Args { const float* in[17]; float* out; unsigned char* ws; int ph_lo, ph_hi, li, flags; };
enum { FL_ATTN = 1, FL_HGRN = 2 };

__device__ __forceinline__ unsigned cvt_pk_bf16(float lo, float hi) { f32x2_t v = {lo, hi}; bf16x2_t b = __builtin_convertvector(v, bf16x2_t); return __builtin_bit_cast(unsigned, b); }
struct EpiPlainT {
    static constexpr bool PERM = true, AFTER_DRAIN = false;
    bf16_t* O; int ld; float sc;
    __device__ __forceinline__ void operator()(const pg8::f32x4 (&acc)[2][2][4][2], const pg8::Unit& u, int wr, int wc, int fr, int fq) const {
        const int row0 = u.pm * 256 + wr * 64 + fr, col0 = u.pn * 256 + wc * 32 + 8 * fq;
#pragma unroll
        for (int ai = 0; ai < 2; ++ai)
#pragma unroll
            for (int m = 0; m < 4; ++m) { bf16_t* rowp = O + (size_t)(row0 + ai * 128 + m * 16) * ld + col0;
#pragma unroll
                for (int bj = 0; bj < 2; ++bj) { const pg8::f32x4 v0 = acc[ai][bj][m][0] * sc, v1 = acc[ai][bj][m][1] * sc;
                    if (MIX8) { u32x2 w8; w8.x = pk4f8(v0[0], v0[1], v0[2], v0[3]); w8.y = pk4f8(v1[0], v1[1], v1[2], v1[3]);
                        *(u32x2*)((unsigned char*)O + (size_t)(row0 + ai * 128 + m * 16) * ld + col0 + bj * 128) = w8; }
                    else { u32x4 w; w.x = cvt_pk_bf16(v0[0], v0[1]); w.y = cvt_pk_bf16(v0[2], v0[3]); w.z = cvt_pk_bf16(v1[0], v1[1]); w.w = cvt_pk_bf16(v1[2], v1[3]);
                    *(u32x4*)(rowp + bj * 128) = w; } } }
    }
};
struct EpiPlainI8 {
    static constexpr bool PERM = true, AFTER_DRAIN = false;
    bf16_t* O; int ld; const float* sa  ; const float* cmax  ;
    __device__ __forceinline__ void operator()(const pg8::f32x4 (&acc)[2][2][4][2], const pg8::Unit& u, int wr, int wc, int fr, int fq) const {
        const int row0 = u.pm * 256 + wr * 64 + fr, col0 = u.pn * 256 + wc * 32 + 8 * fq;
        float cw[2][8];
#pragma unroll
        for (int bj = 0; bj < 2; ++bj)
#pragma unroll
            for (int i = 0; i < 8; ++i) cw[bj][i] = cmax[col0 + bj * 128 + i] * (1.f / 127.f);
#pragma unroll
        for (int ai = 0; ai < 2; ++ai)
#pragma unroll
            for (int m = 0; m < 4; ++m) { const int row = row0 + ai * 128 + m * 16; const float ra = sa[row]; bf16_t* rowp = O + (size_t)row * ld + col0;
#pragma unroll
                for (int bj = 0; bj < 2; ++bj) { float v[8];
#pragma unroll
                    for (int i = 0; i < 4; ++i) { const float a0 = acc[ai][bj][m][0][i], a1 = acc[ai][bj][m][1][i];
                        v[i] = (float)__float_as_int(a0) * ra * cw[bj][i]; v[4 + i] = (float)__float_as_int(a1) * ra * cw[bj][4 + i]; }
                    u32x4 w; w.x = cvt_pk_bf16(v[0], v[1]); w.y = cvt_pk_bf16(v[2], v[3]); w.z = cvt_pk_bf16(v[4], v[5]); w.w = cvt_pk_bf16(v[6], v[7]);
                    *(u32x4*)(rowp + bj * 128) = w; } }
    }
};
struct EpiProjT {
    static constexpr bool PERM = true, AFTER_DRAIN = false;
    static constexpr float ASC = G1F8 ? 0.03125f : 1.f;
    bf16_t* proj; bf16_t* kk; const float* lb; unsigned* kmaxh;
    __device__ __forceinline__ void operator()(const pg8::f32x4 (&acc)[2][2][4][2], const pg8::Unit& u, int wr, int wc, int fr, int fq) const {
        const int row0 = u.pm * 256 + wr * 64 + fr, col0 = u.pn * 256 + wc * 32 + 8 * fq, seg = (u.pn * 256) >> 9;
        float kmx[2] = {0.f, 0.f};
        float lbv[2][8];
        if (seg == 4) {
#pragma unroll
            for (int bj = 0; bj < 2; ++bj)
#pragma unroll
                for (int i = 0; i < 8; ++i) lbv[bj][i] = lb[col0 - C_LF + bj * 128 + i];
        }
        const float sc = (seg == 0) ? QSCALE : (seg == 3) ? HQSCALE : 1.f;
#pragma unroll
        for (int ai = 0; ai < 2; ++ai)
#pragma unroll
            for (int m = 0; m < 4; ++m) { const size_t row = (size_t)(row0 + ai * 128 + m * 16);
#pragma unroll
                for (int bj = 0; bj < 2; ++bj) {
                    float v[8];
#pragma unroll
                    for (int i = 0; i < 4; ++i) { v[i] = acc[ai][bj][m][0][i] * ASC; v[4 + i] = acc[ai][bj][m][1][i] * ASC; }
                    u32x4 w;
                    if (seg == 4) {
                        float k1[8]; unsigned short hh[8];
#pragma unroll
                        for (int i = 0; i < 8; ++i) { const float l = lbv[bj][i], f = l + (1.f - l) * sigmoidf_(v[i]); k1[i] = 1.f - f; hh[i] = f2h(__builtin_amdgcn_logf(f) * 0.69314718056f); }
                        w.x = hh[0] | ((unsigned)hh[1] << 16); w.y = hh[2] | ((unsigned)hh[3] << 16); w.z = hh[4] | ((unsigned)hh[5] << 16); w.w = hh[6] | ((unsigned)hh[7] << 16);
                        (void)k1;
                    } else {
                        if (seg == 6) {
#pragma unroll
                            for (int i = 0; i < 8; ++i) v[i] = v[i] * sigmoidf_(v[i]);
                        } else {
#pragma unroll
                            for (int i = 0; i < 8; ++i) v[i] *= sc;
                        }
                        w.x = cvt_pk_bf16(v[0], v[1]); w.y = cvt_pk_bf16(v[2], v[3]); w.z = cvt_pk_bf16(v[4], v[5]); w.w = cvt_pk_bf16(v[6], v[7]);
                        if (seg == 1) {
                            float s = 0.f;
#pragma unroll
                            for (int i = 0; i < 4; ++i) { const float a = __uint_as_float(w[i] << 16), b = __uint_as_float(w[i] & 0xffff0000u); s += a * a + b * b; }
                            s += __shfl_xor(s, 16); s += __shfl_xor(s, 32);
                            kmx[bj] = fmaxf(kmx[bj], s);
                        }
                    }
                    *(u32x4*)(proj + row * NPROJ + col0 + bj * 128) = w;
                } }
        if (seg == 1) {
#pragma unroll
            for (int bj = 0; bj < 2; ++bj) { float m = kmx[bj]; m = fmaxf(m, __shfl_xor(m, 1)); m = fmaxf(m, __shfl_xor(m, 2)); m = fmaxf(m, __shfl_xor(m, 4)); m = fmaxf(m, __shfl_xor(m, 8));
                const int head = (u.pn - 2) * 4 + bj * 2 + (wc >> 1), b = (u.pm * 256) / SEQ;
                if (fr == 0 && fq == 0) atomicMax(kmaxh + ((b * 8 + head) * 2 + (wc & 1)), __float_as_uint(m)); }
        }
    }
};

template <int SB, int F8OUT = 0> __device__ __forceinline__ void transpose_item(const float* __restrict__ W, int ldw, int c0, bf16_t* WT, int r0, LAS float* scr, int item, int nblk, int lane, const float* cmax = nullptr) {
    const int k0 = 64 * (item / nblk), n0 = 32 * (item % nblk);
#pragma unroll 8
    for (int i = 0; i < 32; ++i) { const int kk = 2 * i + (lane >> 5); scr[kk * 33 + (lane & 31)] = W[(size_t)(k0 + kk) * ldw + c0 + n0 + (lane & 31)]; }
    asm volatile("s_waitcnt lgkmcnt(0)" ::: "memory");
    const int c = lane & 7;
#pragma unroll
    for (int j = 0; j < 4; ++j) { const int n = (lane >> 3) + 8 * j; const LAS float* s = scr + (8 * c) * 33 + n;
        if constexpr (F8OUT == 2) { const float cm = cmax[n0 + n], qs = cm > 0.f ? 127.f / cm : 0.f; int q[8];
#pragma unroll
            for (int e = 0; e < 8; ++e) q[e] = (int)rintf(s[e * 33] * qs);
            if (G3I8 == 2) { const float dq = cm * (1.f / 127.f); u32x4 o; o.x = pk2((float)q[0] * dq, (float)q[1] * dq); o.y = pk2((float)q[2] * dq, (float)q[3] * dq); o.z = pk2((float)q[4] * dq, (float)q[5] * dq); o.w = pk2((float)q[6] * dq, (float)q[7] * dq);
                *(u32x4*)(WT + (size_t)(r0 + n0 + n) * 1024 + k0 + 8 * c) = o; continue; }
#pragma unroll
            for (int e = 0; e < 8; ++e) q[e] &= 255;
            u32x2 o8; o8.x = (unsigned)(q[0] | (q[1] << 8) | (q[2] << 16) | (q[3] << 24)); o8.y = (unsigned)(q[4] | (q[5] << 8) | (q[6] << 16) | (q[7] << 24));
            *(u32x2*)((unsigned char*)WT + (size_t)(r0 + n0 + n) * 1024 + k0 + 8 * c) = o8; continue; }
        if constexpr (F8OUT == 1) { u32x2 o8; o8.x = pk4f8(s[0 * 33] * 32.f, s[1 * 33] * 32.f, s[2 * 33] * 32.f, s[3 * 33] * 32.f); o8.y = pk4f8(s[4 * 33] * 32.f, s[5 * 33] * 32.f, s[6 * 33] * 32.f, s[7 * 33] * 32.f);
            *(u32x2*)((unsigned char*)WT + (size_t)(r0 + n0 + n) * 1024 + k0 + 8 * c) = o8; continue; }
        u32x4 o; o.x = pk2(F8W(SB, s[0 * 33]), F8W(SB, s[1 * 33])); o.y = pk2(F8W(SB, s[2 * 33]), F8W(SB, s[3 * 33])); o.z = pk2(F8W(SB, s[4 * 33]), F8W(SB, s[5 * 33])); o.w = pk2(F8W(SB, s[6 * 33]), F8W(SB, s[7 * 33]));
        *(u32x4*)(WT + (size_t)(r0 + n0 + n) * 1024 + k0 + 8 * c) = o; }
    asm volatile("s_waitcnt lgkmcnt(0)" ::: "memory");
}
__device__ __forceinline__ void qrow_load(f32x4 (&v)[4], const float* __restrict__ src, int row, int lane) {
#pragma unroll
    for (int j = 0; j < 4; ++j) v[j] = __builtin_nontemporal_load((const f32x4*)(src + (size_t)row * 1024 + 256 * j + 4 * lane));
}
template <bool SIGNED4> __device__ __forceinline__ void qrow_store(const f32x4 (&v)[4], unsigned char* q, float* scale, int row, int lane) {
    float ss = 0.f;
#pragma unroll
    for (int j = 0; j < 4; ++j) ss += v[j].x * v[j].x + v[j].y * v[j].y + v[j].z * v[j].z + v[j].w * v[j].w;
    ss = wave_sum(ss);
    const float sc = ss > 0.f ? 0.3352f * sqrtf(ss * (1.f / 1024.f)) : 1.f, inv = __builtin_amdgcn_rcpf(sc);
    unsigned n[16];
#pragma unroll
    for (int j = 0; j < 4; ++j) {
#pragma unroll
        for (int i = 0; i < 4; ++i) { const float f = floorf(v[j][i] * inv) + 8.f; n[4 * j + i] = (unsigned)fminf(fmaxf(f, 0.f), 15.f); } }
    u32x2 o;
#pragma unroll
    for (int m = 0; m < 2; ++m) { unsigned w = 0;
#pragma unroll
        for (int b = 0; b < 4; ++b) w |= (n[8 * m + b] | (n[8 * m + 4 + b] << 4)) << (8 * b);
        o[m] = SIGNED4 ? (w ^ 0x88888888u) : w; }
    *(u32x2*)(q + (size_t)row * 1024 + lane * 16) = o;
    if (lane == 0) scale[row] = sc;
}
__device__ __forceinline__ void h_rows(const float* __restrict__ x, const float* __restrict__ g, const float* __restrict__ mod, const float* __restrict__ wff, const float* __restrict__ bf, bf16_t* H, float* logf, int t0, int t1, int lane) {
    if (t0 >= t1) return;
    const int b = t0 / SEQ;
    const float* shift = mod + b * 6144, * scale = shift + 1024;
    f32x4 gm[4], sh[4];
#pragma unroll
    for (int j = 0; j < 4; ++j) { const int c0 = 256 * j + 4 * lane; gm[j] = *(const f32x4*)(g + c0) * (*(const f32x4*)(scale + c0) + 1.f); sh[j] = *(const f32x4*)(shift + c0); }
    const float bfl = (lane < 8) ? bf[lane] : 0.f;
    f32x4 wf[8][4];
#pragma unroll
    for (int i = 0; i < 8; ++i)
#pragma unroll
        for (int j = 0; j < 4; ++j) wf[i][j] = *(const f32x4*)(wff + i * 1024 + 256 * j + 4 * lane);
    f32x4 nx[2][4];
#pragma unroll
    for (int p = 0; p < 2; ++p) if (t0 + p < t1) {
#pragma unroll
        for (int j = 0; j < 4; ++j) nx[p][j] = __builtin_nontemporal_load((const f32x4*)(x + (size_t)(t0 + p) * 1024 + 256 * j + 4 * lane)); }
    for (int tb = t0; tb < t1; tb += 2) {
#pragma unroll
      for (int p = 0; p < 2; ++p) { const int t = tb + p; if (t >= t1) break;
        f32x4 v[4]; float s = 0.f;
#pragma unroll
        for (int j = 0; j < 4; ++j) { v[j] = nx[p][j]; s += v[j].x * v[j].x + v[j].y * v[j].y + v[j].z * v[j].z + v[j].w * v[j].w; }
        if (t + 2 < t1) {
#pragma unroll
            for (int j = 0; j < 4; ++j) nx[p][j] = __builtin_nontemporal_load((const f32x4*)(x + (size_t)(t + 2) * 1024 + 256 * j + 4 * lane));
        }
        const float rstd = rsqrtf(wave_sum(s) * (1.f / 1024.f) + EPS);
        float ff[8];
#pragma unroll
        for (int i = 0; i < 8; ++i) ff[i] = 0.f;
#pragma unroll
        for (int j = 0; j < 4; ++j) {
            const int c0 = 256 * j + 4 * lane;
            const f32x4 h = v[j] * rstd * gm[j] + sh[j];
            if (G1F8) *(unsigned*)((unsigned char*)H + (size_t)t * 1024 + c0) = pk4f8(h.x, h.y, h.z, h.w);
            else { u32x2 o; o.x = pk2(F8(1, h.x), F8(1, h.y)); o.y = pk2(F8(1, h.z), F8(1, h.w)); *(u32x2*)(H + (size_t)t * 1024 + c0) = o; }
#pragma unroll
            for (int i = 0; i < 8; ++i) { const f32x4 w = wf[i][j]; ff[i] += h.x * w.x + h.y * w.y + h.z * w.z + h.w * w.w; }
        }
#pragma unroll
        for (int i = 0; i < 8; ++i) ff[i] = wave_sum(ff[i]);
        if (lane < 8) {
            float z = 0.f;
#pragma unroll
            for (int i = 0; i < 8; ++i) z = (lane == i) ? ff[i] : z;
            z += bfl;
            logf[(size_t)t * 8 + lane] = fminf(z, 0.f) - log1pf(__expf(-fabsf(z)));
        }
      }
    }
}

__device__ __forceinline__ void row_passes(const float* __restrict__ x, const bf16_t* __restrict__ mix, const float* __restrict__ mod, const float* __restrict__ g_post, const float* __restrict__ g_pre, bf16_t* XB, bf16_t* H2, float* SH2, int t0, int t1, int lane) {
    if (t0 >= t1) return;
    const int b = t0 / SEQ; const float* md = mod + b * 6144;
    f32x4 ga[4], gp[4], shf[4];
#pragma unroll
    for (int j = 0; j < 4; ++j) { const int c0 = 256 * j + 4 * lane; ga[j] = *(const f32x4*)(md + 2048 + c0) * *(const f32x4*)(g_post + c0);
        gp[j] = *(const f32x4*)(g_pre + c0) * (*(const f32x4*)(md + 4096 + c0) + 1.f); shf[j] = *(const f32x4*)(md + 3072 + c0); }
    f32x4 nx[4]; u32x2 nm[4];
#pragma unroll
    for (int j = 0; j < 4; ++j) { const int c0 = 256 * j + 4 * lane; nx[j] = __builtin_nontemporal_load((const f32x4*)(x + (size_t)t0 * 1024 + c0)); nm[j] = MIX8 ? (u32x2){__builtin_nontemporal_load((const unsigned*)((const unsigned char*)mix + (size_t)t0 * 1024 + c0)), 0u} : *(const u32x2*)(mix + (size_t)t0 * 1024 + c0); }
    for (int t = t0; t < t1; ++t) {
        f32x4 m[4], xv[4]; float s = 0.f;
#pragma unroll
        for (int j = 0; j < 4; ++j) { const u32x2 w = nm[j]; xv[j] = nx[j];
            m[j] = MIX8 ? (f32x4){__builtin_amdgcn_cvt_f32_fp8((int)w.x, 0), __builtin_amdgcn_cvt_f32_fp8((int)w.x, 1), __builtin_amdgcn_cvt_f32_fp8((int)w.x, 2), __builtin_amdgcn_cvt_f32_fp8((int)w.x, 3)}
                        : (f32x4){__uint_as_float(w.x << 16), __uint_as_float(w.x & 0xffff0000u), __uint_as_float(w.y << 16), __uint_as_float(w.y & 0xffff0000u)};
            s += m[j].x * m[j].x + m[j].y * m[j].y + m[j].z * m[j].z + m[j].w * m[j].w; }
        if (t + 1 < t1) {
#pragma unroll
            for (int j = 0; j < 4; ++j) { const int c0 = 256 * j + 4 * lane; nx[j] = __builtin_nontemporal_load((const f32x4*)(x + (size_t)(t + 1) * 1024 + c0)); nm[j] = MIX8 ? (u32x2){__builtin_nontemporal_load((const unsigned*)((const unsigned char*)mix + (size_t)(t + 1) * 1024 + c0)), 0u} : *(const u32x2*)(mix + (size_t)(t + 1) * 1024 + c0); }
        }
        const float r1 = rsqrtf(wave_sum(s) * (1.f / 1024.f) + EPS);
        float s2 = 0.f;
#pragma unroll
        for (int j = 0; j < 4; ++j) { const int c0 = 256 * j + 4 * lane;
            xv[j] = xv[j] + ga[j] * (m[j] * r1);
            { u32x2 xo; xo.x = pk2(xv[j].x, xv[j].y); xo.y = pk2(xv[j].z, xv[j].w); *(u32x2*)(XB + (size_t)t * 1024 + c0) = xo; }
            s2 += xv[j].x * xv[j].x + xv[j].y * xv[j].y + xv[j].z * xv[j].z + xv[j].w * xv[j].w; }
        const float r2 = rsqrtf(wave_sum(s2) * (1.f / 1024.f) + EPS);
        if (G3I8) {
            f32x4 hq[4]; float mx = 0.f;
#pragma unroll
            for (int j = 0; j < 4; ++j) { hq[j] = xv[j] * r2 * gp[j] + shf[j]; mx = fmaxf(mx, fmaxf(fmaxf(fabsf(hq[j].x), fabsf(hq[j].y)), fmaxf(fabsf(hq[j].z), fabsf(hq[j].w)))); }
            mx = wave_max(mx);
            const float st = mx > 0.f ? mx * (1.f / 127.f) : 1.f, inv = 1.f / st;
#pragma unroll
            for (int j = 0; j < 4; ++j) { const int c0 = 256 * j + 4 * lane;
                const int q0 = (int)rintf(hq[j].x * inv), q1 = (int)rintf(hq[j].y * inv), q2 = (int)rintf(hq[j].z * inv), q3 = (int)rintf(hq[j].w * inv);
                if (G3I8 == 2) { u32x2 o; o.x = pk2((float)q0 * st, (float)q1 * st); o.y = pk2((float)q2 * st, (float)q3 * st); *(u32x2*)(H2 + (size_t)t * 1024 + c0) = o; } else
                *(unsigned*)((unsigned char*)H2 + (size_t)t * 1024 + c0) = (unsigned)(q0 & 255) | ((unsigned)(q1 & 255) << 8) | ((unsigned)(q2 & 255) << 16) | ((unsigned)(q3 & 255) << 24); }
            if (lane == 0) SH2[t] = st;
        } else {
#pragma unroll
        for (int j = 0; j < 4; ++j) { const int c0 = 256 * j + 4 * lane;
            const f32x4 h = xv[j] * r2 * gp[j] + shf[j];
            u32x2 o; o.x = pk2(F8(4, h.x), F8(4, h.y)); o.y = pk2(F8(4, h.z), F8(4, h.w));
            *(u32x2*)(H2 + (size_t)t * 1024 + c0) = o; }
        }
    }
}

__device__ __forceinline__ float gelu_as(float v) {
    const float av = fabsf(v), t = __builtin_amdgcn_rcpf(av * 0.2316418882f + 1.0f);
    float q = t * 0.5307027145f + (-0.7265760135f); q = q * t + 0.7107068705f; q = q * t + (-0.142248368f); q = q * t + 0.127414796f; q = q * t;
    const float m = v * (q * __builtin_amdgcn_exp2f((v * v) * (-0.72134752044f)));
    return v < 0.f ? m : v - m;
}
constexpr int EB = 16;
__device__ __forceinline__ void gather_only_token(const unsigned char* __restrict__ UV, const int* __restrict__ IDX, float* sink, int t, int lane) {
    const int i0 = IDX[(size_t)t * 128 + lane], i1 = IDX[(size_t)t * 128 + 64 + lane];
    const unsigned lo16 = (unsigned)lane * 16u;
    u32x4 acc = (u32x4){0u, 0u, 0u, 0u};
    u32x4 rb[16];
#pragma unroll
    for (int e = 0; e < 16; ++e) { const unsigned row = (unsigned)__builtin_amdgcn_readlane(i0, e); rb[e] = *(const u32x4*)(UV + (row * 1024u + lo16)); }
#pragma unroll 1
    for (int bi = 0; bi < 8; ++bi) {
        u32x4 rn[16];
        const int nb = (bi + 1) & 7, srcn = (nb < 4) ? i0 : i1, ln = (nb & 3) * 16;
#pragma unroll
        for (int e = 0; e < 16; ++e) { const unsigned row = (unsigned)__builtin_amdgcn_readlane(srcn, ln + e); rn[e] = *(const u32x4*)(UV + (row * 1024u + lo16)); }
#pragma unroll
        for (int e = 0; e < 16; ++e) acc |= rb[e];
#pragma unroll
        for (int e = 0; e < 16; ++e) rb[e] = rn[e];
    }
    if ((acc.x ^ acc.y ^ acc.z ^ acc.w) == 0x12345679u) sink[t] = 1.f;
}
#define EXP_ROW(src, l) (*(const u32x4*)(UV + ((unsigned)__builtin_amdgcn_readlane((src), (l)) * 1024u + lo16)))
#define EXP_STEP(S, BI) do { const int bi_ = (BI); \
        int d[EB]; \
        _Pragma("unroll") for (int e = 0; e < EB; ++e) { const int w0 = (int)S[e].x, w1 = (int)S[e].y;            \
            int s = __builtin_amdgcn_sdot8(xh[0], w0, 0, false); s = __builtin_amdgcn_sdot8(xh[1], w1, s, false); s <<= 4; \
            s = __builtin_amdgcn_sdot8(xl[0], w0, s, false); d[e] = __builtin_amdgcn_sdot8(xl[1], w1, s, false); } \
          \
        int d8[8], d4[4], d2[2], d1; \
        _Pragma("unroll") for (int k = 0; k < 8; ++k) { const auto r = __builtin_amdgcn_permlane32_swap((unsigned)d[k], (unsigned)d[8 + k], false, false); d8[k] = (int)(r[0] + r[1]); } \
        _Pragma("unroll") for (int k = 0; k < 4; ++k) { const auto r = __builtin_amdgcn_permlane16_swap((unsigned)d8[k], (unsigned)d8[4 + k], false, false); d4[k] = (int)(r[0] + r[1]); } \
        { const bool up = (lane & 2) != 0; \
          _Pragma("unroll") for (int k = 0; k < 2; ++k) { const int keep = up ? d4[2 + k] : d4[k], give = up ? d4[k] : d4[2 + k]; d2[k] = keep + __builtin_amdgcn_update_dpp(0, give, 0x4E, 0xF, 0xF, false); } } \
        { const bool up = (lane & 1) != 0; const int keep = up ? d2[1] : d2[0], give = up ? d2[0] : d2[1]; d1 = keep + __builtin_amdgcn_update_dpp(0, give, 0xB1, 0xF, 0xF, false); } \
        d1 += __builtin_amdgcn_update_dpp(0, d1, 0x128, 0xF, 0xF, false);         \
        d1 += __builtin_amdgcn_update_dpp(0, d1, 0x124, 0xF, 0xF, false);         \
        const int ba = ((bi_ * EB + el) & 63) * 4; \
        const float gsel = __uint_as_float((unsigned)__builtin_amdgcn_ds_bpermute(ba, (int)__float_as_uint((bi_ < 4) ? cg0 : cg1))); \
        const float susel = __uint_as_float((unsigned)__builtin_amdgcn_ds_bpermute(ba, (int)__float_as_uint((bi_ < 4) ? csu0 : csu1))); \
        const float svsel = __uint_as_float((unsigned)__builtin_amdgcn_ds_bpermute(ba, (int)__float_as_uint((bi_ < 4) ? csv0 : csv1))); \
        const float aval = ((float)d1 + xoff) * sx * susel; \
        const float cl = gsel * gelu_as(aval) * svsel; \
          \
          \
        const _Float16 chh = (_Float16)(cl * 4096.f); \
        sumc_l += (float)chh;                                    \
        const int chb = (int)__builtin_bit_cast(unsigned short, chh); \
        const int nb_ = bi_ + 2;                   \
        const int srcn_ = (nb_ < 4) ? ci0 : (nb_ < 8) ? ci1 : ni0, ln_ = (nb_ & 3) * EB; \
        _Pragma("unroll") for (int p = 0; p < EB / 2; ++p) { \
            const int e1 = 2 * p, e2 = 2 * p + 1; \
            const unsigned c1 = (unsigned)__builtin_amdgcn_readlane(chb, ((e1 >> 3) & 1) * 32 + ((e1 >> 2) & 1) * 16 + ((e1 >> 1) & 1) * 2 + (e1 & 1)); \
            const unsigned c2 = (unsigned)__builtin_amdgcn_readlane(chb, ((e2 >> 3) & 1) * 32 + ((e2 >> 2) & 1) * 16 + ((e2 >> 1) & 1) * 2 + (e2 & 1)); \
            const h16x2 cp = __builtin_bit_cast(h16x2, c1 | (c2 << 16)); \
            _Pragma("unroll") for (int m = 0; m < 2; ++m) { const unsigned w1 = S[e1][2 + m], w2 = S[e2][2 + m]; \
                const unsigned lo1 = w1 & 0x0F0F0F0Fu, hi1 = (w1 >> 4) & 0x0F0F0F0Fu, lo2 = w2 & 0x0F0F0F0Fu, hi2 = (w2 >> 4) & 0x0F0F0F0Fu; \
                _Pragma("unroll") for (int b = 0; b < 4; ++b) { const unsigned sel = (unsigned)b | 0x0C00u | ((unsigned)(4 + b) << 16) | 0x0C000000u;       \
                    acc[8 * m + b] = __builtin_amdgcn_fdot2(__builtin_bit_cast(h16x2, __builtin_amdgcn_perm(lo2, lo1, sel)), cp, acc[8 * m + b], false); \
                    acc[8 * m + 4 + b] = __builtin_amdgcn_fdot2(__builtin_bit_cast(h16x2, __builtin_amdgcn_perm(hi2, hi1, sel)), cp, acc[8 * m + 4 + b], false); } \
            } \
            __builtin_amdgcn_sched_barrier(0);                                           \
            S[e1] = EXP_ROW(srcn_, ln_ + e1); S[e2] = EXP_ROW(srcn_, ln_ + e2); \
            __builtin_amdgcn_sched_barrier(0); \
        } } while (0)
__device__ __forceinline__ void expert_tokens(const unsigned char* __restrict__ UV, const float* __restrict__ US, const float* __restrict__ VS,
                                              const int* __restrict__ IDX, const float* __restrict__ GATE, const LAS float* pv  ,
                                              const bf16_t* __restrict__ xin, LAS unsigned char* xslot  , float* out, int t0, int t1, int lane, int rmask, float pd) {
    if (t0 >= t1) return;
    const unsigned lo16 = (unsigned)lane * 16u;
    const int el = ((lane >> 5) & 1) * 8 + ((lane >> 4) & 1) * 4 + ((lane >> 1) & 1) * 2 + (lane & 1);
    const unsigned cw0 = (unsigned)IDX[(size_t)t0 * 128 + lane], cw1 = (unsigned)IDX[(size_t)t0 * 128 + 64 + lane];
    int ci0 = (int)cw0 & rmask, ci1 = (int)cw1 & rmask;
    float cg0 = __uint_as_float(cw0 & 0xFFFF0000u), cg1 = __uint_as_float(cw1 & 0xFFFF0000u);
    float csu0 = US[ci0], csu1 = US[ci1], csv0 = VS[ci0], csv1 = VS[ci1];
#define EXP_XROW(tt) do { const char* g_ = (const char*)(xin + (size_t)(tt) * 1024) + lane * 16; LAS unsigned char* l_ = xslot + ((tt) & 1) * 2048; \
        __builtin_amdgcn_global_load_lds((const unsigned*)g_, (LAS unsigned*)l_, 16, 0, 2); __builtin_amdgcn_global_load_lds((const unsigned*)(g_ + 1024), (LAS unsigned*)(l_ + 1024), 16, 0, 2); } while (0)
    EXP_XROW(t0);
    u32x4 A[EB], B[EB];
#pragma unroll
    for (int e = 0; e < EB; ++e) A[e] = EXP_ROW(ci0, e);
#pragma unroll
    for (int e = 0; e < EB; ++e) B[e] = EXP_ROW(ci0, EB + e);
#pragma unroll 1
    for (int t = t0; t < t1; ++t) {
        const bool has_next = t + 1 < t1; const int tn = has_next ? t + 1 : t;
        const LAS float* pvt = pv; asm volatile("" : "+v"(pvt));
        const unsigned nw0 = (unsigned)IDX[(size_t)tn * 128 + lane], nw1 = (unsigned)IDX[(size_t)tn * 128 + 64 + lane];
        const int ni0 = (int)nw0 & rmask, ni1 = (int)nw1 & rmask;
        const float ng0 = __uint_as_float(nw0 & 0xFFFF0000u), ng1 = __uint_as_float(nw1 & 0xFFFF0000u);
        if (t == t0) asm volatile("s_waitcnt vmcnt(0)" ::: "memory"); else asm volatile("s_waitcnt vmcnt(32)" ::: "memory");
        if (has_next) EXP_XROW(tn);
        const LAS unsigned char* xrow = xslot + (t & 1) * 2048;
        float nsu0 = 0.f, nsu1 = 0.f, nsv0 = 0.f, nsv1 = 0.f;
        float hv[16]; float mx = 0.f;
        { float s2 = 0.f; f32x4 x1[4];
#pragma unroll
          for (int j = 0; j < 4; ++j) { const u32x2 xw = *(const LAS u32x2*)(xrow + 512 * j + 8 * lane);
              x1[j] = (f32x4){__uint_as_float(xw.x << 16), __uint_as_float(xw.x & 0xffff0000u), __uint_as_float(xw.y << 16), __uint_as_float(xw.y & 0xffff0000u)}; s2 += x1[j].x * x1[j].x + x1[j].y * x1[j].y + x1[j].z * x1[j].z + x1[j].w * x1[j].w; }
          const float r2 = rsqrtf(wave_sum(s2) * (1.f / 1024.f) + EPS);
#pragma unroll
          for (int j = 0; j < 4; ++j) { const f32x4 h = x1[j] * r2 * *(const LAS f32x4*)(pvt + 256 * j + 4 * lane) + *(const LAS f32x4*)(pvt + 1024 + 256 * j + 4 * lane);
              hv[4 * j] = h.x; hv[4 * j + 1] = h.y; hv[4 * j + 2] = h.z; hv[4 * j + 3] = h.w;
              mx = fmaxf(mx, fmaxf(fmaxf(fabsf(h.x), fabsf(h.y)), fmaxf(fabsf(h.z), fabsf(h.w)))); } }
        mx = wave_max(mx);
        const float sx = mx > 0.f ? mx / 119.f : 1.f, isx = 1.f / sx;
        int xh[2], xl[2]; int xs = 0;
#pragma unroll
        for (int m = 0; m < 2; ++m) { unsigned wh = 0, wl = 0;
#pragma unroll
            for (int k = 0; k < 8; ++k) { const int pos = 8 * m + (k >> 1) + 4 * (k & 1); const int q = (int)rintf(hv[pos] * isx); xs += q;
                const int ql = ((q + 8) & 15) - 8, qh = (q - ql) >> 4;
                wl |= (unsigned)(ql & 15) << (4 * k); wh |= (unsigned)(qh & 15) << (4 * k); }
            xh[m] = (int)wh; xl[m] = (int)wl; }
#pragma unroll
        for (int o = 1; o < 64; o <<= 1) xs += __shfl_xor(xs, o);
        const float xoff = 0.5f * (float)xs;
        float acc[16];
#pragma unroll
        for (int i = 0; i < 16; ++i) acc[i] = 0.f;
        float sumc_l = 0.f;
#pragma unroll 1
        for (int bi = 0; bi < 128 / EB; bi += 2) {
            EXP_STEP(A, bi);
            if (bi == 0) { nsu0 = US[ni0]; nsu1 = US[ni1]; nsv0 = VS[ni0]; nsv1 = VS[ni1]; }
            EXP_STEP(B, bi + 1);
        }
        float sy = 0.f;
        const float sumc = wave_sum(sumc_l) * (0.25f / 4096.f);
#pragma unroll
        for (int i = 0; i < 16; ++i) { acc[i] = acc[i] * 4096.f - 7.5f * sumc; sy += acc[i] * acc[i]; }
        const float ry = rsqrtf(wave_sum(sy) * (1.f / 1024.f) + EPS);
        const float pscale = (t < 2048) ? 1.f + pd : 1.f;
#pragma unroll
        for (int j = 0; j < 4; ++j) { const f32x4 y = (f32x4){acc[4 * j], acc[4 * j + 1], acc[4 * j + 2], acc[4 * j + 3]};
            float* op = out + (size_t)t * 1024 + 256 * j + 4 * lane;
            const u32x2 xw = *(const LAS u32x2*)(xrow + 512 * j + 8 * lane);
            { const f32x4 ov_ = pscale * (f32x4){__uint_as_float(xw.x << 16), __uint_as_float(xw.x & 0xffff0000u), __uint_as_float(xw.y << 16), __uint_as_float(xw.y & 0xffff0000u)} + pscale * *(const LAS f32x4*)(pvt + 2048 + 256 * j + 4 * lane) * (y * ry); __builtin_nontemporal_store(ov_, (f32x4*)op); } }
        ci0 = ni0; ci1 = ni1; cg0 = ng0; cg1 = ng1; csu0 = nsu0; csu1 = nsu1; csv0 = nsv0; csv1 = nsv1;
    }
}
#define CE_DESC(a, b) do { const float _t = fmaxf(a, b); b = fminf(a, b); a = _t; } while (0)
__device__ __forceinline__ void sort16_desc(float (&v)[16]) {
#pragma unroll
    for (int k = 2; k <= 16; k <<= 1)
#pragma unroll
        for (int j = k >> 1; j > 0; j >>= 1)
#pragma unroll
            for (int i = 0; i < 16; ++i) { const int l = i ^ j; if (l > i) { if ((i & k) == 0 || k == 16) CE_DESC(v[i], v[l]); else CE_DESC(v[l], v[i]); } }
}
__device__ __forceinline__ void merge16_desc(float (&a)[16], const float (&b)[16]) {
#pragma unroll
    for (int i = 0; i < 16; ++i) a[i] = fmaxf(a[i], b[15 - i]);
#pragma unroll
    for (int j = 8; j > 0; j >>= 1)
#pragma unroll
        for (int i = 0; i < 16; ++i) { const int l = i ^ j; if (l > i) CE_DESC(a[i], a[l]); }
}
#define CE2_DESC(va, pa, vb, pb) do { const bool _c = (va) >= (vb); const float _tv = _c ? (va) : (vb), _tw = _c ? (vb) : (va); const int _tp = _c ? (pa) : (pb), _tq = _c ? (pb) : (pa); va = _tv; vb = _tw; pa = _tp; pb = _tq; } while (0)
template <int N> __device__ __forceinline__ void bitonic_merge_desc2(float (&v)[N], int (&p)[N]) {
#pragma unroll
    for (int j = N / 2; j > 0; j >>= 1)
#pragma unroll
        for (int i = 0; i < N; ++i) { const int l = i ^ j; if (l > i) CE2_DESC(v[i], p[i], v[l], p[l]); }
}
__device__ __forceinline__ void merge16_desc2(float (&a)[16], int (&pa)[16], const float (&b)[16], const int (&pb)[16]) {
#pragma unroll
    for (int i = 0; i < 16; ++i) { const bool c = a[i] >= b[15 - i]; pa[i] = c ? pa[i] : pb[15 - i]; a[i] = c ? a[i] : b[15 - i]; }
    bitonic_merge_desc2<16>(a, pa);
}
__device__ __forceinline__ void sort8_desc2(float (&v)[8], int (&p)[8]) {
#pragma unroll
    for (int k = 2; k <= 8; k <<= 1)
#pragma unroll
        for (int j = k >> 1; j > 0; j >>= 1)
#pragma unroll
            for (int i = 0; i < 8; ++i) { const int l = i ^ j; if (l > i) { if ((i & k) == 0 || k == 8) CE2_DESC(v[i], p[i], v[l], p[l]); else CE2_DESC(v[l], p[l], v[i], p[i]); } }
}
constexpr int RT_KROW = 272;
__device__ __forceinline__ void route_half(float (&top)[16], LAS const unsigned char* keys_lds, const bf16_t* __restrict__ qrow, int r32, int hi) {
    bf16x8 qf[8]; float ss = 0.f;
#pragma unroll
    for (int ks = 0; ks < 8; ++ks) { qf[ks] = __builtin_nontemporal_load((const bf16x8*)(qrow + 16 * ks + 8 * hi));
#pragma unroll
        for (int j = 0; j < 8; ++j) { const float f = bf2f((bf16_t)qf[ks][j]); ss += f * f; } }
    ss += __shfl_xor(ss, 32);
    const float rn = rsqrtf(ss * (1.f / 128.f) + EPS);
    f32x16 acc[4];
#pragma unroll
    for (int kt = 0; kt < 4; ++kt) {
#pragma unroll
        for (int r = 0; r < 16; ++r) acc[kt][r] = 0.f;
#pragma unroll
        for (int ks = 0; ks < 8; ++ks) { const bf16x8 kf = *(LAS const bf16x8*)(keys_lds + (32 * kt + r32) * RT_KROW + (16 * ks + 8 * hi) * 2);
            acc[kt] = __builtin_amdgcn_mfma_f32_32x32x16_bf16(kf, qf[ks], acc[kt], 0, 0, 0); }
        __builtin_amdgcn_sched_barrier(0);
    }
    const unsigned hi4 = (unsigned)hi << 2;
    float g[4][16];
#pragma unroll
    for (int kt = 0; kt < 4; ++kt)
#pragma unroll
        for (int r = 0; r < 16; ++r) { const unsigned base = (unsigned)(32 * kt + (r & 3) + 8 * (r >> 2)); g[kt][r] = __uint_as_float((__float_as_uint(acc[kt][r] * rn) & 0xFFFFFF80u) | base); }
#pragma unroll
    for (int kt = 0; kt < 4; ++kt) sort16_desc(g[kt]);
    merge16_desc(g[0], g[1]); merge16_desc(g[2], g[3]); merge16_desc(g[0], g[2]);
    float o[16];
#pragma unroll
    for (int i = 0; i < 16; ++i) { g[0][i] = __uint_as_float(__float_as_uint(g[0][i]) | hi4); o[i] = __shfl_xor(g[0][i], 32); }
    merge16_desc(g[0], o);
#pragma unroll
    for (int i = 0; i < 16; ++i) top[i] = g[0][i];
}
__device__ __forceinline__ void route_final(const float (&A)[16], const float (&B)[16], LAS unsigned char* tab, int* idx_out, float* gate_out, bool writer) {
    {
        unsigned w[8];
#pragma unroll
        for (int q = 0; q < 4; ++q) {
            w[q] = (__float_as_uint(A[4 * q]) & 127u) | ((__float_as_uint(A[4 * q + 1]) & 127u) << 8) | ((__float_as_uint(A[4 * q + 2]) & 127u) << 16) | ((__float_as_uint(A[4 * q + 3]) & 127u) << 24);
            w[4 + q] = (__float_as_uint(B[4 * q]) & 127u) | ((__float_as_uint(B[4 * q + 1]) & 127u) << 8) | ((__float_as_uint(B[4 * q + 2]) & 127u) << 16) | ((__float_as_uint(B[4 * q + 3]) & 127u) << 24);
        }
        *(LAS u32x4*)(tab) = (u32x4){w[0], w[1], w[2], w[3]}; *(LAS u32x4*)(tab + 16) = (u32x4){w[4], w[5], w[6], w[7]};
    }
    const float NEG = -INFINITY;
#define CAND(i, j) __uint_as_float((__float_as_uint(A[i] + B[j]) & 0xFFFFFF00u) | (unsigned)(((i) << 4) | (j)))
    float m1[16], m2[16], m3[16];
#pragma unroll
    for (int j = 0; j < 16; ++j) m1[j] = CAND(0, j);
#pragma unroll
    for (int i = 0; i < 16; ++i) m2[i] = (i < 15) ? CAND((i < 15 ? i + 1 : 0), 0) : NEG;
    merge16_desc(m1, m2);
    __builtin_amdgcn_sched_barrier(0);
#pragma unroll
    for (int j = 0; j < 16; ++j) m3[j] = (j < 7) ? CAND(1, (j < 7 ? j + 1 : 0)) : NEG;
#pragma unroll
    for (int i = 0; i < 16; ++i) m2[i] = (i < 6) ? CAND((i < 6 ? i + 2 : 0), 1) : NEG;
    merge16_desc(m3, m2);
    __builtin_amdgcn_sched_barrier(0);
    m2[0] = CAND(2, 2); m2[1] = CAND(2, 3); m2[2] = CAND(2, 4); m2[3] = CAND(3, 2); m2[4] = CAND(4, 2); m2[5] = CAND(3, 3);
#pragma unroll
    for (int i = 6; i < 16; ++i) m2[i] = NEG;
    sort16_desc(m2);
    merge16_desc(m3, m2);
    merge16_desc(m1, m3);
    __builtin_amdgcn_sched_barrier(0);
#undef CAND
    float e[16], den = 0.f; int ex[16];
#pragma unroll
    for (int i = 0; i < 16; ++i) { e[i] = __expf(m1[i] - m1[0]); den += e[i]; const unsigned r = __float_as_uint(m1[i]) & 255u; ex[i] = (int)tab[r >> 4] * 128 + (int)tab[16 + (r & 15u)]; }
    const float inv = 1.f / den;
    if (writer) {
#pragma unroll
        for (int i = 0; i < 4; ++i) {
            u32x4 w;
#pragma unroll
            for (int c = 0; c < 4; ++c) w[c] = (unsigned)ex[4 * i + c] | ((__float_as_uint(e[4 * i + c] * inv) + 0x8000u) & 0xFFFF0000u);
            *(u32x4*)(idx_out + 4 * i) = w; }
        (void)gate_out;
    }
}

namespace fa {
typedef short s16x4 __attribute__((ext_vector_type(4)));
constexpr int SLOT_V = 8192, SLOT_F = 16384, SLOT_BYTES = 16384 + 256;
constexpr int LDS_WS = 2 * SLOT_BYTES, LDS_OST = LDS_WS + 8 * 64 * 4, LDS_TOTAL = LDS_OST + 8 * 4096;
__device__ __forceinline__ int crow(int r, int hi) { return (r & 3) + 8 * (r >> 2) + 4 * hi; }
__device__ __forceinline__ void attn_unit(LAS unsigned char* lds, const bf16_t* __restrict__ PROJ, const float* __restrict__ F2T, bf16_t* OCAT, int b, int h, int qb, float kmax) {
    const int tid = ptid(), lane = tid & 63, r32 = lane & 31, hi = lane >> 5; const int wid = __builtin_amdgcn_readfirstlane(tid >> 6);
    const size_t rowbase = (size_t)b * SEQ; const int q0 = qb * 256;
    const bf16_t* Qw = PROJ + (rowbase + q0 + wid * 32) * NPROJ + C_Q + h * 64;
    const bf16_t* Kh = PROJ + rowbase * NPROJ + C_K + h * 64;
    const bf16_t* Vh = PROJ + rowbase * NPROJ + C_V + h * 64;
    const float* Fh = F2T + (size_t)(b * 8 + h) * SEQ;
    LAS float* wsf = (LAS float*)(lds + LDS_WS) + wid * 64;
    bf16x8 qr[4];
#pragma unroll
    for (int d0 = 0; d0 < 4; ++d0) qr[d0] = *(const bf16x8*)(Qw + (size_t)r32 * NPROJ + d0 * 16 + hi * 8);
    const float Fq = Fh[q0 + wid * 32 + r32];
    const int NT = 4 * qb + 4;
    int t0; float c0;
    {
        float qs = 0.f;
#pragma unroll
        for (int d0 = 0; d0 < 4; ++d0)
#pragma unroll
            for (int j = 0; j < 8; ++j) { const float f = bf2f((bf16_t)qr[d0][j]); qs += f * f; }
        qs += __shfl_xor(qs, 32);
        qs = wave_max(qs);
        if (lane == 0) wsf[0] = qs;
        __syncthreads();
        float qm = 0.f;
#pragma unroll
        for (int w = 0; w < 8; ++w) qm = fmaxf(qm, ((LAS float*)(lds + LDS_WS))[w * 64]);
        c0 = sqrtf(qm) * kmax;
        const float bound = 2.f * c0 + Fh[q0] + 40.f;
        const bool skip = (lane < NT - 4) && (bound - Fh[64 * lane + 63] < 0.f);
        const unsigned long long bal = __ballot(skip);
        t0 = __builtin_amdgcn_readfirstlane((int)__builtin_ctzll(~bal));
        __syncthreads();
    }
    const int krow = 8 * wid + (lane >> 3), kch = lane & 7;
    const bf16_t* ksrc = Kh + (size_t)krow * NPROJ + kch * 8;
    const int kdst = krow * 128 + ((kch ^ (krow & 7)) * 16);
    const bf16_t* vsrc = Vh + (size_t)(16 * (wid & 3) + (lane >> 2)) * NPROJ + (wid >> 2) * 32 + (lane & 3) * 8;
    const int sdst = wid * 1024 + lane * 16;
    u32x4 kreg = *(const u32x4*)(ksrc + (size_t)t0 * 64 * NPROJ), vreg = *(const u32x4*)(vsrc + (size_t)t0 * 64 * NPROJ);
    float freg = (wid == 0) ? Fh[t0 * 64 + lane] : 0.f;
    *(LAS u32x4*)(lds + kdst) = kreg; *(LAS u32x4*)(lds + SLOT_V + sdst) = vreg; if (wid == 0) *(LAS float*)(lds + SLOT_F + lane * 4) = freg;
    if (t0 + 1 < NT) { kreg = *(const u32x4*)(ksrc + (size_t)(t0 + 1) * 64 * NPROJ); vreg = *(const u32x4*)(vsrc + (size_t)(t0 + 1) * 64 * NPROJ); if (wid == 0) freg = Fh[(t0 + 1) * 64 + lane]; }
    __syncthreads();
    float l = 0.f; f32x16 o[2]; const float Fqs = Fq - c0;
#pragma unroll
    for (int r = 0; r < 16; ++r) { o[0][r] = 0.f; o[1][r] = 0.f; }
    const int qrel = wid * 32 + r32;
    int cur = 0;
    for (int t = t0; t < NT; ++t) {
        const bool more = (t + 1 < NT);
        u32x4 kreg2 = kreg, vreg2 = vreg; float freg2 = freg;
        if (t + 2 < NT) { kreg2 = *(const u32x4*)(ksrc + (size_t)(t + 2) * 64 * NPROJ); vreg2 = *(const u32x4*)(vsrc + (size_t)(t + 2) * 64 * NPROJ); if (wid == 0) freg2 = Fh[(t + 2) * 64 + lane]; }
        LAS unsigned char* slot = lds + cur * SLOT_BYTES;
        f32x16 p0, p1;
        { const LAS float* fk = (const LAS float*)(slot + SLOT_F);
#pragma unroll
          for (int g = 0; g < 4; ++g) { const f32x4 a = *(const LAS f32x4*)(fk + 8 * g + 4 * hi), c = *(const LAS f32x4*)(fk + 32 + 8 * g + 4 * hi);
#pragma unroll
              for (int i = 0; i < 4; ++i) { p0[4 * g + i] = Fqs - a[i]; p1[4 * g + i] = Fqs - c[i]; } } }
        { const LAS unsigned char* kb = slot + r32 * 128; const int sw = r32 & 7;
#pragma unroll
          for (int d0 = 0; d0 < 4; ++d0) { const int co = ((2 * d0 + hi) ^ sw) * 16; const bf16x8 b0 = *(const LAS bf16x8*)(kb + co), b1 = *(const LAS bf16x8*)(kb + co + 4096);
              p0 = __builtin_amdgcn_mfma_f32_32x32x16_bf16(b0, qr[d0], p0, 0, 0, 0); p1 = __builtin_amdgcn_mfma_f32_32x32x16_bf16(b1, qr[d0], p1, 0, 0, 0); } }
        const int jb = t - (NT - 4);
        if (jb >= 0) { const int kb0 = 64 * jb + 4 * hi;
#pragma unroll
            for (int r = 0; r < 16; ++r) { const int kv = kb0 + (r & 3) + 8 * (r >> 2); if (kv > qrel) p0[r] = -INFINITY; if (kv + 32 > qrel) p1[r] = -INFINITY; } }
        float rs = 0.f;
#pragma unroll
        for (int r = 0; r < 16; ++r) { p0[r] = __builtin_amdgcn_exp2f(p0[r]); p1[r] = __builtin_amdgcn_exp2f(p1[r]); rs += p0[r] + p1[r]; }
        l += rs;
        u32x4 pw0, pw1, pw2, pw3;
        pw0 = (u32x4){cvt_pk_bf16(p0[0], p0[1]), cvt_pk_bf16(p0[2], p0[3]), cvt_pk_bf16(p0[4], p0[5]), cvt_pk_bf16(p0[6], p0[7])};
        pw1 = (u32x4){cvt_pk_bf16(p0[8], p0[9]), cvt_pk_bf16(p0[10], p0[11]), cvt_pk_bf16(p0[12], p0[13]), cvt_pk_bf16(p0[14], p0[15])};
        pw2 = (u32x4){cvt_pk_bf16(p1[0], p1[1]), cvt_pk_bf16(p1[2], p1[3]), cvt_pk_bf16(p1[4], p1[5]), cvt_pk_bf16(p1[6], p1[7])};
        pw3 = (u32x4){cvt_pk_bf16(p1[8], p1[9]), cvt_pk_bf16(p1[10], p1[11]), cvt_pk_bf16(p1[12], p1[13]), cvt_pk_bf16(p1[14], p1[15])};
        { const int vb = (int)(unsigned)(size_t)(slot + SLOT_V) + ((lane >> 4) & 1) * 32 + (lane & 3) * 8 + (4 * hi + ((lane & 15) >> 2)) * 64;
#pragma unroll
          for (int d0 = 0; d0 < 2; ++d0) { s16x4 lo4[4], hi4[4];
#pragma unroll
              for (int ks = 0; ks < 4; ++ks) {
                  asm volatile("ds_read_b64_tr_b16 %0,%1 offset:%c2" : "=&v"(lo4[ks]) : "v"(vb), "i"(d0 * 4096 + ks * 1024) : "memory");
                  asm volatile("ds_read_b64_tr_b16 %0,%1 offset:%c2" : "=&v"(hi4[ks]) : "v"(vb), "i"(d0 * 4096 + ks * 1024 + 512) : "memory"); }
              asm volatile("s_waitcnt lgkmcnt(0)" ::: "memory"); __builtin_amdgcn_sched_barrier(0);
#define FA_PK(k) (bf16x8){lo4[k][0], lo4[k][1], lo4[k][2], lo4[k][3], hi4[k][0], hi4[k][1], hi4[k][2], hi4[k][3]}
              o[d0] = __builtin_amdgcn_mfma_f32_32x32x16_bf16(__builtin_bit_cast(bf16x8, pw0), FA_PK(0), o[d0], 0, 0, 0);
              o[d0] = __builtin_amdgcn_mfma_f32_32x32x16_bf16(__builtin_bit_cast(bf16x8, pw1), FA_PK(1), o[d0], 0, 0, 0);
              o[d0] = __builtin_amdgcn_mfma_f32_32x32x16_bf16(__builtin_bit_cast(bf16x8, pw2), FA_PK(2), o[d0], 0, 0, 0);
              o[d0] = __builtin_amdgcn_mfma_f32_32x32x16_bf16(__builtin_bit_cast(bf16x8, pw3), FA_PK(3), o[d0], 0, 0, 0);
#undef FA_PK
          } }
        if (more) { LAS unsigned char* nslot = lds + (cur ^ 1) * SLOT_BYTES;
            *(LAS u32x4*)(nslot + kdst) = kreg; *(LAS u32x4*)(nslot + SLOT_V + sdst) = vreg; if (wid == 0) *(LAS float*)(nslot + SLOT_F + lane * 4) = freg; }
        __syncthreads();
        cur ^= 1; kreg = kreg2; vreg = vreg2; freg = freg2;
    }
    l += __shfl_xor(l, 32);
    if (hi == 0) wsf[32 + r32] = l;
    asm volatile("s_waitcnt lgkmcnt(0)" ::: "memory");
    float rli[16];
#pragma unroll
    for (int r = 0; r < 16; ++r) rli[r] = __builtin_amdgcn_rcpf(wsf[32 + crow(r, hi)]);
    if (G2F8) {
        unsigned char* Ow8 = (unsigned char*)OCAT + (rowbase + q0 + wid * 32) * 1024 + h * 64;
        LAS unsigned char* stg8 = (LAS unsigned char*)(lds + LDS_OST) + wid * 4096;
#pragma unroll
        for (int r = 0; r < 16; ++r) { const int orow = crow(r, hi); const int p = __builtin_amdgcn_cvt_pk_fp8_f32(o[0][r] * rli[r], o[1][r] * rli[r], 0, false);
            stg8[orow * 64 + r32] = (unsigned char)(p & 0xff); stg8[orow * 64 + 32 + r32] = (unsigned char)((p >> 8) & 0xff); }
        asm volatile("s_waitcnt lgkmcnt(0)" ::: "memory");
#pragma unroll
        for (int i = 0; i < 2; ++i) { const int row = i * 16 + (lane >> 2), ch = lane & 3; const u32x4 v = *(const LAS u32x4*)(stg8 + row * 64 + ch * 16); *(u32x4*)(Ow8 + (size_t)row * 1024 + ch * 16) = v; }
    } else {
    bf16_t* Ow = OCAT + (rowbase + q0 + wid * 32) * 1024 + h * 64;
    LAS bf16_t* stg = (LAS bf16_t*)(lds + LDS_OST) + wid * 2048;
#pragma unroll
    for (int r = 0; r < 16; ++r) { const int orow = crow(r, hi);
#pragma unroll
        for (int d0 = 0; d0 < 2; ++d0) stg[orow * 64 + d0 * 32 + r32] = f2bf(F8(2, o[d0][r] * rli[r])); }
    asm volatile("s_waitcnt lgkmcnt(0)" ::: "memory");
#pragma unroll
    for (int i = 0; i < 4; ++i) { const int row = i * 8 + (lane >> 3), ch = lane & 7; const u32x4 v = *(const LAS u32x4*)(stg + row * 64 + ch * 8); *(u32x4*)(Ow + (size_t)row * 1024 + ch * 8) = v; }
    }
    __syncthreads();
}
}

namespace hg {
constexpr int P272 = 272, P144 = 144;
constexpr int L_RAW = 2048, L_RLF = L_RAW, L_RQ = L_RAW + 16384, L_RKK = L_RAW + 32768, L_RI = L_RAW + 49152;
constexpr int L_QJ = 2048, L_KH = L_QJ + 160 * P272;
constexpr int L_KT = L_RI + 64 * P272, L_IT = L_KT + 128 * P144, L_P = L_IT + 128 * P144, L_SEGT = L_P + 64 * P144  , L_END = L_SEGT + 4096;
static_assert(L_KH + 64 * P272 <= L_KT && L_END <= RING_BYTES, "hgrn LDS");
__device__ __forceinline__ int crow(int r, int hi) { return (r & 3) + 8 * (r >> 2) + 4 * hi; }
__device__ __forceinline__ int qj_row0(int j) { return (j == 0) ? 0 : (j == 1) ? 64 : (j == 2) ? 112 : 144; }
struct RawRegs { u32x4 lf[2], q[2], iv[2]; };
__device__ __forceinline__ void raw_load(RawRegs& R, const bf16_t* __restrict__ PROJ, const bf16_t* __restrict__ KK, int unit, int tid) {
    const int bh = unit >> 6, cch = unit & 63, b = bh >> 2, h = bh & 3; const size_t row0 = (size_t)b * SEQ + cch * 64;
#pragma unroll
    for (int it = 0; it < 2; ++it) { const int id = tid + 512 * it, t = id >> 4, ch = id & 15;
        const bf16_t* pr = PROJ + (row0 + t) * NPROJ + h * 128 + 8 * ch;
        R.lf[it] = __builtin_nontemporal_load((const u32x4*)(pr + C_LF)); R.q[it] = __builtin_nontemporal_load((const u32x4*)(pr + C_HQ)); R.iv[it] = __builtin_nontemporal_load((const u32x4*)(pr + C_HI));
        }
}
template <bool DRY> __device__ __forceinline__ void pass_a_all(LAS unsigned char* lds, bf16_t* PROJ, const bf16_t* __restrict__ KK, bf16_t* HST, float* HD, int u0, int ustep, int uend) {
    const int tid = ptid(), lane = tid & 63, r32 = lane & 31, hi = lane >> 5; const int wid = __builtin_amdgcn_readfirstlane(tid >> 6);
    LAS float* segt = (LAS float*)(lds + L_SEGT);
    RawRegs R;
    if (u0 < uend) raw_load(R, PROJ, KK, u0, tid);
    for (int unit = u0; unit < uend; unit += ustep) {
        const int bh = unit >> 6, cch = unit & 63, b = bh >> 2, h = bh & 3;
        const size_t row0 = (size_t)b * SEQ + cch * 64;
#pragma unroll
        for (int it = 0; it < 2; ++it) { const int id = tid + 512 * it, t = id >> 4, ch = id & 15;
            *(LAS u32x4*)(lds + L_RLF + t * 256 + ch * 16) = R.lf[it]; *(LAS u32x4*)(lds + L_RQ + t * 256 + ch * 16) = R.q[it];
            *(LAS u32x4*)(lds + L_RI + t * P272 + ch * 16) = R.iv[it]; }
        __syncthreads();
        if (unit + ustep < uend) raw_load(R, PROJ, KK, unit + ustep, tid);
        const int kp = tid & 63, sg8 = wid;
        float Aa[8][2], qv[8][2], kv[8][2];
        { float run0 = 0.f, run1 = 0.f;
#pragma unroll
          for (int i = 0; i < 8; ++i) { const int off = (8 * sg8 + i) * 256 + kp * 4;
              const unsigned wl = *(const LAS unsigned*)(lds + L_RLF + off), wq = *(const LAS unsigned*)(lds + L_RQ + off);
              const float l0 = h2f((unsigned short)(wl & 0xffffu)), l1 = h2f((unsigned short)(wl >> 16));
              run0 += l0; run1 += l1; Aa[i][0] = run0; Aa[i][1] = run1;
              qv[i][0] = __uint_as_float(wq << 16); qv[i][1] = __uint_as_float(wq & 0xffff0000u); kv[i][0] = 1.f - __expf(l0); kv[i][1] = 1.f - __expf(l1); }
          *(LAS f32x2_t*)(segt + sg8 * 128 + 2 * kp) = (f32x2_t){run0, run1}; }
        { const int tp = tid & 31, vc = tid >> 5;
            const bf16x8 r0 = *(const LAS bf16x8*)(lds + L_RI + (2 * tp) * P272 + vc * 16), r1 = *(const LAS bf16x8*)(lds + L_RI + (2 * tp + 1) * P272 + vc * 16);
#pragma unroll
            for (int e8 = 0; e8 < 8; ++e8) *(LAS unsigned*)(lds + L_IT + (8 * vc + e8) * P144 + tp * 4) = (unsigned)(unsigned short)r0[e8] | ((unsigned)(unsigned short)r1[e8] << 16); }
        __syncthreads();
        float E[4][2], pre[2] = {0.f, 0.f};
        { float s0 = 0.f, s1 = 0.f;
#pragma unroll
          for (int sgi = 0; sgi < 8; ++sgi) { const f32x2_t v = *(const LAS f32x2_t*)(segt + sgi * 128 + 2 * kp); if (sgi < sg8) { pre[0] += v.x; pre[1] += v.y; } s0 += v.x; s1 += v.y; if (sgi & 1) { E[sgi >> 1][0] = s0; E[sgi >> 1][1] = s1; } } }
        const int jo = sg8 >> 1;
        float Eown[2];
#pragma unroll
        for (int k2 = 0; k2 < 2; ++k2) Eown[k2] = (jo == 0) ? E[0][k2] : (jo == 1) ? E[1][k2] : (jo == 2) ? E[2][k2] : E[3][k2];
        {
            bf16_t* pq = PROJ + (row0 + 8 * sg8) * NPROJ + C_HQ + h * 128 + 2 * kp;
            unsigned kt[2][4];
            float fj[4][2], f0[2], f3[2];
#pragma unroll
            for (int k2 = 0; k2 < 2; ++k2) { f0[k2] = __expf(Eown[k2]); f3[k2] = __expf(E[3][k2] - Eown[k2]);
#pragma unroll
                for (int j = 0; j < 4; ++j) fj[j][k2] = __expf(Eown[k2] - E[j][k2]); }
#pragma unroll
            for (int i = 0; i < 8; ++i) {
                const int t = 8 * sg8 + i;
                float qe[2], ke1[2];
#pragma unroll
                for (int k2 = 0; k2 < 2; ++k2) { const float A = pre[k2] + Aa[i][k2]; const float e1 = __expf(A - Eown[k2]), r1 = __builtin_amdgcn_rcpf(e1);
                    qe[k2] = qv[i][k2] * e1; ke1[k2] = kv[i][k2] * r1; }
                if (!DRY) *(unsigned*)(pq + (size_t)i * NPROJ) = pk2(qe[0] * f0[0], qe[1] * f0[1]);
#pragma unroll
                for (int j = 0; j < 4; ++j) if (j <= jo) *(LAS unsigned*)(lds + L_QJ + (qj_row0(j) + t - 16 * j) * P272 + kp * 4) = (j == jo) ? pk2(qe[0], qe[1]) : pk2(qe[0] * fj[j][0], qe[1] * fj[j][1]);
                *(LAS unsigned*)(lds + L_KH + t * P272 + kp * 4) = pk2(ke1[0], ke1[1]);
#pragma unroll
                for (int k2 = 0; k2 < 2; ++k2) { const unsigned ke = f2bf(ke1[k2] * f3[k2]); if (i & 1) kt[k2][i >> 1] |= ke << 16; else kt[k2][i >> 1] = ke; }
            }
#pragma unroll
            for (int k2 = 0; k2 < 2; ++k2) *(LAS u32x4*)(lds + L_KT + (2 * kp + k2) * P144 + sg8 * 16) = (u32x4){kt[k2][0], kt[k2][1], kt[k2][2], kt[k2][3]};
            if (sg8 == 0) *(f32x2_t*)(HD + (size_t)unit * 128 + 2 * kp) = (f32x2_t){__expf(E[3][0]), __expf(E[3][1])};
        }
        __syncthreads();
        {
            const int fr = lane & 15, fq = lane >> 4;
#pragma unroll
            for (int bb = 0; bb < 2; ++bb) {
                const int blk = 2 * wid + bb, bi = blk >> 2, bj = blk & 3;
                f32x4 acc = (f32x4){0.f, 0.f, 0.f, 0.f};
                if (bj <= bi) {
                    const LAS unsigned char* ap = lds + L_QJ + (qj_row0(bj) + 16 * (bi - bj) + fr) * P272 + fq * 16;
                    const LAS unsigned char* bp = lds + L_KH + (16 * bj + fr) * P272 + fq * 16;
#pragma unroll
                    for (int s = 0; s < 4; ++s) acc = __builtin_amdgcn_mfma_f32_16x16x32_bf16(*(const LAS bf16x8*)(ap + s * 64), *(const LAS bf16x8*)(bp + s * 64), acc, 0, 0, 0);
                }
#pragma unroll
                for (int r = 0; r < 4; ++r) { const int tl = 4 * fq + r; float v = acc[r]; if (bi == bj && fr > tl) v = 0.f;
                    *(LAS bf16_t*)(lds + L_P + (16 * bi + tl) * P144 + (16 * bj + fr) * 2) = f2bf(v); }
            }
        }
        __syncthreads();
        constexpr int L_SU = L_QJ, L_SO = L_QJ + 128 * P272;
        {
            const int vt = wid & 3, tt = wid >> 2;
            f32x16 acc;
#pragma unroll
            for (int r = 0; r < 16; ++r) acc[r] = 0.f;
#pragma unroll
            for (int ks = 0; ks < 4; ++ks) acc = __builtin_amdgcn_mfma_f32_32x32x16_bf16(*(const LAS bf16x8*)(lds + L_IT + (32 * vt + r32) * P144 + (16 * ks + 8 * hi) * 2), *(const LAS bf16x8*)(lds + L_P + (32 * tt + r32) * P144 + (16 * ks + 8 * hi) * 2), acc, 0, 0, 0);
#pragma unroll
            for (int g = 0; g < 4; ++g) { u32x2 w; w.x = cvt_pk_bf16(acc[4 * g], acc[4 * g + 1]); w.y = cvt_pk_bf16(acc[4 * g + 2], acc[4 * g + 3]); *(LAS u32x2*)(lds + L_SO + (32 * tt + r32) * P272 + (32 * vt + 8 * g + 4 * hi) * 2) = w; }
        }
        {
            const int kt_ = wid & 3;
#pragma unroll
            for (int vv = 0; vv < 2; ++vv) { const int vt = 2 * (wid >> 2) + vv;
                f32x16 acc;
#pragma unroll
                for (int r = 0; r < 16; ++r) acc[r] = 0.f;
#pragma unroll
                for (int ks = 0; ks < 4; ++ks) acc = __builtin_amdgcn_mfma_f32_32x32x16_bf16(*(const LAS bf16x8*)(lds + L_KT + (32 * kt_ + r32) * P144 + (16 * ks + 8 * hi) * 2), *(const LAS bf16x8*)(lds + L_IT + (32 * vt + r32) * P144 + (16 * ks + 8 * hi) * 2), acc, 0, 0, 0);
#pragma unroll
                for (int g = 0; g < 4; ++g) {
                    if (HST8) *(LAS unsigned*)(lds + L_SU + (32 * vt + r32) * P272 + (32 * kt_ + 8 * g + 4 * hi)) = pk4f8(acc[4 * g], acc[4 * g + 1], acc[4 * g + 2], acc[4 * g + 3]);
                    else { u32x2 w; w.x = cvt_pk_bf16(acc[4 * g], acc[4 * g + 1]); w.y = cvt_pk_bf16(acc[4 * g + 2], acc[4 * g + 3]); *(LAS u32x2*)(lds + L_SU + (32 * vt + r32) * P272 + (32 * kt_ + 8 * g + 4 * hi) * 2) = w; } } }
        }
        __syncthreads();
#pragma unroll
        for (int it = 0; it < (HST8 ? 2 : 4); ++it) { const int id = tid + 512 * it;
            if (HST8) { const int v = id >> 3, ch = id & 7; *(u32x4*)((unsigned char*)HST + (size_t)unit * 16384 + (size_t)id * 16) = *(const LAS u32x4*)(lds + L_SU + v * P272 + ch * 16); }
            else { const int v = id >> 4, ch = id & 15; *(u32x4*)(HST + (size_t)unit * 16384 + (size_t)id * 8) = *(const LAS u32x4*)(lds + L_SU + v * P272 + ch * 16); } }
        if (!DRY) {
#pragma unroll
            for (int it = 0; it < 2; ++it) { const int id = tid + 512 * it, t = id >> 4, ch = id & 15;
                *(u32x4*)(PROJ + (row0 + t) * NPROJ + C_LF + h * 128 + 8 * ch) = *(const LAS u32x4*)(lds + L_SO + t * P272 + ch * 16); }
        }
        __syncthreads();
    }
}
__device__ __forceinline__ void pass_b(bf16_t* HST, const float* __restrict__ HD, int grp) {
    const int bh = grp >> 12, rem = grp & 4095;
    float s0 = 0.f, s1 = 0.f, s2 = 0.f, s3 = 0.f;
    bf16_t* p = HST + (size_t)bh * 64 * 16384 + rem * 4;
    const float* pd = HD + (size_t)bh * 64 * 128 + (rem & 31) * 4;
#pragma unroll 8
    for (int cch = 0; cch < 64; ++cch) {
        const u32x2 u = *(const u32x2*)(p + (size_t)cch * 16384); const f32x4 d = *(const f32x4*)(pd + cch * 128);
        u32x2 w; w.x = pk2(s0, s1); w.y = pk2(s2, s3); *(u32x2*)(p + (size_t)cch * 16384) = w;
        s0 = d.x * s0 + __uint_as_float(u.x << 16); s1 = d.y * s1 + __uint_as_float(u.x & 0xffff0000u);
        s2 = d.z * s2 + __uint_as_float(u.y << 16); s3 = d.w * s3 + __uint_as_float(u.y & 0xffff0000u);
    }
}
__device__ __forceinline__ void pass_b_full(bf16_t* HST, const float* __restrict__ HD, int grp) {
    const int bh = grp >> 12, rem = grp & 4095;
    bf16_t* p = HST + (size_t)bh * 64 * 16384 + rem * 4;
    const float* pd = HD + (size_t)bh * 64 * 128 + (rem & 31) * 4;
    constexpr int PB = 16;
    float s0 = 0.f, s1 = 0.f, s2 = 0.f, s3 = 0.f;
#pragma unroll 1
    for (int part = 0; part < 64 / PB; ++part) {
        u32x2 u[PB]; f32x4 dd[PB];
#pragma unroll
        for (int c = 0; c < PB; ++c) u[c] = *(const u32x2*)(p + (size_t)c * 16384);
#pragma unroll
        for (int c = 0; c < PB; ++c) dd[c] = *(const f32x4*)(pd + c * 128);
        __builtin_amdgcn_sched_barrier(0);
#pragma unroll
        for (int c = 0; c < PB; ++c) {
            const f32x4 d = dd[c];
            u32x2 w; w.x = pk2(s0, s1); w.y = pk2(s2, s3); *(u32x2*)(p + (size_t)c * 16384) = w;
            s0 = d.x * s0 + __uint_as_float(u[c].x << 16); s1 = d.y * s1 + __uint_as_float(u[c].x & 0xffff0000u);
            s2 = d.z * s2 + __uint_as_float(u[c].y << 16); s3 = d.w * s3 + __uint_as_float(u[c].y & 0xffff0000u);
        }
        p += (size_t)PB * 16384; pd += PB * 128;
    }
}
__device__ __forceinline__ void pass_b_lds(bf16_t* HST, const LAS float* dl, int grp) {
    const int bh = grp >> 12, rem = grp & 4095;
    bf16_t* p = HST + (size_t)bh * 64 * 16384 + rem * 4;
    const LAS float* pd = dl + (rem & 31) * 4;
    float s0 = 0.f, s1 = 0.f, s2 = 0.f, s3 = 0.f;
#pragma unroll 1
    for (int half = 0; half < 2; ++half) {
        u32x2 u[32];
#pragma unroll
        for (int c = 0; c < 32; ++c) u[c] = *(const u32x2*)(p + (size_t)c * 16384);
#pragma unroll
        for (int c = 0; c < 32; ++c) {
            const f32x4 d = *(const LAS f32x4*)(pd + c * 128);
            u32x2 w; w.x = pk2(s0, s1); w.y = pk2(s2, s3); *(u32x2*)(p + (size_t)c * 16384) = w;
            s0 = d.x * s0 + __uint_as_float(u[c].x << 16); s1 = d.y * s1 + __uint_as_float(u[c].x & 0xffff0000u);
            s2 = d.z * s2 + __uint_as_float(u[c].y << 16); s3 = d.w * s3 + __uint_as_float(u[c].y & 0xffff0000u);
        }
        p += (size_t)32 * 16384; pd += 32 * 128;
    }
}
__device__ __forceinline__ void pass_b8_lds(unsigned char* HST, const LAS float* dl, int bh  , int rem) {
    bh = __builtin_amdgcn_readfirstlane(bh);
    unsigned char* pb = HST + (size_t)bh * 64 * 16384;
    const LAS float* pd = dl + (rem & 15) * 8;
    float s[8];
#pragma unroll
    for (int i = 0; i < 8; ++i) s[i] = 0.f;
#pragma unroll 1
    for (int part = 0; part < 4; ++part) {
        unsigned vo = (unsigned)rem * 8u; asm volatile("" : "+v"(vo));
        u32x2 u[16];
#pragma unroll
        for (int c = 0; c < 16; ++c) u[c] = *(const u32x2*)(pb + (size_t)c * 16384 + vo);
#pragma unroll
        for (int c = 0; c < 16; ++c) {
            const f32x4 d0 = *(const LAS f32x4*)(pd + c * 128), d1 = *(const LAS f32x4*)(pd + c * 128 + 4);
            u32x2 w; w.x = pk4f8(s[0], s[1], s[2], s[3]); w.y = pk4f8(s[4], s[5], s[6], s[7]); *(u32x2*)(pb + (size_t)c * 16384 + vo) = w;
            s[0] = d0.x * s[0] + __builtin_amdgcn_cvt_f32_fp8((int)u[c].x, 0); s[1] = d0.y * s[1] + __builtin_amdgcn_cvt_f32_fp8((int)u[c].x, 1);
            s[2] = d0.z * s[2] + __builtin_amdgcn_cvt_f32_fp8((int)u[c].x, 2); s[3] = d0.w * s[3] + __builtin_amdgcn_cvt_f32_fp8((int)u[c].x, 3);
            s[4] = d1.x * s[4] + __builtin_amdgcn_cvt_f32_fp8((int)u[c].y, 0); s[5] = d1.y * s[5] + __builtin_amdgcn_cvt_f32_fp8((int)u[c].y, 1);
            s[6] = d1.z * s[6] + __builtin_amdgcn_cvt_f32_fp8((int)u[c].y, 2); s[7] = d1.w * s[7] + __builtin_amdgcn_cvt_f32_fp8((int)u[c].y, 3);
        }
        pb += (size_t)16 * 16384; pd += 16 * 128;
    }
}
constexpr int CL_PART = 0, CL_ST = 2048, CL_QT = CL_ST + 128 * P272, CL_OI = CL_QT + 64 * P272, CL_SG = CL_OI + 64 * P272, CL_END = CL_SG + 64 * P272;
static_assert(CL_END <= RING_BYTES, "hgrn pass C LDS");
struct CRegs { u32x4 st[4], qt[2], oi[2], sg[2]; };
__device__ __forceinline__ void c_load(CRegs& R, const bf16_t* __restrict__ PROJ, const bf16_t* __restrict__ HST, int unit, int tid) {
    const int bh = unit >> 6, cch = unit & 63, b = bh >> 2, h = bh & 3; const size_t row0 = (size_t)b * SEQ + cch * 64;
#pragma unroll
    for (int it = 0; it < (HST8 ? 2 : 4); ++it) R.st[it] = HST8 ? *(const u32x4*)((const unsigned char*)HST + (size_t)unit * 16384 + (size_t)(tid + 512 * it) * 16) : *(const u32x4*)(HST + (size_t)unit * 16384 + (size_t)(tid + 512 * it) * 8);
#pragma unroll
    for (int it = 0; it < 2; ++it) { const int id = tid + 512 * it, t = id >> 4, ch = id & 15;
        const bf16_t* pr = PROJ + (row0 + t) * NPROJ + h * 128 + 8 * ch;
        R.qt[it] = __builtin_nontemporal_load((const u32x4*)(pr + C_HQ)); R.oi[it] = __builtin_nontemporal_load((const u32x4*)(pr + C_LF)); R.sg[it] = __builtin_nontemporal_load((const u32x4*)(pr + C_SG)); }
}
__device__ __forceinline__ void pass_c_all(LAS unsigned char* lds, const bf16_t* __restrict__ PROJ, const bf16_t* __restrict__ HST, const float* __restrict__ gn, bf16_t* OCAT, int u0, int ustep, int uend) {
    const int tid = ptid(), lane = tid & 63, r32 = lane & 31, hi = lane >> 5; const int wid = __builtin_amdgcn_readfirstlane(tid >> 6);
    const int vt = wid & 3, tt = wid >> 2, tl = 32 * tt + r32;
    LAS float* part = (LAS float*)(lds + CL_PART);
    CRegs R;
    if (u0 < uend) c_load(R, PROJ, HST, u0, tid);
    int par = 0;
    for (int unit = u0; unit < uend; unit += ustep, par ^= 1) {
        const int bh = unit >> 6, cch = unit & 63, b = bh >> 2, h = bh & 3;
        const size_t row0 = (size_t)b * SEQ + cch * 64;
#pragma unroll
        for (int it = 0; it < (HST8 ? 2 : 4); ++it) { const int id = tid + 512 * it;
            if (HST8) { const int v = id >> 3, ch = id & 7; u32x4 lo, hh;
#pragma unroll
                for (int q = 0; q < 4; ++q) { const int w = (int)R.st[it][q];
                    const unsigned a = pk2(__builtin_amdgcn_cvt_f32_fp8(w, 0), __builtin_amdgcn_cvt_f32_fp8(w, 1)), b = pk2(__builtin_amdgcn_cvt_f32_fp8(w, 2), __builtin_amdgcn_cvt_f32_fp8(w, 3));
                    if (q < 2) { lo[2 * q] = a; lo[2 * q + 1] = b; } else { hh[2 * (q - 2)] = a; hh[2 * (q - 2) + 1] = b; } }
                *(LAS u32x4*)(lds + CL_ST + v * P272 + ch * 32) = lo; *(LAS u32x4*)(lds + CL_ST + v * P272 + ch * 32 + 16) = hh; }
            else { const int v = id >> 4, ch = id & 15; *(LAS u32x4*)(lds + CL_ST + v * P272 + ch * 16) = R.st[it]; } }
#pragma unroll
        for (int it = 0; it < 2; ++it) { const int id = tid + 512 * it, t = id >> 4, ch = id & 15;
            *(LAS u32x4*)(lds + CL_QT + t * P272 + ch * 16) = R.qt[it]; *(LAS u32x4*)(lds + CL_OI + t * P272 + ch * 16) = R.oi[it]; *(LAS u32x4*)(lds + CL_SG + t * P272 + ch * 16) = R.sg[it]; }
        __syncthreads();
        if (unit + ustep < uend) c_load(R, PROJ, HST, unit + ustep, tid);
        f32x16 acc;
#pragma unroll
        for (int g = 0; g < 4; ++g) { const u32x2 w = *(const LAS u32x2*)(lds + CL_OI + tl * P272 + (32 * vt + 8 * g + 4 * hi) * 2);
            acc[4 * g] = __uint_as_float(w.x << 16); acc[4 * g + 1] = __uint_as_float(w.x & 0xffff0000u); acc[4 * g + 2] = __uint_as_float(w.y << 16); acc[4 * g + 3] = __uint_as_float(w.y & 0xffff0000u); }
#pragma unroll
        for (int ks = 0; ks < 8; ++ks) acc = __builtin_amdgcn_mfma_f32_32x32x16_bf16(*(const LAS bf16x8*)(lds + CL_ST + (32 * vt + r32) * P272 + (16 * ks + 8 * hi) * 2), *(const LAS bf16x8*)(lds + CL_QT + tl * P272 + (16 * ks + 8 * hi) * 2), acc, 0, 0, 0);
        float ss = 0.f;
#pragma unroll
        for (int r = 0; r < 16; ++r) ss += acc[r] * acc[r];
        ss += __shfl_xor(ss, 32);
        LAS float* pp = part + par * 256;
        if (hi == 0) pp[vt * 64 + tl] = ss;
        __syncthreads();
        const float rn = rsqrtf((pp[tl] + pp[64 + tl] + pp[128 + tl] + pp[192 + tl]) * (1.f / 128.f) + EPS);
        const float* pg = gn + h * 128 + 32 * vt + 4 * hi;
#pragma unroll
        for (int g = 0; g < 4; ++g) { const u32x2 sw = *(const LAS u32x2*)(lds + CL_SG + tl * P272 + (32 * vt + 8 * g + 4 * hi) * 2); const f32x4 gv = *(const f32x4*)(pg + 8 * g);
            const float f0 = acc[4 * g] * rn * gv.x * __uint_as_float(sw.x << 16), f1 = acc[4 * g + 1] * rn * gv.y * __uint_as_float(sw.x & 0xffff0000u), f2 = acc[4 * g + 2] * rn * gv.z * __uint_as_float(sw.y << 16), f3 = acc[4 * g + 3] * rn * gv.w * __uint_as_float(sw.y & 0xffff0000u);
            if (G2F8) *(LAS unsigned*)(lds + CL_OI + tl * P272 + (32 * vt + 8 * g + 4 * hi)) = pk4f8(f0, f1, f2, f3);
            else { u32x2 w; w.x = cvt_pk_bf16(F8(2, f0), F8(2, f1)); w.y = cvt_pk_bf16(F8(2, f2), F8(2, f3)); *(LAS u32x2*)(lds + CL_OI + tl * P272 + (32 * vt + 8 * g + 4 * hi) * 2) = w; } }
        __syncthreads();
        if (G2F8) { const int t = tid >> 3, ch = tid & 7;
            *(u32x4*)((unsigned char*)OCAT + (row0 + t) * 1024 + 512 + h * 128 + 16 * ch) = *(const LAS u32x4*)(lds + CL_OI + t * P272 + ch * 16); }
        else {
#pragma unroll
        for (int it = 0; it < 2; ++it) { const int id = tid + 512 * it, t = id >> 4, ch = id & 15;
            *(u32x4*)(OCAT + (row0 + t) * 1024 + 512 + h * 128 + 8 * ch) = *(const LAS u32x4*)(lds + CL_OI + t * P272 + ch * 16); }
        }
        __syncthreads();
    }
}
}

__global__ void __launch_bounds__(NTHREADS, 2) mega(Args a) {
    extern __shared__ __attribute__((aligned(16))) unsigned char lds_raw[];
    LAS unsigned char* lds = (LAS unsigned char*)lds_raw;
    volatile LAS unsigned* MISC = (volatile LAS unsigned*)(lds + MISC_OFF);
    const int tid0 = threadIdx.x, wave = __builtin_amdgcn_readfirstlane(tid0 >> 6);
    const int G = gridDim.x, bx = blockIdx.x, vcu = (G % 8 == 0) ? (bx % 8) * (G / 8) + bx / 8 : bx;
    const int gw = vcu * NWAVES + wave, NGW = G * NWAVES;
    unsigned* ctl = (unsigned*)(a.ws + WS_CTL);
    for (int u = tid0; u < (LDS_BYTES - RING_BYTES) / 4; u += NTHREADS) ((LAS unsigned*)(lds + RING_BYTES))[u] = 0u;
    __syncthreads();
    XcdBarrier bar = xcd_barrier_post(ctl + CW_BAR + a.li * XCD_BAR_WORDS, MISC + 8, (unsigned)G);
    const bool hg_member = (G % 8 == 0) ? (bx / 8) < HG_PER_XCD : true;
    const int NHG = (G % 8 == 0) ? 8 * HG_PER_XCD : G, hgi = (G % 8 == 0) ? (bx % 8) * HG_PER_XCD + bx / 8 : bx;
    XcdBarrier hbar = xcd_barrier_post(ctl + CW_BAR2, MISC + 10, (unsigned)NHG, hg_member);
    const int lo = a.ph_lo, hi = a.ph_hi;
    if (TPROBE >= 0 && blockIdx.x == 0 && threadIdx.x == 0) ((unsigned long long*)(ctl + 8192))[0] = __builtin_amdgcn_s_memrealtime();
#ifndef PH_COMPILE
#define PH_COMPILE 0x7FF
#endif
#define IN(k) ((((PH_COMPILE) >> (k)) & 1) && lo <= (k) && (k) < hi)
#define STAMP(i) do { if (TPROBE >= 0 && bx == 0 && tid0 == 0) ((unsigned long long*)(ctl + 8192))[i] = __builtin_amdgcn_s_memrealtime(); } while (0)
#define SEAM(k) do { if (IN(k) && IN((k) + 1)) xcd_barrier(bar); STAMP((k) + 1); } while (0)

    typedef const __attribute__((address_space(4))) Args* KArgs;
#define PHASE_PTRS \
    KArgs ka = (KArgs)__builtin_amdgcn_kernarg_segment_ptr(); asm volatile("" : "+s"(ka)); \
    const int tid = ptid(), lane = tid & 63; (void)lane; \
    unsigned char* ws = ka->ws; (void)ws; \
    const float* x = ka->in[0]; const float* c_in = ka->in[1]; const float* w_ada = ka->in[2]; const float* b_ada = ka->in[3]; \
    const float* pre_mix_g = ka->in[4]; const float* w_in = ka->in[6]; const float* b_fox_f = ka->in[7]; const float* gamma = ka->in[8]; \
    const float* w_out = ka->in[10]; const float* w_q = ka->in[13]; const float* sub_keys = ka->in[14]; const float* U = ka->in[15]; const float* V = ka->in[16]; \
    float* MOD = (float*)(ws + WS_MOD); float* LB = (float*)(ws + WS_LB); float* WFF = (float*)(ws + WS_WFF); \
    bf16_t* WIN = (bf16_t*)(ws + WS_WIN); bf16_t* WOUT = (bf16_t*)(ws + WS_WOUT); bf16_t* WQ = (bf16_t*)(ws + WS_WQ); bf16_t* KEYS = (bf16_t*)(ws + WS_KEYS); \
    float* LOGF = (float*)(ws + WS_F); float* F2T = (float*)(ws + WS_F2T); bf16_t* H = (bf16_t*)(ws + WS_H); bf16_t* PROJ = (bf16_t*)(ws + WS_PROJ); bf16_t* KK = (bf16_t*)(ws + WS_KK); \
    bf16_t* OCAT = (bf16_t*)(ws + WS_OCAT); bf16_t* MIX = H; bf16_t* H2 = OCAT; bf16_t* Q2 = (bf16_t*)(ws + WS_Q2); \
    (void)x; (void)c_in; (void)w_ada; (void)b_ada; (void)pre_mix_g; (void)w_in; (void)b_fox_f; (void)gamma; (void)w_out; (void)w_q; (void)sub_keys; (void)U; (void)V; \
    (void)MOD; (void)LB; (void)WFF; (void)WIN; (void)WOUT; (void)WQ; (void)KEYS; (void)LOGF; (void)F2T; (void)H; (void)PROJ; (void)KK; (void)OCAT; (void)MIX; (void)H2; (void)Q2;
    const int flags = a.flags;

    for (int rep_ = 0; rep_ < ((DUP_PHASE == 0) ? 2 : 1); ++rep_) if (IN(0)) { PHASE_PTRS
        LAS float* condl = (LAS float*)lds;
        for (int i = tid; i < 8192; i += NTHREADS) { const float cv = c_in[i]; condl[i] = cv * sigmoidf_(cv); }
        __syncthreads();
        for (int it = gw; it < 768; it += NGW) {
            const int j = it * 8 + (lane & 7), ks = lane >> 3;
            float acc[8];
#pragma unroll
            for (int b = 0; b < 8; ++b) acc[b] = 0.f;
            const float* wp = w_ada + (size_t)ks * 6144 + j;
#pragma unroll 32
            for (int i = 0; i < 128; ++i) { const float w = wp[(size_t)i * 8 * 6144]; const int k = ks + 8 * i;
#pragma unroll
                for (int b = 0; b < 8; ++b) acc[b] += condl[b * 1024 + k] * w; }
#pragma unroll
            for (int b = 0; b < 8; ++b) { float v = acc[b]; v += __shfl_xor(v, 8); v += __shfl_xor(v, 16); v += __shfl_xor(v, 32); acc[b] = v; }
            if (lane < 8) { const float bb = b_ada[j];
#pragma unroll
                for (int b = 0; b < 8; ++b) MOD[b * 6144 + j] = acc[b] + bb; }
        }
        if (gw == NGW - 1) { for (int i = lane; i < 512; i += 64) LB[i] = 1.f / (1.f + __expf(gamma[512 + i] - gamma[i])); ((float*)(ws + WS_LB + 4096))[lane] = 0.f; ((float*)(ws + WS_LB + 4096))[64 + lane] = 0.f; }
        LAS float* scr = (LAS float*)(lds + 32768 + wave * 8448);
        if (G3I8) {
            unsigned* cmaxq = ctl + CW_CMAXQ;
            for (int it = gw - 768; it >= 0 && it < 128; it += NGW) { const int kb = it >> 3, cb = it & 7; const float* p = w_q + (size_t)(kb * 64) * 2048 + cb * 256 + 4 * lane;
                f32x4 m = (f32x4){0.f, 0.f, 0.f, 0.f};
#pragma unroll 16
                for (int r = 0; r < 64; ++r) { const f32x4 v = *(const f32x4*)(p + (size_t)r * 2048); m.x = fmaxf(m.x, fabsf(v.x)); m.y = fmaxf(m.y, fabsf(v.y)); m.z = fmaxf(m.z, fabsf(v.z)); m.w = fmaxf(m.w, fabsf(v.w)); }
                atomicMax(cmaxq + cb * 256 + 4 * lane, __float_as_uint(m.x)); atomicMax(cmaxq + cb * 256 + 4 * lane + 1, __float_as_uint(m.y)); atomicMax(cmaxq + cb * 256 + 4 * lane + 2, __float_as_uint(m.z)); atomicMax(cmaxq + cb * 256 + 4 * lane + 3, __float_as_uint(m.w)); }
        }
        for (int it = (gw >= 768) ? gw - 768 : gw + NGW - 768; it < (G3I8 ? 2304 : 3328); it += NGW) {
            int r = it;
            if (r < 768) { transpose_item<1, G1F8 ? 1 : 0>(w_in, 3592, 0, WIN, 0, scr, r, 48, lane); continue; } r -= 768;
            if (r < 1024) { transpose_item<1, G1F8 ? 1 : 0>(w_in, 3592, 1544, WIN, 1536, scr, r, 64, lane); continue; } r -= 1024;
            if (r < 512) { transpose_item<2, G2F8 ? 1 : 0>(w_out, 1024, 0, WOUT, 0, scr, r, 32, lane); continue; } r -= 512;
            transpose_item<4>(w_q, 2048, 0, WQ, 0, scr, r, 64, lane);
        }
        for (int i = gw * 64 + lane; i < 8192; i += NGW * 64) { const int jj = i >> 10, k = i & 1023; WFF[i] = w_in[(size_t)k * 3592 + 1536 + jj]; }
        for (int i = gw * 64 + lane; i < 65536; i += NGW * 64) { const f32x4 v = *(const f32x4*)(sub_keys + (size_t)i * 4); u32x2 o; o.x = pk2(v.x, v.y); o.y = pk2(v.z, v.w); *(u32x2*)(KEYS + (size_t)i * 4) = o; }
    }
    SEAM(0);
    for (int rep_ = 0; rep_ < ((DUP_PHASE == 1) ? 2 : 1); ++rep_) if (IN(1)) { PHASE_PTRS const int rpw = (T + NGW - 1) / NGW; h_rows(x, pre_mix_g, MOD, WFF, b_fox_f, H, LOGF, gw * rpw, (gw * rpw + rpw < T) ? gw * rpw + rpw : T, lane);
        if (G3I8) { LAS float* scr = (LAS float*)(lds + 32768 + wave * 8448);
            for (int it = gw; it < 1024; it += NGW) transpose_item<4, 2>(w_q, 2048, 0, WQ, 0, scr, it, 64, lane, (const float*)(ctl + CW_CMAXQ)); } }
    SEAM(1);
    if (DUP_PHASE == 99) { for (int i = 0; i < 10; ++i) xcd_barrier(bar); }
    for (int rep_ = 0; rep_ < ((DUP_PHASE == 2) ? 2 : 1); ++rep_) if (IN(2)) { PHASE_PTRS
        if (bx < 64) {
            const int bh = bx, b = bh >> 3, h = bh & 7;
            LAS float* wtot = (LAS float*)lds;
            const float* p = LOGF + ((size_t)b * SEQ + tid * 8) * 8 + h;
            float v[8], tot = 0.f;
#pragma unroll
            for (int i = 0; i < 8; ++i) { v[i] = p[i * 8]; tot += v[i]; }
            float incl = tot;
#pragma unroll
            for (int o = 1; o < 64; o <<= 1) { const float n = __shfl_up(incl, o); if (lane >= o) incl += n; }
            if (lane == 63) wtot[wave] = incl;
            __syncthreads();
            float base = incl - tot;
            for (int w = 0; w < wave; ++w) base += wtot[w];
            u32x4 dummy; (void)dummy;
            float run = base;
            float* o = F2T + (size_t)bh * SEQ + tid * 8;
#pragma unroll
            for (int i = 0; i < 8; ++i) { run += v[i]; o[i] = run * LOG2E; }
            __syncthreads();
        }
        pg8::Gemm g{H, WIN, T, NPROJ, G1F8 ? 512 : 1024}; pg8::StaticOrder S; S.init(T, NPROJ, G, bx, WGM_G1);
        EpiProjT E{PROJ, KK, LB, (unsigned*)(ws + WS_LB + 4096)};
        pg8::gemm_phase<EpiProjT, pg8::StaticOrder, true, true, G1F8 != 0>(lds, g, S, E);
    }
    SEAM(2);
    if (IN(3)) { PHASE_PTRS
        const float* KMAXH = (const float*)(ws + WS_LB + 4096);
        static_assert(HST8 && (8 * HG_PER_XCD) % 32 == 0 && HG_PER_XCD % ((8 * HG_PER_XCD) / 32) == 0, "the HGRN2 chain is organised per (b, head) group");
        if ((flags & FL_HGRN) && hg_member) {
            const int nblk = NHG / 32, bhb = hgi / nblk, sub = hgi % nblk;
            unsigned* gcnt = ctl + CW_GB + bhb * 16; unsigned* gtmo = ctl + CW_BAR + XB_TMO;
            hg::pass_a_all<false>(lds, PROJ, KK, (bf16_t*)(ws + WS_HST), (float*)(ws + WS_HD), bhb * 64 + sub, nblk, bhb * 64 + 64);
            group_barrier(gcnt, (unsigned)nblk, gtmo); STAMP(20);
            {   const int per = (2048 + nblk - 1) / nblk, base = sub * per, cnt = (base + per <= 2048) ? per : 2048 - base;
                LAS float* dl = (LAS float*)lds;
#pragma unroll
                for (int it = 0; it < 4; ++it) *(LAS f32x4*)(dl + (tid + 512 * it) * 4) = *(const f32x4*)((const float*)(ws + WS_HD) + (size_t)bhb * 8192 + (tid + 512 * it) * 4);
                __syncthreads();
                if (tid < cnt) hg::pass_b8_lds((unsigned char*)(ws + WS_HST), dl, bhb, base + tid);
            }
            group_barrier(gcnt, 2u * (unsigned)nblk, gtmo);
            hg::pass_c_all(lds, PROJ, (const bf16_t*)(ws + WS_HST), ka->in[9], OCAT, bhb * 64 + sub, nblk, bhb * 64 + 64);
        }
        if (flags & FL_ATTN) {
            unsigned* qctr = ctl + CW_ATTNQ;
            LAS int* ubox = (LAS int*)(lds + RING_BYTES + 64);
            for (int rep_ = 0; rep_ < ((DUP_PHASE == 3) ? 2 : 1); ++rep_)
            for (;;) {
                if (tid == 0) *ubox = (int)atomicAdd(qctr + 64 * rep_, 1u);
                __syncthreads();
                const int u = *ubox;
                __syncthreads();
                if (u >= 1024) break;
                const int qb = 15 - (u >> 6), bh = u & 63;
                fa::attn_unit(lds, PROJ, F2T, OCAT, bh >> 3, bh & 7, qb, sqrtf(KMAXH[2 * bh] + KMAXH[2 * bh + 1]));
            }
        }
    }
    SEAM(3); STAMP(6);
    for (int rep_ = 0; rep_ < ((DUP_PHASE == 6) ? 2 : 1); ++rep_) if (IN(6)) { PHASE_PTRS
        pg8::Gemm g{OCAT, WOUT, T, 1024, G2F8 ? 512 : 1024}; pg8::StaticOrder S; S.init(T, 1024, G, bx, WGM_G2);
        EpiPlainT E{MIX, 1024, G2F8 ? 0.03125f : 1.f};
        pg8::gemm_phase<EpiPlainT, pg8::StaticOrder, true, true, G2F8 != 0>(lds, g, S, E);
    }
    SEAM(6);
    for (int rep_ = 0; rep_ < ((DUP_PHASE == 7) ? 2 : 1); ++rep_) if (IN(7)) { PHASE_PTRS const int rpw = (T + NGW - 1) / NGW; row_passes(x, MIX, MOD, ka->in[5], ka->in[11], (bf16_t*)(ws + WS_HST), H2, (float*)(ws + WS_F), gw * rpw, (gw * rpw + rpw < T) ? gw * rpw + rpw : T, lane); }
    SEAM(7);
    for (int rep_ = 0; rep_ < ((DUP_PHASE == 8) ? 2 : 1); ++rep_) if (IN(8)) { PHASE_PTRS
        pg8::Gemm g{H2, WQ, T, NQ2, (G3I8 == 1) ? 512 : 1024}; pg8::StaticOrder S; S.init(T, NQ2, G, bx, WGM_G3);
        if (G3I8 == 1) { EpiPlainI8 E{Q2, NQ2, (const float*)(ws + WS_F), (const float*)(ctl + CW_CMAXQ)};
            pg8::gemm_phase<EpiPlainI8, pg8::StaticOrder, true, true, false, 0, 0, true>(lds, g, S, E); }
        else { EpiPlainT E{Q2, NQ2, 1.f};
            pg8::gemm_phase<EpiPlainT, pg8::StaticOrder, true, true>(lds, g, S, E); }
    }
    SEAM(8);
    for (int rep_ = 0; rep_ < ((DUP_PHASE == 9) ? 2 : 1); ++rep_) if (IN(9)) { PHASE_PTRS
        const int h = vcu & 7;
        {
            const bf16_t* ksrc = KEYS + (size_t)h * 2 * 128 * 128;
            for (int i = tid; i < 4096; i += NTHREADS) { const int row = i >> 4, ch = i & 15; *(LAS u32x4*)(lds + row * RT_KROW + ch * 16) = *(const u32x4*)(ksrc + row * 128 + ch * 8); }
        }
        __syncthreads();
        const int r32 = lane & 31, hi = lane >> 5;
        int* IDXw = (int*)(ws + WS_IDX); float* GATEw = (float*)(ws + WS_GATE);
        int qi = 0;
        const int qrows = (NEXP + NGW - 1) / NGW;
        for (int tb = (vcu >> 3); tb < T / 256; tb += G / 8) {
            const int t = tb * 256 + wave * 32 + r32;
            const bf16_t* qrow = Q2 + (size_t)t * NQ2 + h * 256;
            float A[16], B[16];
            f32x4 qa[4], qb[4];
            const int ra = gw * qrows + qi, rb_ = ra + 1; const bool oka = (qi < qrows) && (ra < NEXP), okb = (qi + 1 < qrows) && (rb_ < NEXP);
            if (oka) qrow_load(qa, U, ra, lane); if (okb) qrow_load(qb, U, rb_, lane);
            route_half(A, lds, qrow, r32, hi);
            __builtin_amdgcn_sched_barrier(0);
            if (oka) qrow_store<true>(qa, ws + WS_UQ, (float*)(ws + WS_US), ra, lane); if (okb) qrow_store<true>(qb, ws + WS_UQ, (float*)(ws + WS_US), rb_, lane);
            if (oka) qrow_load(qa, V, ra, lane); if (okb) qrow_load(qb, V, rb_, lane);
            route_half(B, lds + 128 * RT_KROW, qrow + 128, r32, hi);
            __builtin_amdgcn_sched_barrier(0);
            if (oka) qrow_store<false>(qa, ws + WS_UQ + 8, (float*)(ws + WS_VS), ra, lane); if (okb) qrow_store<false>(qb, ws + WS_UQ + 8, (float*)(ws + WS_VS), rb_, lane);
            qi += 2;
            route_final(A, B, lds + 256 * RT_KROW + tid * 32, IDXw + (size_t)t * 128 + h * 16, GATEw + (size_t)t * 128 + h * 16, hi == 0);
        }
        for (; qi < qrows; ++qi) { const int r = gw * qrows + qi; if (r < NEXP) { f32x4 qa[4]; qrow_load(qa, U, r, lane); qrow_store<true>(qa, ws + WS_UQ, (float*)(ws + WS_US), r, lane); qrow_load(qa, V, r, lane); qrow_store<false>(qa, ws + WS_UQ + 8, (float*)(ws + WS_VS), r, lane); } }
    }
    SEAM(9);
    if (IN(10)) { PHASE_PTRS
        const int* IDX = (const int*)(ws + WS_IDX); const float* GATE = (const float*)(ws + WS_GATE);
        for (int rep_ = ((DUP_PHASE == 10) ? 0 : 1); rep_ < 2; ++rep_) { float* outp = rep_ ? ka->out : (float*)(ws + 280 * MiB);
            const int rmask = (rep_ == 0 && DUP_MODE == 1) ? 255 : 0x3FFF;
            float pd = 0.f;
            if (TPROBE >= 0) { const unsigned long long* ts = (const unsigned long long*)(ctl + 8192); const int i0_ = (TPROBE == 30) ? 3 : (TPROBE == 31) ? 20 : (TPROBE == 5) ? 4 : TPROBE, i1_ = (TPROBE == 30) ? 20 : (TPROBE == 31) ? 4 : TPROBE + 1;
                const float dus = (float)(long long)(__hip_atomic_load(ts + i1_, __ATOMIC_RELAXED, __HIP_MEMORY_SCOPE_AGENT) - __hip_atomic_load(ts + i0_, __ATOMIC_RELAXED, __HIP_MEMORY_SCOPE_AGENT)) * 0.01f;
                pd = sqrtf(16.f * 0.004f * fminf(fmaxf(dus, 0.f), TPROBE_FS) / TPROBE_FS); }
            {
                const int tpw = (T + NGW - 1) / NGW, tb0 = vcu * NWAVES * tpw, b = (tb0 < T ? tb0 : 0) / SEQ;
                LAS float* pv = (LAS float*)lds; const float* md = MOD + b * 6144; const float* g_pre = ka->in[11]; const float* g_post = ka->in[12];
                for (int i = tid; i < 1024; i += NTHREADS) { pv[i] = g_pre[i] * (md[4096 + i] + 1.f); pv[1024 + i] = md[3072 + i]; pv[2048 + i] = md[5120 + i] * g_post[i]; }
                __syncthreads();
                const int t0 = gw * tpw, t1 = (t0 + tpw < T) ? t0 + tpw : T;
                if (rep_ == 0 && DUP_MODE == 2) { for (int t = t0; t < t1; ++t) gather_only_token((const unsigned char*)(ws + WS_UQ), IDX, outp, t, lane); } else
                expert_tokens((const unsigned char*)(ws + WS_UQ), (const float*)(ws + WS_US), (const float*)(ws + WS_VS), IDX, GATE, pv, (const bf16_t*)(ws + WS_HST), lds + 16384 + wave * 4096, outp, t0, t1, lane, rmask, pd);
                __syncthreads();
            } }
    }
#undef IN
#undef SEAM
}

extern "C" void kernel_launch(void* const* d_in, const int* in_sizes, int n_in, void* d_out, int out_size, void* d_ws, size_t ws_size, hipStream_t stream) {
    if (n_in != 17 || in_sizes[0] != T * DM || out_size != T * DM || ws_size < WS_END) { fprintf(stderr, "kernel_launch: unexpected inputs (n_in %d, ws %zu); nothing launched\n", n_in, ws_size); return; }
    static int grid = 0;
    if (grid == 0) {
        int dev = 0, cus = 0, per_cu = 0;
        if (hipGetDevice(&dev) != hipSuccess || hipDeviceGetAttribute(&cus, hipDeviceAttributeMultiprocessorCount, dev) != hipSuccess) { grid = -1; return; }
        if (hipFuncSetAttribute((const void*)mega, hipFuncAttributeMaxDynamicSharedMemorySize, LDS_BYTES) != hipSuccess) { fprintf(stderr, "kernel_launch: hipFuncSetAttribute failed\n"); grid = -1; return; }
        if (hipOccupancyMaxActiveBlocksPerMultiprocessor(&per_cu, (const void*)mega, NTHREADS, LDS_BYTES) != hipSuccess || per_cu < 1) { fprintf(stderr, "kernel_launch: occupancy query says %d\n", per_cu); (void)hipGetLastError(); grid = -1; return; }
        grid = cus;
        { const int rpw = (T + grid * NWAVES - 1) / (grid * NWAVES); if (SEQ % rpw != 0) { fprintf(stderr, "kernel_launch: %d CUs: the row passes give each wave %d consecutive rows, which must not straddle a batch; nothing launched\n", grid, rpw); grid = -1; return; } }
        if (grid % 8 != 0) { fprintf(stderr, "kernel_launch: %d CUs: the routing phase deals heads over groups of 8 workgroups; nothing launched\n", grid); grid = -1; return; }
    }
    if (grid < 0) return;
    if (hipMemsetAsync((unsigned char*)d_ws + WS_CTL, 0, CTL_ZERO_BYTES, stream) != hipSuccess) return;
    Args a{}; for (int i = 0; i < 17; ++i) a.in[i] = (const float*)d_in[i];
    a.out = (float*)d_out; a.ws = (unsigned char*)d_ws; a.ph_lo = 0; a.ph_hi = 11; a.li = 0; a.flags = FL_ATTN | FL_HGRN;
    hipLaunchKernelGGL(mega, dim3(grid), dim3(NTHREADS), LDS_BYTES, stream, a);
}
```
